# Optimizing an MI355X kernel written in HIP

```python
import math
import jax
import jax.numpy as jnp
from jax import lax
import numpy as np

D_MODEL = 4096
BATCH = 2
SEQ = 8192
DEPTH = 2

CTX_LEN = 256
GRID_W = 64
N_SUB = 3
N_MOD = 3 * N_SUB
D_FF = 3 * D_MODEL // 2
ATT_HEAD_DIM = 128
ATT_WIDTH = D_MODEL // 2
ATT_HEADS = ATT_WIDTH // ATT_HEAD_DIM
WIN_H = 8
WIN_W = 16
ROPE_BASE = 10000.0
GMLP_WIDTH = D_MODEL // 4
CHUNK = 128
GMLP_GROUP_DIM = 128
GMLP_GROUPS = GMLP_WIDTH // GMLP_GROUP_DIM
SSM_WIDTH = D_MODEL // 4
SSM_GROUP = 16
SSM_GROUPS = SSM_WIDTH // SSM_GROUP
SSM_STATE = 64
DT_MIN = 1e-3
DT_MAX = 1e-1
N_BRANCH = 3
Q_OFF = 0
K_OFF = ATT_WIDTH
V_OFF = 2 * ATT_WIDTH
GM_OFF = 3 * ATT_WIDTH
SSM_OFF = GM_OFF + 2 * GMLP_WIDTH
GATE_OFF = SSM_OFF + SSM_WIDTH
IN_COLS = GATE_OFF + N_BRANCH * D_MODEL
ALPHA = (2.0 * DEPTH) ** 0.25
BETA = (8.0 * DEPTH) ** -0.25
LN_EPS = 1e-6
NEG_INF = -1e30

kernel_name = 'hybrid_natten_gmlp_s5_diffusion_block'


def layer_norm(x, g=None, b=None):
    xf = x.astype(jnp.float32)
    mu = jnp.mean(xf, axis=-1, keepdims=True)
    var = jnp.mean(jnp.square(xf - mu), axis=-1, keepdims=True)
    y = (xf - mu) * lax.rsqrt(var + LN_EPS)
    if g is not None:
        y = y * g.astype(jnp.float32) + b.astype(jnp.float32)
    return y.astype(x.dtype)


def modulate(x, shift, scale):
    return layer_norm(x) * (1.0 + scale) + shift


def post_norm(x, y, g, b):
    return layer_norm(ALPHA * x + y, g, b)


def swiglu(h, w_in, w_out):
    g, u = jnp.split(h @ w_in, 2, axis=-1)
    return (jax.nn.silu(g) * u) @ w_out


def rope_1d(t, pos):
    half = t.shape[-1] // 2
    inv = ROPE_BASE ** (-jnp.arange(half, dtype=jnp.float32) / half)
    ang = pos.astype(jnp.float32)[:, None] * inv[None, :]
    cos = jnp.cos(ang)[:, None, :]
    sin = jnp.sin(ang)[:, None, :]
    t1 = t[..., :half].astype(jnp.float32)
    t2 = t[..., half:].astype(jnp.float32)
    return jnp.concatenate([t1 * cos - t2 * sin, t1 * sin + t2 * cos], axis=-1).astype(t.dtype)


def rope_2d(t, rows, cols):
    h = t.shape[-1] // 2
    return jnp.concatenate([rope_1d(t[..., :h], rows), rope_1d(t[..., h:], cols)], axis=-1)


def neighborhood_attention(q, q_rot, k_rot, v, k_ctx, v_ctx, rpb):
    Bn, L, H, Dh = q.shape
    rows = L // GRID_W
    kh = min(WIN_H, rows)
    scale = Dh ** -0.5
    qg = q.reshape(Bn, rows, GRID_W, H, Dh)
    qrg = q_rot.reshape(Bn, rows, GRID_W, H, Dh)
    kg = k_rot.reshape(Bn, rows, GRID_W, H, Dh)
    vg = v.reshape(Bn, rows, GRID_W, H, Dh)
    col = jnp.arange(GRID_W)
    col_start = jnp.clip(col - WIN_W // 2, 0, GRID_W - WIN_W)
    col_mask = (col[None, :] >= col_start[:, None]) & (col[None, :] < col_start[:, None] + WIN_W)
    dc = jnp.clip(col[None, :] - col[:, None] + WIN_W - 1, 0, 2 * WIN_W - 2)

    def one_row(r):
        rs = jnp.clip(r - kh // 2, 0, rows - kh)
        kb = lax.dynamic_slice_in_dim(kg, rs, kh, axis=1)
        vb = lax.dynamic_slice_in_dim(vg, rs, kh, axis=1)
        qr = lax.dynamic_index_in_dim(qrg, r, axis=1, keepdims=False)
        qp = lax.dynamic_index_in_dim(qg, r, axis=1, keepdims=False)
        s_loc = jnp.einsum('bqhd,bikhd->bhqik', qr, kb, preferred_element_type=jnp.float32) * scale
        dr = rs + jnp.arange(kh) - r + (WIN_H - 1)
        bias = rpb[:, dr][:, :, dc].astype(jnp.float32)
        s_loc = s_loc + jnp.transpose(bias, (0, 2, 1, 3))[None]
        s_loc = jnp.where(col_mask[None, None, :, None, :], s_loc, NEG_INF)
        s_ctx = jnp.einsum('bqhd,bchd->bhqc', qp, k_ctx, preferred_element_type=jnp.float32) * scale
        s = jnp.concatenate([s_loc.reshape(Bn, H, GRID_W, kh * GRID_W), s_ctx], axis=-1)
        p = jax.nn.softmax(s, axis=-1).astype(v.dtype)
        p_loc = p[..., :kh * GRID_W].reshape(Bn, H, GRID_W, kh, GRID_W)
        p_ctx = p[..., kh * GRID_W:]
        return (jnp.einsum('bhqik,bikhd->bqhd', p_loc, vb)
                + jnp.einsum('bhqc,bchd->bqhd', p_ctx, v_ctx))

    out = lax.map(one_row, jnp.arange(rows))
    return jnp.transpose(out, (1, 0, 2, 3, 4)).reshape(Bn, L, H * Dh)


def context_attention(q, k, v):
    s = jnp.einsum('bqhd,bkhd->bhqk', q, k, preferred_element_type=jnp.float32) * (ATT_HEAD_DIM ** -0.5)
    p = jax.nn.softmax(s, axis=-1).astype(v.dtype)
    o = jnp.einsum('bhqk,bkhd->bqhd', p, v)
    return o.reshape(o.shape[0], o.shape[1], ATT_WIDTH)


def chunk_gmlp(z, ln_g, ln_b, w_s, b_s):
    z = jax.nn.gelu(z)
    u, v = jnp.split(z, 2, axis=-1)
    v = layer_norm(v, ln_g, ln_b)
    Bn, L, _ = v.shape
    vc = v.reshape(Bn, L // CHUNK, CHUNK, GMLP_GROUPS, GMLP_GROUP_DIM)
    mixed = jnp.einsum('gqp,bnpgc->bnqgc', w_s, vc) + jnp.transpose(b_s)[None, None, :, :, None]
    return u * mixed.reshape(Bn, L, GMLP_WIDTH)


def s5_discretize(lam_re, lam_im, log_dt, b_re, b_im):
    dt = jnp.exp(log_dt.astype(jnp.float32))[:, None]
    lr = lam_re.astype(jnp.float32)
    li = lam_im.astype(jnp.float32)
    mag = jnp.exp(lr * dt)
    ar = mag * jnp.cos(li * dt)
    ai = mag * jnp.sin(li * dt)
    den = lr * lr + li * li
    fr = ((ar - 1.0) * lr + ai * li) / den
    fi = (ai * lr - (ar - 1.0) * li) / den
    br = b_re.astype(jnp.float32)
    bi = b_im.astype(jnp.float32)
    bbr = fr[..., None] * br - fi[..., None] * bi
    bbi = fr[..., None] * bi + fi[..., None] * br
    return ar, ai, bbr, bbi


def _cplx_combine(e1, e2):
    a1r, a1i, b1r, b1i = e1
    a2r, a2i, b2r, b2i = e2
    return (a2r * a1r - a2i * a1i, a2r * a1i + a2i * a1r,
            a2r * b1r - a2i * b1i + b2r, a2r * b1i + a2i * b1r + b2i)


def s5_states(ug, h0r, h0i, ar, ai, bbr, bbi):
    bur = jnp.einsum('blgc,gpc->blgp', ug, bbr)
    bui = jnp.einsum('blgc,gpc->blgp', ug, bbi)
    bur = bur.at[:, 0].add(ar * h0r - ai * h0i)
    bui = bui.at[:, 0].add(ar * h0i + ai * h0r)
    L = ug.shape[1]
    a_r = jnp.broadcast_to(ar, (1, L) + ar.shape)
    a_i = jnp.broadcast_to(ai, (1, L) + ai.shape)
    _, _, hr, hi = lax.associative_scan(_cplx_combine, (a_r, a_i, bur, bui), axis=1)
    return hr, hi


def s5_readout(hr, hi, c_re, c_im):
    y = (jnp.einsum('blgp,gcp->blgc', hr, c_re.astype(jnp.float32))
         - jnp.einsum('blgp,gcp->blgc', hi, c_im.astype(jnp.float32)))
    return y.reshape(y.shape[0], y.shape[1], SSM_WIDTH)


def dir_flip(t, d):
    return jnp.flip(t, axis=1) if d == 1 else t


def s5_output(y, u, d_skip, w_glu, b_glu):
    y = (y + d_skip.astype(jnp.float32) * u.astype(jnp.float32)).astype(u.dtype)
    y = jax.nn.gelu(y)
    return y * jax.nn.sigmoid(y @ w_glu + b_glu)


def merge_branches(o_a, o_b, o_c, gates, w_pa, w_pb, w_pc, w_o):
    g = jax.nn.sigmoid(gates.astype(jnp.float32)).astype(gates.dtype)
    ga, gb, gc = jnp.split(g, N_BRANCH, axis=-1)
    return (ga * (o_a @ w_pa) + gb * (o_b @ w_pb) + gc * (o_c @ w_pc)) @ w_o


def token_mixer(h, hc, w_in, rpb, gm_ln_g, gm_ln_b, gm_ws, gm_bs,
                lam_re, lam_im, log_dt, b_re, b_im, c_re, c_im, d_skip, w_glu, b_glu,
                w_pa, w_pb, w_pc, w_o, need_ctx_out):
    Bn, L, _ = h.shape
    Bc = hc.shape[0]

    def heads(t):
        return t.reshape(t.shape[0], t.shape[1], ATT_HEADS, ATT_HEAD_DIM)

    p = h @ w_in
    q = heads(p[..., Q_OFF:K_OFF])
    k = heads(p[..., K_OFF:V_OFF])
    v = heads(p[..., V_OFF:GM_OFF])
    z = p[..., GM_OFF:SSM_OFF]
    us = p[..., SSM_OFF:GATE_OFF]
    gates = p[..., GATE_OFF:]
    kvc = hc @ w_in[:, K_OFF:GM_OFF]
    kc = heads(kvc[..., :ATT_WIDTH])
    vc = heads(kvc[..., ATT_WIDTH:])
    usc = hc @ w_in[:, SSM_OFF:GATE_OFF]

    t = jnp.arange(L)
    rows = t // GRID_W
    cols = t % GRID_W
    o_att = neighborhood_attention(q, rope_2d(q, rows, cols), rope_2d(k, rows, cols), v, kc, vc, rpb)
    o_gm = chunk_gmlp(z, gm_ln_g, gm_ln_b, gm_ws, gm_bs)
    ug = us.astype(jnp.float32).reshape(Bn, L, SSM_GROUPS, SSM_GROUP)
    ugc = usc.astype(jnp.float32).reshape(Bc, hc.shape[1], SSM_GROUPS, SSM_GROUP)
    zeros = jnp.zeros((Bc, SSM_GROUPS, SSM_STATE), jnp.float32)
    y_s = 0.0
    y_sc = 0.0
    for d in range(2):
        ar, ai, bbr, bbi = s5_discretize(lam_re[d], lam_im[d], log_dt[d], b_re[d], b_im[d])
        scr, sci = s5_states(dir_flip(ugc, d), zeros, zeros, ar, ai, bbr, bbi)
        slr, sli = s5_states(dir_flip(ug, d), scr[:, -1], sci[:, -1], ar, ai, bbr, bbi)
        y_s = y_s + dir_flip(s5_readout(slr, sli, c_re[d], c_im[d]), d)
        if need_ctx_out:
            y_sc = y_sc + dir_flip(s5_readout(scr, sci, c_re[d], c_im[d]), d)
    o_ssm = s5_output(y_s, us, d_skip, w_glu, b_glu)
    y_lat = merge_branches(o_gm, o_att, o_ssm, gates, w_pa, w_pb, w_pc, w_o)
    if not need_ctx_out:
        return y_lat, None

    qc = heads(hc @ w_in[:, Q_OFF:K_OFF])
    zc = hc @ w_in[:, GM_OFF:SSM_OFF]
    gates_c = hc @ w_in[:, GATE_OFF:]
    oc_att = context_attention(qc, kc, vc)
    oc_gm = chunk_gmlp(zc, gm_ln_g, gm_ln_b, gm_ws, gm_bs)
    oc_ssm = s5_output(y_sc, usc, d_skip, w_glu, b_glu)
    y_ctx = merge_branches(oc_gm, oc_att, oc_ssm, gates_c, w_pa, w_pb, w_pc, w_o)
    return y_lat, y_ctx


def setup_inputs(seed: int = 0) -> dict:
    key = jax.random.key(seed)
    ks = iter(jax.random.split(key, 40))
    f32 = jnp.float32

    def nrm(shape, s):
        return jax.random.normal(next(ks), shape, f32) * s

    D = D_MODEL
    G, P = SSM_GROUPS, SSM_STATE
    x = nrm((BATCH, SEQ, D), 1.0)
    c = nrm((BATCH, D), 1.0)
    ctx = nrm((BATCH, CTX_LEN, D), 1.0)
    c_ctx = nrm((D,), 1.0)
    w_mod = nrm((DEPTH, D, N_MOD * D), D ** -0.5)
    b_mod = nrm((DEPTH, N_MOD * D), 0.02)
    ln_g = 1.0 + nrm((DEPTH, N_SUB, D), 0.02)
    ln_b = nrm((DEPTH, N_SUB, D), 0.02)
    ffn1_w_in = nrm((DEPTH, D, 2 * D_FF), D ** -0.5)
    ffn1_w_out = nrm((DEPTH, D_FF, D), BETA * D_FF ** -0.5)
    ffn2_w_in = nrm((DEPTH, D, 2 * D_FF), D ** -0.5)
    ffn2_w_out = nrm((DEPTH, D_FF, D), BETA * D_FF ** -0.5)
    w_in = nrm((DEPTH, D, IN_COLS), D ** -0.5)
    rpb = nrm((DEPTH, ATT_HEADS, 2 * WIN_H - 1, 2 * WIN_W - 1), 0.05)
    gm_ln_g = 1.0 + nrm((DEPTH, GMLP_WIDTH), 0.02)
    gm_ln_b = nrm((DEPTH, GMLP_WIDTH), 0.02)
    gm_ws = nrm((DEPTH, GMLP_GROUPS, CHUNK, CHUNK), CHUNK ** -0.5)
    gm_bs = 1.0 + nrm((DEPTH, GMLP_GROUPS, CHUNK), 0.02)
    ssm_lam_re = -0.5 + nrm((DEPTH, 2, G, P), 0.01)
    ssm_lam_im = math.pi * jnp.arange(P, dtype=f32) + nrm((DEPTH, 2, G, P), 0.01)
    ssm_log_dt = jax.random.uniform(next(ks), (DEPTH, 2, G), f32, math.log(DT_MIN), math.log(DT_MAX))
    ssm_b_re = nrm((DEPTH, 2, G, P, SSM_GROUP), (2 * SSM_GROUP) ** -0.5)
    ssm_b_im = nrm((DEPTH, 2, G, P, SSM_GROUP), (2 * SSM_GROUP) ** -0.5)
    ssm_c_re = nrm((DEPTH, 2, G, SSM_GROUP, P), P ** -0.5)
    ssm_c_im = nrm((DEPTH, 2, G, SSM_GROUP, P), P ** -0.5)
    ssm_d = nrm((DEPTH, SSM_WIDTH), 1.0)
    ssm_w_glu = nrm((DEPTH, SSM_WIDTH, SSM_WIDTH), SSM_WIDTH ** -0.5)
    ssm_b_glu = nrm((DEPTH, SSM_WIDTH), 0.02)
    w_pa = nrm((DEPTH, GMLP_WIDTH, D), GMLP_WIDTH ** -0.5)
    w_pb = nrm((DEPTH, ATT_WIDTH, D), ATT_WIDTH ** -0.5)
    w_pc = nrm((DEPTH, SSM_WIDTH, D), SSM_WIDTH ** -0.5)
    w_o = nrm((DEPTH, D, D), BETA * D ** -0.5)
    return {'x': x, 'c': c, 'ctx': ctx, 'c_ctx': c_ctx, 'w_mod': w_mod, 'b_mod': b_mod,
            'ln_g': ln_g, 'ln_b': ln_b, 'ffn1_w_in': ffn1_w_in, 'ffn1_w_out': ffn1_w_out,
            'ffn2_w_in': ffn2_w_in, 'ffn2_w_out': ffn2_w_out, 'w_in': w_in, 'rpb': rpb,
            'gm_ln_g': gm_ln_g, 'gm_ln_b': gm_ln_b, 'gm_ws': gm_ws, 'gm_bs': gm_bs,
            'ssm_lam_re': ssm_lam_re, 'ssm_lam_im': ssm_lam_im, 'ssm_log_dt': ssm_log_dt,
            'ssm_b_re': ssm_b_re, 'ssm_b_im': ssm_b_im, 'ssm_c_re': ssm_c_re, 'ssm_c_im': ssm_c_im,
            'ssm_d': ssm_d, 'ssm_w_glu': ssm_w_glu, 'ssm_b_glu': ssm_b_glu,
            'w_pa': w_pa, 'w_pb': w_pb, 'w_pc': w_pc, 'w_o': w_o}


def reference(x, c, ctx, c_ctx, w_mod, b_mod, ln_g, ln_b, ffn1_w_in, ffn1_w_out, ffn2_w_in, ffn2_w_out,
              w_in, rpb, gm_ln_g, gm_ln_b, gm_ws, gm_bs, ssm_lam_re, ssm_lam_im, ssm_log_dt,
              ssm_b_re, ssm_b_im, ssm_c_re, ssm_c_im, ssm_d, ssm_w_glu, ssm_b_glu,
              w_pa, w_pb, w_pc, w_o):
    Bn = x.shape[0]
    for l in range(DEPTH):
        need_ctx_out = l < DEPTH - 1
        mx = (jax.nn.silu(c) @ w_mod[l] + b_mod[l]).reshape(Bn, N_MOD, 1, D_MODEL)
        mx = [mx[:, i] for i in range(N_MOD)]
        mc = (jax.nn.silu(c_ctx) @ w_mod[l] + b_mod[l]).reshape(N_MOD, D_MODEL)
        x = post_norm(x, 0.5 * mx[2] * swiglu(modulate(x, mx[0], mx[1]), ffn1_w_in[l], ffn1_w_out[l]),
                      ln_g[l, 0], ln_b[l, 0])
        ctx = post_norm(ctx, 0.5 * mc[2] * swiglu(modulate(ctx, mc[0], mc[1]), ffn1_w_in[l], ffn1_w_out[l]),
                        ln_g[l, 0], ln_b[l, 0])
        y_lat, y_ctx = token_mixer(
            modulate(x, mx[3], mx[4]), modulate(ctx, mc[3], mc[4]), w_in[l], rpb[l],
            gm_ln_g[l], gm_ln_b[l], gm_ws[l], gm_bs[l],
            ssm_lam_re[l], ssm_lam_im[l], ssm_log_dt[l], ssm_b_re[l], ssm_b_im[l],
            ssm_c_re[l], ssm_c_im[l], ssm_d[l], ssm_w_glu[l], ssm_b_glu[l],
            w_pa[l], w_pb[l], w_pc[l], w_o[l], need_ctx_out)
        x = post_norm(x, mx[5] * y_lat, ln_g[l, 1], ln_b[l, 1])
        x = post_norm(x, 0.5 * mx[8] * swiglu(modulate(x, mx[6], mx[7]), ffn2_w_in[l], ffn2_w_out[l]),
                      ln_g[l, 2], ln_b[l, 2])
        if need_ctx_out:
            ctx = post_norm(ctx, mc[5] * y_ctx, ln_g[l, 1], ln_b[l, 1])
            ctx = post_norm(ctx, 0.5 * mc[8] * swiglu(modulate(ctx, mc[6], mc[7]), ffn2_w_in[l], ffn2_w_out[l]),
                            ln_g[l, 2], ln_b[l, 2])
    return x
```

```cpp
#include <hip/hip_runtime.h>
#include <cstdio>
#include <cstdint>

#ifndef MK_N_LAUNCHES
#define MK_N_LAUNCHES 1
#endif

#define GAS __attribute__((address_space(1)))
#define LAS __attribute__((address_space(3)))
typedef unsigned short bf16;
typedef short bf16x8 __attribute__((ext_vector_type(8)));
typedef short s16x4 __attribute__((ext_vector_type(4)));
typedef float f32x2 __attribute__((ext_vector_type(2)));
typedef float f32x4 __attribute__((ext_vector_type(4)));
typedef float f32x16 __attribute__((ext_vector_type(16)));
typedef unsigned u32x2 __attribute__((ext_vector_type(2)));
typedef unsigned u32x4 __attribute__((ext_vector_type(4)));

constexpr int D = 4096, NB = 2, SEQ = 8192, CTXL = 256, DEPTH = 2;
constexpr int ML = NB * SEQ, MC = NB * CTXL, M = ML + MC;
constexpr int DFF = 6144, NMOD = 9, NMODC = NMOD * D;
constexpr int AW = 2048, NH = 16, HD = 128, GMW = 1024, SSW = 1024, NG = 64, NP = 64, SG = 16;
constexpr int NIN = 21504;
constexpr int NCH = M / 128;
constexpr int NK = 66;
constexpr float ALPHA = 1.4142135623730951f, LN_EPS = 1e-6f, LOG2E = 1.4426950408889634f;

constexpr size_t MiB = 1u << 20;
constexpr size_t WS_CTL = 0, CTL_ZERO_BYTES = 1 * MiB;
constexpr size_t WS_MOD = 1 * MiB;
constexpr size_t WS_ROPE = 2 * MiB;
constexpr size_t WS_SA = 3 * MiB;
constexpr size_t WS_SBB = 4 * MiB;
constexpr size_t WS_SC = 6 * MiB;
constexpr size_t WS_GWS = 7 * MiB;
constexpr size_t WS_HEND = 8 * MiB;
constexpr size_t WS_W = 32 * MiB;
constexpr size_t LW_W1IN = 0, LW_W1OUT = 96 * MiB, LW_W2IN = 144 * MiB, LW_W2OUT = 240 * MiB, LW_WIN = 288 * MiB, LW_WGLU = 456 * MiB, LW_WCAT = 458 * MiB, LW_WO = 490 * MiB, LW_W8 = 522 * MiB  , LW_BYTES = 570 * MiB;
constexpr size_t WS_X = WS_W + 2 * LW_BYTES;
constexpr size_t WS_H = WS_X + 264 * MiB;
constexpr size_t WS_ACT = WS_H + 132 * MiB;
constexpr size_t WS_QP = WS_ACT + 198 * MiB;
constexpr size_t WS_QR = WS_QP + 66 * MiB;
constexpr size_t WS_KB = WS_QR + 66 * MiB;
constexpr size_t WS_VB = WS_KB + 66 * MiB;
constexpr size_t WS_ZB = WS_VB + 66 * MiB;
constexpr size_t WS_US = WS_ZB + 66 * MiB;
constexpr size_t WS_GB = WS_US + 33 * MiB;
constexpr size_t WS_ACAT = WS_GB + 396 * MiB;
constexpr size_t WS_YS = WS_ACAT + 132 * MiB;
constexpr size_t WS_MG = WS_YS + 33 * MiB;
constexpr size_t WS_Y = WS_MG + 132 * MiB;
constexpr size_t WS_END = WS_Y + 132 * MiB;
constexpr int CW_BAR = 4096;

constexpr int RING_BYTES = 131072, LDSCTL_OFF = RING_BYTES, MISC_OFF = LDSCTL_OFF + 320, LDS_BYTES = 147456;

__device__ __forceinline__ unsigned cvt_pk_bf16(float lo, float hi) { unsigned r; asm volatile("v_cvt_pk_bf16_f32 %0, %1, %2" : "=v"(r) : "v"(lo), "v"(hi)); return r; }
__device__ __forceinline__ float bf_lo(unsigned w) { return __uint_as_float(w << 16); }
__device__ __forceinline__ float bf_hi(unsigned w) { return __uint_as_float(w & 0xffff0000u); }
__device__ __forceinline__ float fast_sigmoid(float x) { return __builtin_amdgcn_rcpf(1.0f + __builtin_amdgcn_exp2f(-LOG2E * x)); }
__device__ __forceinline__ float silu_f(float x) { return x * fast_sigmoid(x); }
__device__ __forceinline__ float gelu_tanh_f(float x) { const float u = 1.5957691216057308f * (x + 0.044715f * x * x * x); return x * fast_sigmoid(u); }
template <class T> __device__ __forceinline__ T* as_global(T* p) { return (T*)(GAS T*)p; }
#define LDS_WAIT() asm volatile("s_waitcnt lgkmcnt(0)" ::: "memory")
#define VM_WAIT() asm volatile("s_waitcnt vmcnt(0)" ::: "memory")

namespace pg8 {
constexpr int BM = 256, BK = 64, HALF = 128, HTB = HALF * BK * 2, STAGE_BYTES = 8 * HTB, NXCD = 8, WGM = 4;
__host__ __device__ __forceinline__ int lds_byte(int r, int c) { const int st = (r >> 4) * 2 + (c >> 5), rr = r & 15, cc = c & 31, ob = rr * 64 + cc * 2; return st * 1024 + (ob ^ (((ob >> 9) & 1) << 5)); }
__host__ __device__ __forceinline__ void stage_rc(int b, int& R, int& C) { const int st = b / 1024, sb = b % 1024, swz = sb ^ (((sb >> 9) & 1) << 5); R = (st >> 1) * 16 + swz / 64; C = (st & 1) * 32 + (swz % 64) / 2; }
__host__ __device__ __forceinline__ int perm32(int rho) { const int n = rho >> 4, i = rho & 15; return 8 * (i >> 2) + 4 * n + (i & 3); }
typedef int v8i __attribute__((ext_vector_type(8)));
typedef int v4i __attribute__((ext_vector_type(4)));
struct Unit { int pm, pn, k0, nt, seg; };
struct Gemm { const bf16* A; const bf16* Bt; int M, N, K, lda, ldb; };
struct StaticOrder {
    int nM, nN, nwg, G, c, ntk;
    __host__ __device__ void init(int M_, int N_, int G_, int c_, int K_) { nM = M_ / BM; nN = N_ / BM; nwg = nM * nN; G = G_; c = c_; ntk = K_ / BK; }
    __host__ __device__ __forceinline__ bool next(int i, Unit& u) const {
        u.pm = 0; u.pn = 0; u.k0 = 0; u.nt = ntk; u.seg = 0;
        const long L = (long)i * G + c; if (L >= nwg) return false;
        int wgid = (int)L; { const int q = nwg / NXCD, r = nwg % NXCD, xcd = wgid % NXCD, off = wgid / NXCD; wgid = (xcd < r ? xcd * (q + 1) : r * (q + 1) + (xcd - r) * q) + off; }
        const int nig = WGM * nN, gid = wgid / nig, fm = gid * WGM, gsz = (nM - fm) < WGM ? (nM - fm) : WGM;
        u.pm = fm + ((wgid % nig) % gsz); u.pn = (wgid % nig) / gsz; return true;
    }
    __device__ __forceinline__ void a_ready(const Unit&) const {}
    __device__ __forceinline__ void done(const Unit&) const {}
};

struct CtxOrder {
    int nN, c, ntk;
    __host__ __device__ void init(int N_, int c_, int K_) { nN = N_ / BM; c = c_; ntk = K_ / BK; }
    __host__ __device__ __forceinline__ bool next(int i, Unit& u) const { u.pm = ML / BM + c / nN; u.pn = c % nN; u.k0 = 0; u.nt = ntk; u.seg = 0; return i == 0 && c < (MC / BM) * nN; }
    __device__ __forceinline__ void a_ready(const Unit&) const {}
    __device__ __forceinline__ void done(const Unit&) const {}
};
struct MergeOrder {
    StaticOrder tiles;
    __host__ __device__ void init(int M_, int N_, int G_, int c_) { tiles.init(M_, N_, G_, c_, GMW + AW + SSW); }
    __host__ __device__ __forceinline__ bool next(int i, Unit& u) const {
        const int it = i / 3, sg = i - 3 * it; Unit t; const bool ok = tiles.next(it, t);
        u.pm = t.pm; u.pn = t.pn; u.seg = sg; u.k0 = sg == 0 ? 0 : (sg == 1 ? GMW : GMW + AW); u.nt = (sg == 1 ? AW : GMW) / BK; return ok;
    }
    __device__ __forceinline__ void a_ready(const Unit&) const {}
    __device__ __forceinline__ void done(const Unit&) const {}
};

template <class Epi, class Sched, bool ALIGN_EPI = true, bool SP2 = true>
__device__ __forceinline__ void gemm_phase(LAS unsigned char* lds, const Gemm g, const Sched& S, const Epi& E, const int tid) {
    const int wid = __builtin_amdgcn_readfirstlane(tid >> 6), lane = tid & 63, wr = wid >> 2, wc = wid & 3, fr = lane & 15, fq = lane >> 4;
    unsigned voffA[2], voffB[2];
#pragma unroll
    for (int i = 0; i < 2; ++i) { int R, C; stage_rc(tid * 16 + i * 8192, R, C); const int Rb = Epi::PERM ? ((R & ~31) + perm32(R & 31)) : R;
        voffA[i] = (unsigned)(R * g.lda + C) * 2u; voffB[i] = (unsigned)(Rb * g.ldb + C) * 2u; }
    const unsigned kstep = (unsigned)(BK * 2);
    const unsigned hA = (unsigned)HALF * (unsigned)g.lda * 2u, hB = (unsigned)HALF * (unsigned)g.ldb * 2u;
    const unsigned tA = 2 * hA, tB = 2 * hB;
    const __amdgpu_buffer_rsrc_t srd_voffA = __builtin_amdgcn_make_buffer_rsrc((void*)g.A, 0, 0x7ffffff0, 0x00020000);
    const __amdgpu_buffer_rsrc_t srd_voffB = __builtin_amdgcn_make_buffer_rsrc((void*)g.Bt, 0, 0x7ffffff0, 0x00020000);
    const unsigned ldsw = (unsigned)wid * 1024u;
    constexpr bool FP8 = Epi::FP8;
    const int aoff = FP8 ? lds_byte(wr * 64 + fr, fq * 16) : lds_byte(wr * 64 + fr, fq * 8), boff = FP8 ? lds_byte(wc * 32 + fr, fq * 16) : lds_byte(wc * 32 + fr, fq * 8);
    const int aoff1 = FP8 ? lds_byte(wr * 64 + fr, fq * 16 + 8) : aoff + 1024, boff1 = FP8 ? lds_byte(wc * 32 + fr, fq * 16 + 8) : boff + 1024;
#define PG8_SA(b, h) (((b) * 2 + (h)) * HTB)
#define PG8_SB(b, h) ((4 + (b) * 2 + (h)) * HTB)
#define PG8_STAGE(bufoff, gbase, voff) do { _Pragma("unroll") for (int _i = 0; _i < 2; ++_i) \
        __builtin_amdgcn_raw_ptr_buffer_load_lds(srd_##voff, (LAS void*)(lds + (bufoff) + ldsw + _i * 8192), 16, (int)(voff)[_i], (int)(gbase), 0, 0); } while (0)
#define PG8_LDA(dst, b, h) do { if constexpr (FP8) { _Pragma("unroll") for (int m = 0; m < 4; ++m) { dst##8[m].lo = *(const LAS v4i*)(lds + PG8_SA(b, h) + aoff + m * 2048); dst##8[m].hi = *(const LAS v4i*)(lds + PG8_SA(b, h) + aoff1 + m * 2048); } } \
        else { _Pragma("unroll") for (int m = 0; m < 4; ++m) _Pragma("unroll") for (int k = 0; k < 2; ++k) dst[m][k] = *(const LAS bf16x8*)(lds + PG8_SA(b, h) + (k ? aoff1 : aoff) + m * 2048); } } while (0)
#define PG8_LDB(dst, b, h) do { if constexpr (FP8) { _Pragma("unroll") for (int n = 0; n < 2; ++n) { dst##8[n].lo = *(const LAS v4i*)(lds + PG8_SB(b, h) + boff + n * 2048); dst##8[n].hi = *(const LAS v4i*)(lds + PG8_SB(b, h) + boff1 + n * 2048); } } \
        else { _Pragma("unroll") for (int n = 0; n < 2; ++n) _Pragma("unroll") for (int k = 0; k < 2; ++k) dst[n][k] = *(const LAS bf16x8*)(lds + PG8_SB(b, h) + (k ? boff1 : boff) + n * 2048); } } while (0)
#define PG8_MMA(ai, bj, At, Bt) do { __builtin_amdgcn_s_setprio(1); _Pragma("unroll") for (int m = 0; m < 4; ++m) _Pragma("unroll") for (int n = 0; n < 2; ++n) { \
        if constexpr (FP8) asm volatile("v_mfma_scale_f32_16x16x128_f8f6f4 %0, %1, %2, %0, %3, %3 op_sel_hi:[0,0,0]" : "+v"(acc[ai][bj][m][n]) : "v"(Bt##8[n]), "v"(At##8[m]), "v"(scale1));   \
        else { _Pragma("unroll") for (int k = 0; k < 2; ++k) acc[ai][bj][m][n] = __builtin_amdgcn_mfma_f32_16x16x32_bf16(Bt[n][k], At[m][k], acc[ai][bj][m][n], 0, 0, 0); } } __builtin_amdgcn_s_setprio(0); } while (0)
#define PG8_WAIT_V(n) asm volatile("s_waitcnt vmcnt(" #n ")" ::: "memory")
#define PG8_WAIT_L(n) asm volatile("s_waitcnt lgkmcnt(" #n ")" ::: "memory")
#define PG8_BAR __builtin_amdgcn_s_barrier()
#define PG8_SCHED __builtin_amdgcn_sched_barrier(0)
    Unit cur, nxt; int ui = 0;
    if (!S.next(0, cur)) return;
    f32x4 acc[2][2][4][2];
#pragma unroll
    for (int a = 0; a < 2; ++a)
#pragma unroll
        for (int b = 0; b < 2; ++b)
#pragma unroll
            for (int m = 0; m < 4; ++m)
#pragma unroll
                for (int n = 0; n < 2; ++n) acc[a][b][m][n] = (f32x4){0.f, 0.f, 0.f, 0.f};
    const int scale1 = 0x7f7f7f7f;
    bf16x8 At[4][2], B0[2][2], B1[2][2]; v8i At8[4], B08[2], B18[2];
    unsigned cA = (unsigned)cur.pm * tA + (unsigned)cur.k0 * 2u, cB = (unsigned)cur.pn * tB + (unsigned)cur.k0 * 2u;
    S.a_ready(cur);
    if constexpr (SP2) {
        PG8_STAGE(PG8_SB(0, 0), cB, voffB); PG8_STAGE(PG8_SB(0, 1), cB + hB, voffB); PG8_STAGE(PG8_SA(0, 0), cA, voffA); PG8_STAGE(PG8_SA(0, 1), cA + hA, voffA);
        if (wr == 1) PG8_BAR;
        PG8_WAIT_V(2); PG8_BAR;
        PG8_STAGE(PG8_SB(1, 0), cB + kstep, voffB); PG8_STAGE(PG8_SA(1, 0), cA + kstep, voffA); PG8_STAGE(PG8_SB(1, 1), cB + hB + kstep, voffB);
        PG8_WAIT_V(6); PG8_BAR;
    } else {
        PG8_STAGE(PG8_SB(0, 0), cB, voffB); PG8_STAGE(PG8_SA(0, 0), cA, voffA); PG8_STAGE(PG8_SB(0, 1), cB + hB, voffB); PG8_STAGE(PG8_SA(0, 1), cA + hA, voffA);
        if (wr == 1) PG8_BAR;
        PG8_WAIT_V(4); PG8_BAR;
        PG8_STAGE(PG8_SB(1, 0), cB + kstep, voffB); PG8_STAGE(PG8_SA(1, 0), cA + kstep, voffA); PG8_STAGE(PG8_SB(1, 1), cB + hB + kstep, voffB);
        PG8_WAIT_V(6); PG8_BAR;
    }
    for (;;) {
        const bool has_next = S.next(ui + 1, nxt);
        const unsigned nA = has_next ? (unsigned)nxt.pm * tA + (unsigned)nxt.k0 * 2u : cA, nB = has_next ? (unsigned)nxt.pn * tB + (unsigned)nxt.k0 * 2u : cB;
        const int nt = cur.nt;
        for (int t = 0; t < nt; t += 2) {
            const bool last = (t == nt - 2);
            const unsigned a1 = cA + (unsigned)(t + 1) * kstep;
            const unsigned a2 = last ? nA : cA + (unsigned)(t + 2) * kstep, b2 = last ? nB : cB + (unsigned)(t + 2) * kstep;
            const unsigned a3 = a2 + kstep, b3 = b2 + kstep;
            if (last && has_next) S.a_ready(nxt);
            if constexpr (SP2) {
            PG8_LDB(B0, 0, 0); PG8_LDB(B1, 0, 1); PG8_SCHED; PG8_LDA(At, 0, 0); PG8_STAGE(PG8_SA(1, 1), a1 + hA, voffA);
            PG8_WAIT_V(8); PG8_WAIT_L(0); PG8_BAR; PG8_MMA(0, 0, At, B0); PG8_MMA(0, 1, At, B1); PG8_BAR; PG8_SCHED;
            PG8_LDA(At, 0, 1); PG8_STAGE(PG8_SB(0, 0), b2, voffB); PG8_STAGE(PG8_SB(0, 1), b2 + hB, voffB); PG8_STAGE(PG8_SA(0, 0), a2, voffA);
            PG8_WAIT_V(8); PG8_WAIT_L(0); PG8_BAR; PG8_MMA(1, 0, At, B0); PG8_MMA(1, 1, At, B1); PG8_BAR; PG8_SCHED;
            PG8_LDB(B0, 1, 0); PG8_LDB(B1, 1, 1); PG8_SCHED; PG8_LDA(At, 1, 0); PG8_STAGE(PG8_SA(0, 1), a2 + hA, voffA);
            PG8_WAIT_V(8); PG8_WAIT_L(0); PG8_BAR; PG8_MMA(0, 0, At, B0); PG8_MMA(0, 1, At, B1); PG8_BAR; PG8_SCHED;
            PG8_LDA(At, 1, 1); PG8_STAGE(PG8_SB(1, 0), b3, voffB); PG8_STAGE(PG8_SB(1, 1), b3 + hB, voffB); PG8_STAGE(PG8_SA(1, 0), a3, voffA);
            PG8_WAIT_V(8); PG8_WAIT_L(0); PG8_BAR; PG8_MMA(1, 0, At, B0); PG8_MMA(1, 1, At, B1); PG8_BAR; PG8_SCHED;
            } else {
            PG8_LDB(B0, 0, 0); PG8_SCHED; PG8_LDA(At, 0, 0); PG8_STAGE(PG8_SA(1, 1), a1 + hA, voffA);
            PG8_WAIT_L(8); PG8_BAR; PG8_WAIT_L(0); PG8_MMA(0, 0, At, B0); PG8_BAR; PG8_SCHED;
            PG8_LDB(B1, 0, 1); PG8_STAGE(PG8_SB(0, 0), b2, voffB);
            PG8_BAR; PG8_WAIT_L(0); PG8_MMA(0, 1, At, B1); PG8_BAR;
            PG8_LDA(At, 0, 1); PG8_STAGE(PG8_SA(0, 0), a2, voffA);
            PG8_BAR; PG8_WAIT_L(0); PG8_MMA(1, 0, At, B0); PG8_BAR; PG8_SCHED;
            PG8_STAGE(PG8_SB(0, 1), b2 + hB, voffB);
            PG8_WAIT_V(6); PG8_BAR; PG8_MMA(1, 1, At, B1); PG8_BAR;
            PG8_LDB(B0, 1, 0); PG8_SCHED; PG8_LDA(At, 1, 0); PG8_STAGE(PG8_SA(0, 1), a2 + hA, voffA);
            PG8_WAIT_L(8); PG8_BAR; PG8_WAIT_L(0); PG8_MMA(0, 0, At, B0); PG8_BAR; PG8_SCHED;
            PG8_LDB(B1, 1, 1); PG8_STAGE(PG8_SB(1, 0), b3, voffB);
            PG8_BAR; PG8_WAIT_L(0); PG8_MMA(0, 1, At, B1); PG8_BAR;
            PG8_LDA(At, 1, 1); PG8_STAGE(PG8_SA(1, 0), a3, voffA);
            PG8_BAR; PG8_WAIT_L(0); PG8_MMA(1, 0, At, B0); PG8_BAR; PG8_SCHED;
            PG8_STAGE(PG8_SB(1, 1), b3 + hB, voffB);
            PG8_WAIT_V(6); PG8_BAR; PG8_MMA(1, 1, At, B1); PG8_BAR;
            }
        }
        if constexpr (ALIGN_EPI) { if (wr == 0) PG8_BAR; }
        if constexpr (FP8) asm volatile("s_nop 15\n\ts_nop 15" ::: "memory");
        E(acc, cur, wr, wc, fr, fq); S.done(cur);
        if (!has_next) break;
        if constexpr (!Epi::CARRY) {
#pragma unroll
        for (int a = 0; a < 2; ++a)
#pragma unroll
            for (int b = 0; b < 2; ++b)
#pragma unroll
                for (int m = 0; m < 4; ++m)
#pragma unroll
                    for (int n = 0; n < 2; ++n) acc[a][b][m][n] = (f32x4){0.f, 0.f, 0.f, 0.f};
        }
        cur = nxt; cA = nA; cB = nB; ++ui;
        if constexpr (ALIGN_EPI) { if (wr == 1) PG8_BAR; }
    }
    PG8_WAIT_V(0);
    if constexpr (!ALIGN_EPI) { if (wr == 0) PG8_BAR; }
    PG8_BAR;
#undef PG8_SA
#undef PG8_SB
#undef PG8_STAGE
#undef PG8_LDA
#undef PG8_LDB
#undef PG8_MMA
#undef PG8_WAIT_V
#undef PG8_WAIT_L
#undef PG8_BAR
#undef PG8_SCHED
}

__device__ __forceinline__ u32x4 pack8(const f32x4 a, const f32x4 b) { u32x4 w; w.x = cvt_pk_bf16(a[0], a[1]); w.y = cvt_pk_bf16(a[2], a[3]); w.z = cvt_pk_bf16(b[0], b[1]); w.w = cvt_pk_bf16(b[2], b[3]); return w; }

struct EpiSwiGLU {
    static constexpr bool PERM = true, CARRY = false, FP8 = false;
    bf16* O; int ldo;
    __device__ __forceinline__ void operator()(const f32x4 (&acc)[2][2][4][2], const Unit& u, int wr, int wc, int fr, int fq) const {
        const int row0 = u.pm * BM + wr * 64 + fr, col0 = u.pn * 128 + wc * 32 + 8 * fq;
#pragma unroll
        for (int ai = 0; ai < 2; ++ai)
#pragma unroll
            for (int m = 0; m < 4; ++m) {
                f32x4 v0, v1;
#pragma unroll
                for (int e = 0; e < 4; ++e) { v0[e] = silu_f(acc[ai][0][m][0][e]) * acc[ai][1][m][0][e]; v1[e] = silu_f(acc[ai][0][m][1][e]) * acc[ai][1][m][1][e]; }
                *(u32x4*)(O + (size_t)(row0 + ai * HALF + m * 16) * ldo + col0) = pack8(v0, v1);
            }
    }
};
struct EpiY {
    static constexpr bool PERM = true, CARRY = false, FP8 = false;
    bf16* Y; const float* modl; int gi; float cg;
    __device__ __forceinline__ void operator()(const f32x4 (&acc)[2][2][4][2], const Unit& u, int wr, int wc, int fr, int fq) const {
        const int row0 = u.pm * BM + wr * 64 + fr, col0 = u.pn * BM + wc * 32 + 8 * fq;
        const int s = u.pm < 32 ? 0 : (u.pm < 64 ? 1 : 2);
        const float* gate = modl + (size_t)(s * NMOD + gi) * D;
        f32x4 gv[2][2];
#pragma unroll
        for (int bj = 0; bj < 2; ++bj)
#pragma unroll
            for (int n = 0; n < 2; ++n) gv[bj][n] = *(const f32x4*)(gate + col0 + bj * HALF + 4 * n) * cg;
#pragma unroll
        for (int ai = 0; ai < 2; ++ai)
#pragma unroll
            for (int m = 0; m < 4; ++m) { bf16* rowp = Y + (size_t)(row0 + ai * HALF + m * 16) * D + col0;
#pragma unroll
                for (int bj = 0; bj < 2; ++bj) *(u32x4*)(rowp + bj * HALF) = pack8(gv[bj][0] * acc[ai][bj][m][0], gv[bj][1] * acc[ai][bj][m][1]); }
    }
};
template <bool FP8_> struct EpiIn {
    static constexpr bool PERM = true, CARRY = false, FP8 = FP8_;
    unsigned char* ws; const float* rope; int pn0; float ascale;
    __device__ __forceinline__ void operator()(const f32x4 (&acc)[2][2][4][2], const Unit& u0, int wr, int wc, int fr, int fq) const {
        Unit u; u.pm = u0.pm; u.pn = u0.pn + pn0;
        const int row0 = u.pm * BM + wr * 64 + fr;
        if (u.pn < 16) {
            const bool isq = u.pn < 8; const int head = 2 * (u.pn & 7) + (wc >> 1), rr = wc & 1, i0 = 8 * fq;
            const int colb = head * HD + rr * 64 + i0;
            const bool lat = u.pm < 64;
#pragma unroll
            for (int ai = 0; ai < 2; ++ai)
#pragma unroll
                for (int m = 0; m < 4; ++m) {
                    const int row = row0 + ai * HALF + m * 16;
                    const f32x4 a0 = acc[ai][0][m][0], a1 = acc[ai][0][m][1], b0 = acc[ai][1][m][0], b1 = acc[ai][1][m][1];
                    if (isq || !lat) { bf16* dst = (bf16*)(ws + (isq ? WS_QP : WS_KB)) + (size_t)row * AW + colb; *(u32x4*)dst = pack8(a0, a1); *(u32x4*)(dst + 32) = pack8(b0, b1); }
                    if (lat) {
                        const int t = row & (SEQ - 1), pos = rr ? (t & 63) : (t >> 6);
                        const float* cp = rope + pos * 32 + i0; const float* sp = cp + 128 * 32;
                        const f32x4 c0 = *(const f32x4*)cp, c1 = *(const f32x4*)(cp + 4), s0 = *(const f32x4*)sp, s1 = *(const f32x4*)(sp + 4);
                        const f32x4 o0 = a0 * c0 - b0 * s0, o1 = a1 * c1 - b1 * s1, p0 = a0 * s0 + b0 * c0, p1 = a1 * s1 + b1 * c1;
                        bf16* dst = (bf16*)(ws + (isq ? WS_QR : WS_KB)) + (size_t)row * AW + colb; *(u32x4*)dst = pack8(o0, o1); *(u32x4*)(dst + 32) = pack8(p0, p1);
                    }
                }
            return;
        }
        size_t boff; int ld, colt, act;
        if (u.pn < 24) { boff = WS_VB; ld = AW; colt = (u.pn - 16) * BM; act = 0; }
        else if (u.pn < 32) { boff = WS_ZB; ld = 2048; colt = (u.pn - 24) * BM; act = 1; }
        else if (u.pn < 36) { boff = WS_US; ld = SSW; colt = (u.pn - 32) * BM; act = 0; }
        else { boff = WS_GB; ld = 3 * D; colt = (u.pn - 36) * BM; act = 2; }
        bf16* base = (bf16*)(ws + boff);
        const int col0 = colt + wc * 32 + 8 * fq;
#pragma unroll
        for (int ai = 0; ai < 2; ++ai)
#pragma unroll
            for (int m = 0; m < 4; ++m) { bf16* rowp = base + (size_t)(row0 + ai * HALF + m * 16) * ld + col0;
#pragma unroll
                for (int bj = 0; bj < 2; ++bj) { f32x4 v0 = acc[ai][bj][m][0], v1 = acc[ai][bj][m][1];
                    if (act == 1) {
#pragma unroll
                        for (int e = 0; e < 4; ++e) { v0[e] = gelu_tanh_f(v0[e]); v1[e] = gelu_tanh_f(v1[e]); } }
                    else if (act == 2) {
#pragma unroll
                        for (int e = 0; e < 4; ++e) { v0[e] = fast_sigmoid(v0[e] * ascale); v1[e] = fast_sigmoid(v1[e] * ascale); } }
                    *(u32x4*)(rowp + bj * HALF) = pack8(v0, v1); } }
    }
};
__device__ __forceinline__ void unpack8(const u32x4 w, f32x4& a, f32x4& b) { a = (f32x4){bf_lo(w.x), bf_hi(w.x), bf_lo(w.y), bf_hi(w.y)}; b = (f32x4){bf_lo(w.z), bf_hi(w.z), bf_lo(w.w), bf_hi(w.w)}; }
struct EpiGLU {
    static constexpr bool PERM = true, CARRY = false, FP8 = false;
    const bf16* YS; bf16* O; const float* bias;
    __device__ __forceinline__ void operator()(const f32x4 (&acc)[2][2][4][2], const Unit& u, int wr, int wc, int fr, int fq) const {
        const int row0 = u.pm * BM + wr * 64 + fr, col0 = u.pn * BM + wc * 32 + 8 * fq;
        const f32x4 bv[2][2] = {{*(const f32x4*)(bias + col0), *(const f32x4*)(bias + col0 + 4)}, {*(const f32x4*)(bias + col0 + HALF), *(const f32x4*)(bias + col0 + HALF + 4)}};
        constexpr int PD = 7;
        u32x4 yr[PD + 1];
#define EG_ROW(s_) ((size_t)(row0 + ((s_) >> 3) * HALF + (((s_) >> 1) & 3) * 16))
#define EG_LOAD(s_) yr[(s_) % (PD + 1)] = *(const u32x4*)(YS + EG_ROW(s_) * SSW + col0 + ((s_) & 1) * HALF)
#pragma unroll
        for (int s = 0; s < PD; ++s) EG_LOAD(s);
#pragma unroll
        for (int s = 0; s < 16; ++s) {
            if (s + PD < 16) EG_LOAD(s + PD);
            const int ai = s >> 3, m = (s >> 1) & 3, bj = s & 1;
            f32x4 y0, y1; unpack8(yr[s % (PD + 1)], y0, y1);
            f32x4 v0 = acc[ai][bj][m][0] + bv[bj][0], v1 = acc[ai][bj][m][1] + bv[bj][1];
#pragma unroll
            for (int e = 0; e < 4; ++e) { v0[e] = y0[e] * fast_sigmoid(v0[e]); v1[e] = y1[e] * fast_sigmoid(v1[e]); }
            *(u32x4*)(O + EG_ROW(s) * D + col0 + bj * HALF) = pack8(v0, v1);
            asm volatile("" ::: "memory");
        }
#undef EG_LOAD
#undef EG_ROW
    }
};
#ifndef MERGE_PD
#define MERGE_PD 3
#endif
struct EpiMerge1 {
    static constexpr bool PERM = true, CARRY = true, FP8 = false;
    const bf16* GB; bf16* MG;
    __device__ __forceinline__ void operator()(f32x4 (&acc)[2][2][4][2], const Unit& u, int wr, int wc, int fr, int fq) const {
        const int row0 = u.pm * BM + wr * 64 + fr, col0 = u.pn * BM + wc * 32 + 8 * fq;
        const bool fin = u.seg == 2;
        const int noff = u.seg * D;
        const float keep = fin ? 0.f : 1.f;
        constexpr int PD = MERGE_PD;
        u32x4 nwr[PD + 1], dwr[PD + 1];
#define EM_ROW(s_) ((size_t)(row0 + ((s_) >> 3) * HALF + (((s_) >> 1) & 3) * 16))
#define EM_LOAD(s_) do { const bf16* gp_ = GB + EM_ROW(s_) * (3 * D) + noff + col0 + ((s_) & 1) * HALF; nwr[(s_) % (PD + 1)] = *(const u32x4*)gp_; dwr[(s_) % (PD + 1)] = *(const u32x4*)(gp_ + (fin ? 0 : D)); } while (0)
#pragma unroll
        for (int s = 0; s < PD; ++s) EM_LOAD(s);
#pragma unroll
        for (int s = 0; s < 16; ++s) {
            if (s + PD < 16) EM_LOAD(s + PD);
            const int ai = s >> 3, m = (s >> 1) & 3, bj = s & 1;
            f32x4 n0, n1, d0, d1; unpack8(nwr[s % (PD + 1)], n0, n1); unpack8(dwr[s % (PD + 1)], d0, d1);
            f32x4 r0, r1;
#pragma unroll
            for (int e = 0; e < 4; ++e) { const float q0 = __builtin_amdgcn_rcpf(fmaxf(d0[e], 1e-30f)), q1 = __builtin_amdgcn_rcpf(fmaxf(d1[e], 1e-30f));
                r0[e] = fmaxf(n0[e], 1e-30f) * (fin ? 1.0f : q0); r1[e] = fmaxf(n1[e], 1e-30f) * (fin ? 1.0f : q1); }
            const f32x4 v0 = acc[ai][bj][m][0] * r0, v1 = acc[ai][bj][m][1] * r1;
            if (fin) *(u32x4*)(MG + EM_ROW(s) * D + col0 + bj * HALF) = pack8(v0, v1);
            acc[ai][bj][m][0] = v0 * keep; acc[ai][bj][m][1] = v1 * keep;
            asm volatile("" : "+v"(acc[ai][bj][m][0]), "+v"(acc[ai][bj][m][1]) :: "memory");
        }
#undef EM_LOAD
#undef EM_ROW
    }
};
}
using pg8::unpack8; using pg8::pack8;

#define XB_TMO      128
#define XB_XCNT(j)  (256  + 64 * (j))
#define XB_XSUB(j)  (1280 + 64 * (j))
#define XB_XGEN(j)  (2304 + 64 * (j))
#define XB_TOP      3328
#define XB_TOPGEN   3392
#define XCD_BAR_WORDS 3456
#define XB_SPIN_CAP (1u << 18)
__device__ __forceinline__ unsigned xb_ld(unsigned* p)              { return __hip_atomic_load(p, __ATOMIC_RELAXED, __HIP_MEMORY_SCOPE_AGENT); }
__device__ __forceinline__ unsigned xb_add(unsigned* p, unsigned v) { return __hip_atomic_fetch_add(p, v, __ATOMIC_RELAXED, __HIP_MEMORY_SCOPE_AGENT); }
__device__ __forceinline__ unsigned xb_xcc_id() { return (unsigned)__builtin_amdgcn_s_getreg((3 << 11) | 20) & 0xFu; }
#define XB_SPIN(cond, bar) do { unsigned _sp = 0; while (cond) { __builtin_amdgcn_s_sleep(1); \
    if ((++_sp & 255u) == 0u) { if (xb_ld(&(bar)[XB_TMO])) break; if (_sp > XB_SPIN_CAP) { atomicAdd(&(bar)[XB_TMO], 1u); break; } } } } while (0)
struct XcdBarrier { unsigned* bar; unsigned x; volatile LAS unsigned* st; };
__device__ __forceinline__ XcdBarrier xcd_barrier_post(unsigned* bar, volatile LAS unsigned* st) {
    XcdBarrier b; b.bar = bar; b.x = xb_xcc_id(); b.st = st;
    if (threadIdx.x == 0) (void)xb_add(&bar[XB_XCNT(b.x)], 1u);
    return b;
}
__device__ __forceinline__ void xcd_barrier_complete(unsigned* bar, unsigned x, unsigned& nloc, unsigned& nx) {
    const unsigned G = gridDim.x * gridDim.y * gridDim.z;
    unsigned sum, cnt, mine, sp = 0u;
    for (;;) {
        sum = 0u; cnt = 0u; mine = 0u;
#pragma unroll
        for (unsigned j = 0; j < 16; ++j) { const unsigned c = xb_ld(&bar[XB_XCNT(j)]); sum += c; cnt += (c > 0u) ? 1u : 0u; mine = (j == x) ? c : mine; }
        if (sum == G) break;
        __builtin_amdgcn_s_sleep(1);
        if ((++sp & 255u) == 0u) { if (xb_ld(&bar[XB_TMO])) break; if (sp > XB_SPIN_CAP) { atomicAdd(&bar[XB_TMO], 1u); break; } }
    }
    nloc = mine > 0u ? mine : 1u; nx = cnt > 0u ? cnt : 1u;
}
__device__ __forceinline__ void xcd_barrier(const XcdBarrier& b) {
    asm volatile("s_waitcnt vmcnt(0)" ::: "memory");
    __syncthreads();
    if (threadIdx.x == 0) {
        unsigned* bar = b.bar;
        __builtin_amdgcn_s_waitcnt(0);
        unsigned nloc = b.st[0], nx = b.st[1];
        if (nloc == 0u) { xcd_barrier_complete(bar, b.x, nloc, nx); b.st[0] = nloc; b.st[1] = nx; }
        const unsigned old = xb_add(&bar[XB_XSUB(b.x)], 1u);
        const unsigned gen = old / nloc;
        if (old + 1u == (gen + 1u) * nloc) {
            __builtin_amdgcn_fence(__ATOMIC_RELEASE, "agent");
            asm volatile("s_waitcnt vmcnt(0)" ::: "memory");
            const unsigned og = xb_add(&bar[XB_TOP], 1u);
            const unsigned tg = og / nx;
            if (og + 1u == (tg + 1u) * nx) xb_add(&bar[XB_TOPGEN], 1u);
            else XB_SPIN(xb_ld(&bar[XB_TOPGEN]) == tg, bar);
            __builtin_amdgcn_fence(__ATOMIC_ACQUIRE, "agent");
            xb_add(&bar[XB_XGEN(b.x)], 1u);
            asm volatile("s_waitcnt vmcnt(0)" ::: "memory");
        } else {
            XB_SPIN(xb_ld(&bar[XB_XGEN(b.x)]) == gen, bar);
            __builtin_amdgcn_fence(__ATOMIC_ACQUIRE, "agent");
            asm volatile("s_waitcnt vmcnt(0)" ::: "memory");
        }
    }
    __syncthreads();
}

__device__ __forceinline__ float wave_sum(float v) {
#pragma unroll
    for (int o = 1; o < 64; o <<= 1) v += __shfl_xor(v, o);
    return v;
}
#define MFMA32(a, b, c) __builtin_amdgcn_mfma_f32_32x32x16_bf16((a), (b), (c), 0, 0, 0)
#define MFMA16(a, b, c) __builtin_amdgcn_mfma_f32_16x16x32_bf16((a), (b), (c), 0, 0, 0)
#define PACK_STEP(dst, x, s) do { u32x4 _p; asm volatile("v_cvt_pk_bf16_f32 %0, %4, %5\n\tv_cvt_pk_bf16_f32 %1, %6, %7\n\tv_cvt_pk_bf16_f32 %2, %8, %9\n\tv_cvt_pk_bf16_f32 %3, %10, %11\n\ts_nop 1" \
        : "=&v"(_p[0]), "=&v"(_p[1]), "=&v"(_p[2]), "=&v"(_p[3]) \
        : "v"(x[8 * (s)]), "v"(x[8 * (s) + 1]), "v"(x[8 * (s) + 2]), "v"(x[8 * (s) + 3]), "v"(x[8 * (s) + 4]), "v"(x[8 * (s) + 5]), "v"(x[8 * (s) + 6]), "v"(x[8 * (s) + 7])); \
        dst = __builtin_bit_cast(bf16x8, _p); } while (0)
template <int OFF_LO, int OFF_HI> __device__ __forceinline__ bf16x8 tr_read2(unsigned base) {
    s16x4 lo, hi;
    asm volatile("ds_read_b64_tr_b16 %0, %2 offset:%3\n\tds_read_b64_tr_b16 %1, %2 offset:%4\n\ts_waitcnt lgkmcnt(0)" : "=&v"(lo), "=&v"(hi) : "v"(base), "i"(OFF_LO), "i"(OFF_HI) : "memory");
    return __builtin_shufflevector(lo, hi, 0, 1, 2, 3, 4, 5, 6, 7);
}
__device__ __forceinline__ unsigned lds_addr(LAS unsigned char* p) { return (unsigned)(__UINTPTR_TYPE__)p; }

__device__ __forceinline__ void transpose_item(const float* W, int N, bf16* WT, int ldt, int k0, int src_n0, int dst_n0, LAS float* scr, int lane) {
#pragma unroll
    for (int i = 0; i < 32; ++i) { const int kk = 2 * i + (lane >> 5); scr[kk * 33 + (lane & 31)] = __builtin_nontemporal_load(W + (size_t)(k0 + kk) * N + src_n0 + (lane & 31)); }
    LDS_WAIT();
    const int c = lane & 7;
#pragma unroll
    for (int j = 0; j < 4; ++j) { const int n = (lane >> 3) + 8 * j; const LAS float* s = scr + (8 * c) * 33 + n;
        u32x4 o; o.x = cvt_pk_bf16(s[0 * 33], s[1 * 33]); o.y = cvt_pk_bf16(s[2 * 33], s[3 * 33]); o.z = cvt_pk_bf16(s[4 * 33], s[5 * 33]); o.w = cvt_pk_bf16(s[6 * 33], s[7 * 33]);
        *(u32x4*)(WT + (size_t)(dst_n0 + n) * ldt + k0 + 8 * c) = o; }
    LDS_WAIT();
}
__device__ __forceinline__ void transpose_item_fp8(const float* W, int N, unsigned char* WT8, int ldt, int k0, int src_n0, int dst_n0, LAS float* scr, int lane) {
#pragma unroll
    for (int i = 0; i < 32; ++i) { const int kk = 2 * i + (lane >> 5); scr[kk * 33 + (lane & 31)] = __builtin_nontemporal_load(W + (size_t)(k0 + kk) * N + src_n0 + (lane & 31)); }
    LDS_WAIT();
    const int c = lane & 7;
#pragma unroll
    for (int j = 0; j < 4; ++j) { const int n = (lane >> 3) + 8 * j; const LAS float* s = scr + (8 * c) * 33 + n;
        float e[8];
#pragma unroll
        for (int q = 0; q < 8; ++q) e[q] = fminf(fmaxf(s[q * 33] * 2048.f, -448.f), 448.f);
        int w0 = __builtin_amdgcn_cvt_pk_fp8_f32(e[0], e[1], 0, false); w0 = __builtin_amdgcn_cvt_pk_fp8_f32(e[2], e[3], w0, true);
        int w1 = __builtin_amdgcn_cvt_pk_fp8_f32(e[4], e[5], 0, false); w1 = __builtin_amdgcn_cvt_pk_fp8_f32(e[6], e[7], w1, true);
        *(u32x2*)(WT8 + (size_t)(dst_n0 + n) * ldt + k0 + 8 * c) = (u32x2){(unsigned)w0, (unsigned)w1}; }
    LDS_WAIT();
}
__device__ __forceinline__ int src_block(int mode, int nb) {
    if (mode == 1) { const int pn = nb >> 3, wb = nb & 7, bj = wb >> 2, jb = wb & 3; return bj * 192 + 4 * pn + jb; }
    if (mode == 2 && nb < 128) { const int tile = nb >> 3, wb = nb & 7, bj = wb >> 2, hh = (wb & 3) >> 1, rr = wb & 1; const int base = tile < 8 ? 0 : AW, head = 2 * (tile & 7) + hh; return (base + head * HD + rr * 64 + 32 * bj) >> 5; }
    return nb;
}
__device__ __forceinline__ void transpose_matrix_items(const float* W, int K, int N, bf16* WT, int ldt, int mode, int it, LAS float* scr, int lane, unsigned char* WT8 = nullptr) {
    const int nblk = N / 32, kb = it / nblk, nb = it % nblk;
    if (mode == 2 && nb >= 288) { transpose_item_fp8(W, N, WT8, K, 64 * kb, 32 * nb, 32 * (nb - 288), scr, lane); return; }
    transpose_item(W, N, WT, ldt, 64 * kb, 32 * src_block(mode, nb), 32 * nb, scr, lane);
}

struct Args { const float* in[32]; float* out; unsigned char* ws; int ph_lo, ph_hi; };

__device__ __forceinline__ void p0_tables(const Args& args, int gtid, int gthreads) {
    unsigned char* ws = args.ws;
    float* rope = (float*)(ws + WS_ROPE);
    for (int i = gtid; i < 128 * 32; i += gthreads) { const int pos = i >> 5, j = i & 31; const float inv = exp2f(-(float)j * (13.287712379549449f / 32.0f)); const float ang = (float)pos * inv; rope[i] = cosf(ang); rope[128 * 32 + i] = sinf(ang); }
    const float *lam_re = as_global(args.in[18]), *lam_im = as_global(args.in[19]), *log_dt = as_global(args.in[20]), *b_re = as_global(args.in[21]), *b_im = as_global(args.in[22]), *c_re = as_global(args.in[23]), *c_im = as_global(args.in[24]);
    f32x4* SA = (f32x4*)(ws + WS_SA); bf16* SBB = (bf16*)(ws + WS_SBB); bf16* SC = (bf16*)(ws + WS_SC);
    for (int i = gtid; i < DEPTH * 2 * NG * NP; i += gthreads) {
        const int p = i & 63, ldg = i >> 6;
        const float dt = expf(log_dt[ldg]), lr = lam_re[i], li = lam_im[i];
        const float x = lr * dt, y = li * dt, mag = expf(x), cs = cosf(y), sn = sinf(y), sh = sinf(0.5f * y);
        const float ar = mag * cs, ai = mag * sn, re1 = expm1f(x) * cs - 2.0f * sh * sh, den = lr * lr + li * li;
        const float fr = (re1 * lr + ai * li) / den, fi = (ai * lr - re1 * li) / den;
        float tr = ar, ti = ai;
#pragma unroll
        for (int q = 0; q < 7; ++q) { const float nr = tr * tr - ti * ti, ni = 2.0f * tr * ti; tr = nr; ti = ni; }
        SA[i] = (f32x4){ar, ai, tr, ti};
        { bf16* o_re = SBB + ((size_t)ldg * 128 + p) * SG; bf16* o_im = o_re + 64 * SG;
#pragma unroll
          for (int ch = 0; ch < SG; ch += 2) { const float br0 = b_re[(size_t)i * SG + ch], bi0 = b_im[(size_t)i * SG + ch], br1 = b_re[(size_t)i * SG + ch + 1], bi1 = b_im[(size_t)i * SG + ch + 1];
              *(unsigned*)(o_re + ch) = cvt_pk_bf16(fr * br0 - fi * bi0, fr * br1 - fi * bi1); *(unsigned*)(o_im + ch) = cvt_pk_bf16(fr * bi0 + fi * br0, fr * bi1 + fi * br1); } }
#pragma unroll
        for (int ch = 0; ch < SG; ++ch) { const size_t ci = ((size_t)ldg * SG + ch) * NP + p; const size_t o = ((size_t)ldg * SG + ch) * 128;
            SC[o + p] = (bf16)(cvt_pk_bf16(c_re[ci], 0.f) & 0xffffu); SC[o + 64 + p] = (bf16)(cvt_pk_bf16(-c_im[ci], 0.f) & 0xffffu); }
    }
    const float* gws = as_global(args.in[16]); bf16* GWS = (bf16*)(ws + WS_GWS);
    for (int i = gtid; i < DEPTH * 8 * 128 * 128 / 2; i += gthreads) ((unsigned*)GWS)[i] = cvt_pk_bf16(gws[2 * i], gws[2 * i + 1]);
}

__device__ __forceinline__ void p0_mod(const Args& args, LAS unsigned char* lds, int wid, int lane, int tid, int G, int bx) {
    LAS float* sv = (LAS float*)lds;
    LAS float* red = (LAS float*)(lds + 49152);
    const float *c = as_global(args.in[1]), *cctx = as_global(args.in[3]);
    for (int i = tid; i < 3 * D; i += 512) { const float v = i < 2 * D ? c[i] : cctx[i - 2 * D]; sv[i] = silu_f(v); }
    __syncthreads();
    float* modv = (float*)(args.ws + WS_MOD);
    constexpr int NCB = NMODC / 256;
    for (int u = bx; u < DEPTH * NCB; u += G) {
        const int l = u / NCB, cb = u % NCB;
        const float* W = as_global(args.in[4]) + (size_t)l * D * NMODC + (size_t)cb * 256 + 4 * lane;
        f32x4 a0 = {0.f, 0.f, 0.f, 0.f}, a1 = a0, a2 = a0;
        const int kbeg = wid * 512;
        for (int k = kbeg; k < kbeg + 512; k += 8) {
            f32x4 w[8];
#pragma unroll
            for (int i = 0; i < 8; ++i) w[i] = __builtin_nontemporal_load((const f32x4*)(W + (size_t)(k + i) * NMODC));
#pragma unroll
            for (int i = 0; i < 8; ++i) { a0 += w[i] * sv[k + i]; a1 += w[i] * sv[D + k + i]; a2 += w[i] * sv[2 * D + k + i]; }
        }
        *(LAS f32x4*)(red + (wid * 3 + 0) * 256 + 4 * lane) = a0; *(LAS f32x4*)(red + (wid * 3 + 1) * 256 + 4 * lane) = a1; *(LAS f32x4*)(red + (wid * 3 + 2) * 256 + 4 * lane) = a2;
        __syncthreads();
        for (int o = tid; o < 768; o += 512) { const int s = o >> 8, cc = o & 255; float sum = 0.f;
#pragma unroll
            for (int w8 = 0; w8 < 8; ++w8) sum += red[(w8 * 3 + s) * 256 + cc];
            modv[(size_t)(l * 3 + s) * NMODC + cb * 256 + cc] = sum + as_global(args.in[5])[(size_t)l * NMODC + cb * 256 + cc]; }
        __syncthreads();
    }
}

__device__ __forceinline__ void p0_weights(const Args& args, LAS unsigned char* lds, int wid, int lane, int G, int bx) {
    LAS float* scr = (LAS float*)(lds + wid * 16384);
    const int gw = bx * 8 + wid, NGW = G * 8;
    constexpr int I_FI = (D / 64) * (2 * DFF / 32), I_FO = (DFF / 64) * (D / 32), I_IN = (D / 64) * (NIN / 32), I_GL = (SSW / 64) * (SSW / 32), I_PA = (GMW / 64) * (D / 32), I_PB = (AW / 64) * (D / 32), I_PC = (SSW / 64) * (D / 32), I_O = (D / 64) * (D / 32);
    constexpr int PER_L = 2 * I_FI + 2 * I_FO + I_IN + I_GL + I_PA + I_PB + I_PC + I_O;
    constexpr int TOTAL = DEPTH * PER_L, MODU = (D * 256 * 4) / (12 * 1024) / 8;
    const int nheavy = (DEPTH * (NMODC / 256) > G && DEPTH * (NMODC / 256) < 2 * G) ? DEPTH * (NMODC / 256) - G : 0;
    const int X = nheavy > 0 && TOTAL > MODU * 8 * (G - nheavy) ? TOTAL - MODU * 8 * (G - nheavy) : TOTAL;
    for (int pass = 0; pass < 2; ++pass) {
        int it0, step;
        if (pass == 0) { it0 = gw; step = NGW; } else { if (bx < nheavy) break; it0 = X + (bx - nheavy) * 8 + wid; step = (G - nheavy) * 8; }
        const int itend = pass == 0 ? X : TOTAL;
    for (int it = it0; it < itend; it += step) {
        const int l = it / PER_L; int r = it % PER_L;
        unsigned char* wl = args.ws + WS_W + (size_t)l * LW_BYTES;
        if (r < I_FI) { transpose_matrix_items(as_global(args.in[8]) + (size_t)l * D * 2 * DFF, D, 2 * DFF, (bf16*)(wl + LW_W1IN), D, 1, r, scr, lane); continue; } r -= I_FI;
        if (r < I_FO) { transpose_matrix_items(as_global(args.in[9]) + (size_t)l * DFF * D, DFF, D, (bf16*)(wl + LW_W1OUT), DFF, 0, r, scr, lane); continue; } r -= I_FO;
        if (r < I_FI) { transpose_matrix_items(as_global(args.in[10]) + (size_t)l * D * 2 * DFF, D, 2 * DFF, (bf16*)(wl + LW_W2IN), D, 1, r, scr, lane); continue; } r -= I_FI;
        if (r < I_FO) { transpose_matrix_items(as_global(args.in[11]) + (size_t)l * DFF * D, DFF, D, (bf16*)(wl + LW_W2OUT), DFF, 0, r, scr, lane); continue; } r -= I_FO;
        if (r < I_IN) { transpose_matrix_items(as_global(args.in[12]) + (size_t)l * D * NIN, D, NIN, (bf16*)(wl + LW_WIN), D, 2, r, scr, lane, wl + LW_W8); continue; } r -= I_IN;
        if (r < I_GL) { transpose_matrix_items(as_global(args.in[26]) + (size_t)l * SSW * SSW, SSW, SSW, (bf16*)(wl + LW_WGLU), SSW, 0, r, scr, lane); continue; } r -= I_GL;
        if (r < I_PA) { transpose_matrix_items(as_global(args.in[28]) + (size_t)l * GMW * D, GMW, D, (bf16*)(wl + LW_WCAT), D, 0, r, scr, lane); continue; } r -= I_PA;
        if (r < I_PB) { transpose_matrix_items(as_global(args.in[29]) + (size_t)l * AW * D, AW, D, (bf16*)(wl + LW_WCAT) + GMW, D, 0, r, scr, lane); continue; } r -= I_PB;
        if (r < I_PC) { transpose_matrix_items(as_global(args.in[30]) + (size_t)l * SSW * D, SSW, D, (bf16*)(wl + LW_WCAT) + GMW + AW, D, 0, r, scr, lane); continue; } r -= I_PC;
        transpose_matrix_items(as_global(args.in[31]) + (size_t)l * D * D, D, D, (bf16*)(wl + LW_WO), D, 0, r, scr, lane);
    }
    }
}

__device__ __forceinline__ void thin_phase(int mode, const float* xin, const float* cin, float* X, const bf16* Y, const float* lng, const float* lnb, const float* modl, int sh_i, int sc_i, bf16* H, float* outp, int mrows, int gw, int NGW, int lane, LAS float* vl, int tid, unsigned char* H8 = nullptr, int row_lo = 0) {
    for (int i = tid; i < D / 4; i += 512) { const int c4 = 4 * i;
        if (mode != 0) { *(LAS f32x4*)(vl + c4) = *(const f32x4*)(lng + c4); *(LAS f32x4*)(vl + D + c4) = *(const f32x4*)(lnb + c4); }
        if (mode != 2) {
#pragma unroll
            for (int sx = 0; sx < 3; ++sx) { *(LAS f32x4*)(vl + (2 + sx) * D + c4) = *(const f32x4*)(modl + (size_t)(sx * NMOD + sh_i) * D + c4); *(LAS f32x4*)(vl + (5 + sx) * D + c4) = *(const f32x4*)(modl + (size_t)(sx * NMOD + sc_i) * D + c4) + 1.0f; } } }
    __syncthreads();
    if (row_lo + gw >= mrows) return;
    f32x4 v[16]; u32x2 y[16];
#define THIN_LOAD(dst, dsty, r) do { if (xin) { const float* src_ = (r) < ML ? xin + (size_t)(r) * D : cin + (size_t)((r) - ML) * D; \
        _Pragma("unroll") for (int j = 0; j < 16; ++j) dst[j] = __builtin_nontemporal_load((const f32x4*)(src_ + 256 * j + 4 * lane)); } \
        else { const unsigned* src_ = (const unsigned*)X + (size_t)(r) * (9 * D / 16); unsigned w_[37]; w_[36] = 0u; \
        _Pragma("unroll") for (int g = 0; g < 9; ++g) { const u32x4 t_ = __builtin_nontemporal_load((const u32x4*)(src_ + 256 * g + 4 * lane)); w_[4 * g] = t_.x; w_[4 * g + 1] = t_.y; w_[4 * g + 2] = t_.z; w_[4 * g + 3] = t_.w; } \
        _Pragma("unroll") for (int e = 0; e < 64; ++e) { const int lo_ = (18 * e) >> 5, sh_ = (18 * e) & 31; \
            const unsigned f_ = sh_ == 0 ? w_[lo_] : (sh_ + 18 <= 32 ? (w_[lo_] >> sh_) : __builtin_amdgcn_alignbit(w_[lo_ + 1], w_[lo_], sh_)); dst[e >> 2][e & 3] = __uint_as_float(f_ << 14); } } \
        if (mode != 0) { _Pragma("unroll") for (int j = 0; j < 16; ++j) dsty[j] = __builtin_nontemporal_load((const u32x2*)(Y + (size_t)(r) * D + 256 * j + 4 * lane)); } } while (0)
    for (int row = row_lo + gw; row < mrows; row += NGW) {
        THIN_LOAD(v, y, row);
        if (mode != 0) {
            float s = 0.f;
#pragma unroll
            for (int j = 0; j < 16; ++j) { v[j] = v[j] * ALPHA + (f32x4){bf_lo(y[j].x), bf_hi(y[j].x), bf_lo(y[j].y), bf_hi(y[j].y)}; s += (v[j][0] + v[j][1]) + (v[j][2] + v[j][3]); }
            const float mean = wave_sum(s) * (1.0f / D); float q = 0.f;
#pragma unroll
            for (int j = 0; j < 16; ++j) { v[j] = v[j] - mean; q += (v[j][0] * v[j][0] + v[j][1] * v[j][1]) + (v[j][2] * v[j][2] + v[j][3] * v[j][3]); }
            const float rstd = 1.0f / sqrtf(wave_sum(q) * (1.0f / D) + LN_EPS);
#pragma unroll
            for (int j = 0; j < 16; ++j) { const f32x4 g = *(const LAS f32x4*)(vl + 256 * j + 4 * lane), b = *(const LAS f32x4*)(vl + D + 256 * j + 4 * lane); v[j] = v[j] * rstd * g + b; }
            if (mode == 2) { float* dst = outp + (size_t)row * D;
#pragma unroll
                for (int j = 0; j < 16; ++j) __builtin_nontemporal_store(v[j], (f32x4*)(dst + 256 * j + 4 * lane)); }
            else { unsigned* dst = (unsigned*)X + (size_t)row * (9 * D / 16);
                unsigned w_[37];
#pragma unroll
                for (int k = 0; k < 37; ++k) w_[k] = 0u;
#pragma unroll
                for (int e = 0; e < 64; ++e) { const int lo_ = (18 * e) >> 5, sh_ = (18 * e) & 31; const unsigned f_ = (__float_as_uint(v[e >> 2][e & 3]) + 0x2000u) >> 14;
                    w_[lo_] |= f_ << sh_; if (sh_ + 18 > 32) w_[lo_ + 1] |= f_ >> (32 - sh_); }
#pragma unroll
                for (int g = 0; g < 9; ++g) { u32x4 t_; t_.x = w_[4 * g]; t_.y = w_[4 * g + 1]; t_.z = w_[4 * g + 2]; t_.w = w_[4 * g + 3]; __builtin_nontemporal_store(t_, (u32x4*)(dst + 256 * g + 4 * lane)); } }
        }
        if (mode != 2) {
            float s = 0.f;
#pragma unroll
            for (int j = 0; j < 16; ++j) s += (v[j][0] + v[j][1]) + (v[j][2] + v[j][3]);
            const float mean = wave_sum(s) * (1.0f / D); float q = 0.f;
#pragma unroll
            for (int j = 0; j < 16; ++j) { v[j] = v[j] - mean; q += (v[j][0] * v[j][0] + v[j][1] * v[j][1]) + (v[j][2] * v[j][2] + v[j][3] * v[j][3]); }
            const float rstd = 1.0f / sqrtf(wave_sum(q) * (1.0f / D) + LN_EPS);
            const int sidx = row < SEQ ? 0 : (row < ML ? 1 : 2);
            const LAS float* shp = vl + (2 + sidx) * D; const LAS float* scp = vl + (5 + sidx) * D;
#pragma unroll
            for (int j = 0; j < 16; ++j) { const f32x4 sh = *(const LAS f32x4*)(shp + 256 * j + 4 * lane), sc = *(const LAS f32x4*)(scp + 256 * j + 4 * lane);
                const f32x4 h = v[j] * rstd * sc + sh; u32x2 w; w.x = cvt_pk_bf16(h[0], h[1]); w.y = cvt_pk_bf16(h[2], h[3]);
                *(u32x2*)(H + (size_t)row * D + 256 * j + 4 * lane) = w;
                if (H8) { const f32x4 q = __builtin_elementwise_min(__builtin_elementwise_max(h * 8.f, (f32x4){-448.f, -448.f, -448.f, -448.f}), (f32x4){448.f, 448.f, 448.f, 448.f});
                    int w8 = __builtin_amdgcn_cvt_pk_fp8_f32(q[0], q[1], 0, false); w8 = __builtin_amdgcn_cvt_pk_fp8_f32(q[2], q[3], w8, true); *(unsigned*)(H8 + (size_t)row * D + 256 * j + 4 * lane) = (unsigned)w8; } }
        }
    }
#undef THIN_LOAD
}

constexpr int AT_KP = 272, AT_VP = 320, AT_VOFF = 64 * AT_KP, AT_BUF = AT_VOFF + 64 * AT_VP, AT_BOFF = 2 * AT_BUF + 256;
__device__ __forceinline__ int clampi(int v, int lo, int hi) { return v < lo ? lo : (v > hi ? hi : v); }
template <int OFF> __device__ __forceinline__ void tr_read_v4(unsigned base, bf16x8 (&f)[4]) {
    s16x4 l0, h0, l1, h1, l2, h2, l3, h3;
    asm volatile("ds_read_b64_tr_b16 %0, %8 offset:%9\n\tds_read_b64_tr_b16 %1, %8 offset:%10\n\tds_read_b64_tr_b16 %2, %8 offset:%11\n\tds_read_b64_tr_b16 %3, %8 offset:%12\n\t"
                 "ds_read_b64_tr_b16 %4, %8 offset:%13\n\tds_read_b64_tr_b16 %5, %8 offset:%14\n\tds_read_b64_tr_b16 %6, %8 offset:%15\n\tds_read_b64_tr_b16 %7, %8 offset:%16\n\ts_waitcnt lgkmcnt(0)"
                 : "=&v"(l0), "=&v"(h0), "=&v"(l1), "=&v"(h1), "=&v"(l2), "=&v"(h2), "=&v"(l3), "=&v"(h3)
                 : "v"(base), "i"(OFF), "i"(OFF + 8 * AT_VP), "i"(OFF + 64), "i"(OFF + 8 * AT_VP + 64), "i"(OFF + 128), "i"(OFF + 8 * AT_VP + 128), "i"(OFF + 192), "i"(OFF + 8 * AT_VP + 192) : "memory");
    f[0] = __builtin_shufflevector(l0, h0, 0, 1, 2, 3, 4, 5, 6, 7); f[1] = __builtin_shufflevector(l1, h1, 0, 1, 2, 3, 4, 5, 6, 7);
    f[2] = __builtin_shufflevector(l2, h2, 0, 1, 2, 3, 4, 5, 6, 7); f[3] = __builtin_shufflevector(l3, h3, 0, 1, 2, 3, 4, 5, 6, 7);
}
__device__ __forceinline__ void attn_unit(LAS unsigned char* lds, const bf16* QP, const bf16* QR, const bf16* KB, const bf16* VB, bf16* ACAT, const float* rpb_l, int b, int h, int r0, int tid, int wid, int lane) {
    const int hl = lane >> 5, l31 = lane & 31;
    const bool isctx = r0 < 0;
    const int r = isctx ? 0 : r0 + (wid >> 1), half = wid & 1;
    const int qrow = isctx ? ML + b * CTXL + 32 * wid + l31 : b * SEQ + r * 64 + 32 * half + l31;
    const int c = 32 * half + l31;
    int lo = 0, nloc = 0;
    if (!isctx) { lo = clampi(r0 - 4, 0, 120); nloc = clampi(r0 - 1, 0, 120) + 7 - lo + 1; }
    const int nt = nloc + 4, rs = clampi(r - 4, 0, 120);
    LAS float* bias = (LAS float*)(lds + AT_BOFF);
    const int skey = tid >> 3, spart = tid & 7;
    u32x4 kreg0, kreg1, vreg0, vreg1;
#define AT_GLOAD(it_) do { const int t_ = (it_); const size_t off = (size_t)((t_ < nloc ? b * SEQ + (lo + t_) * 64 : ML + b * CTXL + 64 * (t_ - nloc)) + skey) * AW + h * HD + 16 * spart; \
        kreg0 = *(const u32x4*)(KB + off); kreg1 = *(const u32x4*)(KB + off + 8); vreg0 = *(const u32x4*)(VB + off); vreg1 = *(const u32x4*)(VB + off + 8); } while (0)
#define AT_LWRITE(buf_) do { LAS unsigned char* kb_ = lds + (buf_) * AT_BUF; *(LAS u32x4*)(kb_ + skey * AT_KP + 32 * spart) = kreg0; *(LAS u32x4*)(kb_ + skey * AT_KP + 32 * spart + 16) = kreg1; \
        *(LAS u32x4*)(kb_ + AT_VOFF + skey * AT_VP + 32 * spart) = vreg0; *(LAS u32x4*)(kb_ + AT_VOFF + skey * AT_VP + 32 * spart + 16) = vreg1; } while (0)
    AT_GLOAD(0);
    __syncthreads();
    for (int i = tid; i < 15 * 31; i += 512) bias[i] = rpb_l[h * 465 + i] * LOG2E;
    AT_LWRITE(0);
    AT_GLOAD(1);
    bf16x8 qf[8];
    { const bf16* p2 = (isctx ? QP : QR) + (size_t)qrow * AW + h * HD + 8 * hl;
#pragma unroll
      for (int s = 0; s < 8; ++s) qf[s] = *(const bf16x8*)(p2 + 16 * s);
#pragma unroll
      for (int s = 0; s < 8; ++s) asm volatile("" : "+v"(qf[s])); }
    f32x16 O[4];
#pragma unroll
    for (int cc = 0; cc < 4; ++cc)
#pragma unroll
        for (int i = 0; i < 16; ++i) O[cc][i] = 0.f;
    float mrun = -1e30f, lrun = 0.f;
    const float SC = 0.08838834764831845f * LOG2E;
    const int blk = (lane >> 4) & 1, q4 = (lane & 15) >> 2, p4 = lane & 3;
    const unsigned vtr0 = lds_addr(lds + AT_VOFF) + (unsigned)((4 * hl + q4) * AT_VP + 32 * blk + 8 * p4);
    __syncthreads();
    for (int it = 0; it < nt; ++it) {
        const int cur = it & 1;
        if (it + 1 < nt) { AT_LWRITE(cur ^ 1); if (it + 2 < nt) AT_GLOAD(it + 2); }
        const bool local = it < nloc; const int kr = lo + it;
        if (!(local && (kr < rs || kr > rs + 7))) {
            LAS unsigned char* kimg = lds + cur * AT_BUF;
            f32x16 s0, s1;
#pragma unroll
            for (int i = 0; i < 16; ++i) { s0[i] = 0.f; s1[i] = 0.f; }
            if (it == nloc && !isctx) {
                const bf16* p = QP + (size_t)qrow * AW + h * HD + 8 * hl;
#pragma unroll
                for (int s = 0; s < 8; ++s) qf[s] = *(const bf16x8*)(p + 16 * s);
#pragma unroll
                for (int s = 0; s < 8; ++s) asm volatile("" : "+v"(qf[s]));
            }
#pragma unroll
            for (int s = 0; s < 8; ++s) { const bf16x8 a0 = *(const LAS bf16x8*)(kimg + l31 * AT_KP + 32 * s + 16 * hl), a1 = *(const LAS bf16x8*)(kimg + (32 + l31) * AT_KP + 32 * s + 16 * hl);
                s0 = MFMA32(a0, qf[s], s0); s1 = MFMA32(a1, qf[s], s1); }
            float tmax = -INFINITY;
            if (local) {
                int cv = c; asm volatile("" : "+v"(cv));
                const int e0 = 4 * hl - clampi(cv - 8, 0, 48);
                const LAS float* bl = bias + ((kr - r + 7) * 31 + 4 * hl - cv + 15);
#pragma unroll
                for (int i = 0; i < 16; ++i) { const int ki = (i & 3) + 8 * (i >> 2);
                    const float x0 = s0[i] * SC + bl[ki], x1 = s1[i] * SC + bl[ki + 32];
                    s0[i] = ((unsigned)(ki + e0) < 16u) ? x0 : -INFINITY; s1[i] = ((unsigned)(ki + 32 + e0) < 16u) ? x1 : -INFINITY;
                    tmax = fmaxf(tmax, fmaxf(s0[i], s1[i])); }
            } else {
#pragma unroll
                for (int i = 0; i < 16; ++i) { s0[i] *= SC; s1[i] *= SC; tmax = fmaxf(tmax, fmaxf(s0[i], s1[i])); }
            }
            tmax = fmaxf(tmax, __shfl_xor(tmax, 32));
            const float mnew = fmaxf(mrun, tmax), alpha = __builtin_amdgcn_exp2f(mrun - mnew); mrun = mnew;
            float psum = 0.f;
#pragma unroll
            for (int i = 0; i < 16; ++i) { s0[i] = __builtin_amdgcn_exp2f(s0[i] - mnew); s1[i] = __builtin_amdgcn_exp2f(s1[i] - mnew); psum += s0[i] + s1[i]; }
            lrun = lrun * alpha + psum;
            if (!__all(alpha == 1.0f)) {
#pragma unroll
                for (int cc = 0; cc < 4; ++cc)
#pragma unroll
                    for (int i = 0; i < 16; ++i) O[cc][i] *= alpha;
            }
            const unsigned vtr = vtr0 + (unsigned)(cur * AT_BUF);
#define AT_PV(S16, SRC, ST) do { bf16x8 pf, vf[4]; PACK_STEP(pf, SRC, ST); tr_read_v4<16 * S16 * AT_VP>(vtr, vf); \
                O[0] = MFMA32(vf[0], pf, O[0]); O[1] = MFMA32(vf[1], pf, O[1]); O[2] = MFMA32(vf[2], pf, O[2]); O[3] = MFMA32(vf[3], pf, O[3]); } while (0)
            if (!(local && half == 1)) AT_PV(0, s0, 0);
            AT_PV(1, s0, 1); AT_PV(2, s1, 0);
            if (!(local && half == 0)) AT_PV(3, s1, 1);
#undef AT_PV
        }
        __syncthreads();
    }
#undef AT_GLOAD
#undef AT_LWRITE
    const float inv = 1.0f / (lrun + __shfl_xor(lrun, 32));
    bf16* orow = ACAT + (size_t)qrow * D + GMW + h * HD + 4 * hl;
#pragma unroll
    for (int cc = 0; cc < 4; ++cc)
#pragma unroll
        for (int g = 0; g < 4; ++g) { u32x2 w; w.x = cvt_pk_bf16(O[cc][4 * g] * inv, O[cc][4 * g + 1] * inv); w.y = cvt_pk_bf16(O[cc][4 * g + 2] * inv, O[cc][4 * g + 3] * inv);
            *(u32x2*)(orow + 32 * cc + 8 * g) = w; }
}

constexpr int GM_IMG = 128 * 96;
__device__ __forceinline__ void gmlp_unit(LAS unsigned char* lds, const bf16* ZB, bf16* ACAT, const float* lng, const float* lnb, const bf16* WSb, const float* bs, int unit, int tid, int wid, int lane) {
    const int chunk = unit >> 1, gh = unit & 1;
    const int hl = lane >> 5, l31 = lane & 31, row0 = 128 * chunk;
    LAS f32x2* stats = (LAS f32x2*)(lds + 8 * GM_IMG);
    __syncthreads();
    {
        u32x4 raw[16][2];
#pragma unroll
        for (int k = 0; k < 16; ++k) { const bf16* p = ZB + (size_t)(row0 + 16 * wid + k) * 2048 + 1024 + 8 * lane; raw[k][0] = *(const u32x4*)p; raw[k][1] = *(const u32x4*)(p + 512); }
#pragma unroll
        for (int k = 0; k < 16; ++k) {
            f32x4 v[4]; unpack8(raw[k][0], v[0], v[1]); unpack8(raw[k][1], v[2], v[3]);
            float s = 0.f;
#pragma unroll
            for (int j = 0; j < 4; ++j) s += (v[j][0] + v[j][1]) + (v[j][2] + v[j][3]);
            const float mean = wave_sum(s) * (1.0f / 1024.0f); float q = 0.f;
#pragma unroll
            for (int j = 0; j < 4; ++j) { const f32x4 d = v[j] - mean; q += (d[0] * d[0] + d[1] * d[1]) + (d[2] * d[2] + d[3] * d[3]); }
            const float rstd = 1.0f / sqrtf(wave_sum(q) * (1.0f / 1024.0f) + LN_EPS);
            if (lane == 0) stats[16 * wid + k] = (f32x2){mean, rstd};
        }
    }
    __syncthreads();
    const int g = 4 * gh + (wid & 3);
    LAS unsigned char* img = lds + wid * GM_IMG;
    const int blk = (lane >> 4) & 1, q4 = (lane & 15) >> 2, p4 = lane & 3;
    const unsigned itr = lds_addr(img) + (unsigned)((8 * hl + q4) * 96 + 32 * blk + 8 * p4);
    const bf16* wbase = WSb + ((size_t)(g * 128 + l31) * 128 + 8 * hl);
    for (int cbi = 0; cbi < 2; ++cbi) {
        const int cbase = 128 * g + 32 * (2 * (wid >> 2) + cbi);
        u32x4 vraw[2][4];
#pragma unroll
        for (int j2 = 0; j2 < 2; ++j2)
#pragma unroll
            for (int k4 = 0; k4 < 4; ++k4) vraw[j2][k4] = *(const u32x4*)(ZB + (size_t)(row0 + lane + 64 * j2) * 2048 + 1024 + cbase + 8 * k4);
        bf16x8 wf[4][4];
#pragma unroll
        for (int s4 = 0; s4 < 4; ++s4)
#pragma unroll
            for (int qb = 0; qb < 4; ++qb) wf[s4][qb] = *(const bf16x8*)(wbase + (size_t)(32 * qb) * 128 + 16 * s4);
#pragma unroll
        for (int j2 = 0; j2 < 2; ++j2) {
            const int p = lane + 64 * j2; const f32x2 st = stats[p];
#pragma unroll
            for (int k4 = 0; k4 < 4; ++k4) {
                f32x4 a, bq; unpack8(vraw[j2][k4], a, bq);
                const f32x4 g0 = *(const f32x4*)(lng + cbase + 8 * k4), g1 = *(const f32x4*)(lng + cbase + 8 * k4 + 4), b0 = *(const f32x4*)(lnb + cbase + 8 * k4), b1 = *(const f32x4*)(lnb + cbase + 8 * k4 + 4);
                a = (a - st.x) * st.y * g0 + b0; bq = (bq - st.x) * st.y * g1 + b1;
                *(LAS u32x4*)(img + p * 96 + 16 * k4) = pg8::pack8(a, bq);
            }
        }
        u32x2 uw[4][4]; float bqv[4];
#pragma unroll
        for (int qb = 0; qb < 4; ++qb) { bqv[qb] = bs[g * 128 + 32 * qb + l31];
#pragma unroll
            for (int gq = 0; gq < 4; ++gq) uw[qb][gq] = *(const u32x2*)(ZB + (size_t)(row0 + 32 * qb + l31) * 2048 + cbase + 8 * gq + 4 * hl); }
        LDS_WAIT();
        f32x16 acc[4];
#pragma unroll
        for (int qb = 0; qb < 4; ++qb)
#pragma unroll
            for (int i = 0; i < 16; ++i) acc[qb][i] = 0.f;
#define GM_STEP(S, WF) do { const bf16x8 vf = tr_read2<16 * S * 96, 16 * S * 96 + 4 * 96>(itr); \
            _Pragma("unroll") for (int qb = 0; qb < 4; ++qb) acc[qb] = MFMA32(vf, WF[S & 3][qb], acc[qb]); } while (0)
        GM_STEP(0, wf); GM_STEP(1, wf); GM_STEP(2, wf); GM_STEP(3, wf);
#pragma unroll
        for (int s4 = 0; s4 < 4; ++s4)
#pragma unroll
            for (int qb = 0; qb < 4; ++qb) wf[s4][qb] = *(const bf16x8*)(wbase + (size_t)(32 * qb) * 128 + 16 * (4 + s4));
        GM_STEP(4, wf); GM_STEP(5, wf); GM_STEP(6, wf); GM_STEP(7, wf);
#undef GM_STEP
#pragma unroll
        for (int qb = 0; qb < 4; ++qb) {
            const int q = 32 * qb + l31; const float bq = bqv[qb];
            const size_t row = (size_t)(row0 + q);
#pragma unroll
            for (int gq = 0; gq < 4; ++gq) { const int col = cbase + 8 * gq + 4 * hl;
                const u32x2 uwv = uw[qb][gq];
                u32x2 w; w.x = cvt_pk_bf16(bf_lo(uwv.x) * (acc[qb][4 * gq] + bq), bf_hi(uwv.x) * (acc[qb][4 * gq + 1] + bq)); w.y = cvt_pk_bf16(bf_lo(uwv.y) * (acc[qb][4 * gq + 2] + bq), bf_hi(uwv.y) * (acc[qb][4 * gq + 3] + bq));
                *(u32x2*)(ACAT + row * D + col) = w; }
        }
        LDS_WAIT();
    }
}

constexpr int S5_WAVE_LDS = 8192 + 16 * 272;
__device__ __forceinline__ void s5_chunk_ids(int ci, int& b, int& n, bool& isctx) { isctx = ci >= 128; if (isctx) { b = (ci - 128) >> 1; n = (ci - 128) & 1; } else { b = ci >> 6; n = ci & 63; } }
__device__ __forceinline__ int s5_scan_index(int d, int n, bool isctx) { return d == 0 ? (isctx ? n : 2 + n) : (isctx ? 1 - n : 2 + (63 - n)); }
__device__ __forceinline__ void s5_load_u(bf16x8 (&ufr)[4], const bf16* US, int row0, int g, int lane) {
#pragma unroll
    for (int tb = 0; tb < 4; ++tb) ufr[tb] = *(const bf16x8*)(US + (size_t)(row0 + 32 * tb + (lane & 31)) * SSW + SG * g + 8 * (lane >> 5));
}
__device__ __forceinline__ void s5_bu(f32x16 (&Dt)[4], const bf16x8 uf, const bf16x8 (&bfr)[4]) {
#pragma unroll
    for (int j = 0; j < 4; ++j) {
#pragma unroll
        for (int i = 0; i < 16; ++i) Dt[j][i] = 0.f;
        Dt[j] = MFMA32(uf, bfr[j], Dt[j]); }
}
template <int H2> __device__ __forceinline__ void s5_bu_to_lds(LAS float* bu, const f32x16 (&Dt)[4], int lane) {
    const int hl = lane >> 5, l31 = lane & 31;
#pragma unroll
    for (int j = 0; j < 4; ++j)
#pragma unroll
        for (int ii = 0; ii < 8; ++ii) { const int i = 8 * H2 + ii, tt = (ii & 3) + 8 * (ii >> 2) + 4 * hl; bu[tt * 128 + 32 * j + l31] = Dt[j][i]; }
    LDS_WAIT();
}
template <bool WRITE_H> __device__ __forceinline__ void s5_scan16(const LAS float* bu, LAS unsigned char* hs, int d, float ar, float ai, float& hr, float& hi, int lane) {
    for (int st = 0; st < 16; ++st) { const int tt = d ? 15 - st : st;
        const float br = bu[tt * 128 + lane], bi = bu[tt * 128 + 64 + lane];
        const float nr = ar * hr - ai * hi + br, ni = ar * hi + ai * hr + bi; hr = nr; hi = ni;
        if (WRITE_H) { const unsigned w = cvt_pk_bf16(hr, hi);
            *(LAS unsigned short*)(hs + tt * 272 + 2 * lane) = (unsigned short)(w & 0xffffu); *(LAS unsigned short*)(hs + tt * 272 + 128 + 2 * lane) = (unsigned short)(w >> 16); } }
    LDS_WAIT();
}
__device__ __forceinline__ void s5_pass1(LAS unsigned char* wl, const bf16* US, const f32x4* SA_l, const bf16* SBB_l, f32x2* HEND, int ci, int g, int lane) {
    LAS float* bu = (LAS float*)wl;
    int b, n; bool isctx; s5_chunk_ids(ci, b, n, isctx);
    const int row0 = 128 * ci;
    bf16x8 ufr[4]; s5_load_u(ufr, US, row0, g, lane);
#pragma unroll
    for (int d = 0; d < 2; ++d) {
        const int k = s5_scan_index(d, n, isctx);
        if (k == NK - 1) continue;
        const f32x4 A = SA_l[(d * NG + g) * NP + lane];
        bf16x8 bfr[4];
#pragma unroll
        for (int j = 0; j < 4; ++j) bfr[j] = *(const bf16x8*)(SBB_l + ((size_t)((d * NG + g) * 128 + 32 * j + (lane & 31)) * SG + 8 * (lane >> 5)));
        float hr = 0.f, hi = 0.f;
#pragma unroll
        for (int tbi = 0; tbi < 4; ++tbi) {
            const int tb = d ? 3 - tbi : tbi;
            f32x16 Dt[4]; s5_bu(Dt, ufr[tb], bfr);
            if (d == 0) { s5_bu_to_lds<0>(bu, Dt, lane); s5_scan16<false>(bu, nullptr, 0, A[0], A[1], hr, hi, lane); s5_bu_to_lds<1>(bu, Dt, lane); s5_scan16<false>(bu, nullptr, 0, A[0], A[1], hr, hi, lane); }
            else        { s5_bu_to_lds<1>(bu, Dt, lane); s5_scan16<false>(bu, nullptr, 1, A[0], A[1], hr, hi, lane); s5_bu_to_lds<0>(bu, Dt, lane); s5_scan16<false>(bu, nullptr, 1, A[0], A[1], hr, hi, lane); }
        }
        HEND[((size_t)((b * 2 + d) * NK + k) * NG + g) * NP + lane] = (f32x2){hr, hi};
    }
}
__device__ __forceinline__ void s5_pass2(LAS unsigned char* wl, const bf16* US, const f32x4* SA_l, const bf16* SBB_l, const bf16* SC_l, const f32x2* HEND, const float* dskip_l, bf16* YS, int ci, int g, int lane) {
    LAS float* bu = (LAS float*)wl; LAS unsigned char* hs = wl + 8192;
    int b, n; bool isctx; s5_chunk_ids(ci, b, n, isctx);
    const int row0 = 128 * ci;
    f32x4 yacc[8];
#pragma unroll
    for (int sb = 0; sb < 8; ++sb) yacc[sb] = (f32x4){0.f, 0.f, 0.f, 0.f};
    const int t16 = lane & 15, kq = lane >> 4;
    bf16x8 ufr[4]; s5_load_u(ufr, US, row0, g, lane);
#define S5_HALF(SB, H2, DIR) do { s5_bu_to_lds<H2>(bu, Dt, lane); s5_scan16<true>(bu, hs, DIR, A[0], A[1], hr, hi, lane); \
        _Pragma("unroll") for (int kb = 0; kb < 4; ++kb) { const bf16x8 hf = *(const LAS bf16x8*)(hs + t16 * 272 + 64 * kb + 16 * kq); yacc[SB] = MFMA16(cf[kb], hf, yacc[SB]); } \
        LDS_WAIT(); } while (0)
#pragma unroll
    for (int d = 0; d < 2; ++d) {
        const int k = s5_scan_index(d, n, isctx);
        const f32x4 A = SA_l[(d * NG + g) * NP + lane];
        bf16x8 bfr[4], cf[4];
#pragma unroll
        for (int j = 0; j < 4; ++j) bfr[j] = *(const bf16x8*)(SBB_l + ((size_t)((d * NG + g) * 128 + 32 * j + (lane & 31)) * SG + 8 * (lane >> 5)));
#pragma unroll
        for (int kb = 0; kb < 4; ++kb) cf[kb] = *(const bf16x8*)(SC_l + ((size_t)((d * NG + g) * SG + t16) * 128 + 32 * kb + 8 * kq));
        float hr = 0.f, hi = 0.f;
        const f32x2* he = HEND + ((size_t)((b * 2 + d) * NK) * NG + g) * NP + lane;
        for (int j0 = 0; j0 < k; j0 += 8) {
            f32x2 e[8];
#pragma unroll
            for (int q = 0; q < 8; ++q) { const int jj = (j0 + q < k) ? j0 + q : k - 1; e[q] = he[(size_t)jj * NG * NP]; }
#pragma unroll
            for (int q = 0; q < 8; ++q) if (j0 + q < k) { const float nr = A[2] * hr - A[3] * hi + e[q].x, ni = A[2] * hi + A[3] * hr + e[q].y; hr = nr; hi = ni; }
        }
        f32x16 Dt[4];
        if (d == 0) {
            s5_bu(Dt, ufr[0], bfr); S5_HALF(0, 0, 0); S5_HALF(1, 1, 0);
            s5_bu(Dt, ufr[1], bfr); S5_HALF(2, 0, 0); S5_HALF(3, 1, 0);
            s5_bu(Dt, ufr[2], bfr); S5_HALF(4, 0, 0); S5_HALF(5, 1, 0);
            s5_bu(Dt, ufr[3], bfr); S5_HALF(6, 0, 0); S5_HALF(7, 1, 0);
        } else {
            s5_bu(Dt, ufr[3], bfr); S5_HALF(7, 1, 1); S5_HALF(6, 0, 1);
            s5_bu(Dt, ufr[2], bfr); S5_HALF(5, 1, 1); S5_HALF(4, 0, 1);
            s5_bu(Dt, ufr[1], bfr); S5_HALF(3, 1, 1); S5_HALF(2, 0, 1);
            s5_bu(Dt, ufr[0], bfr); S5_HALF(1, 1, 1); S5_HALF(0, 0, 1);
        }
    }
#undef S5_HALF
    const f32x4 dsk = *(const f32x4*)(dskip_l + SG * g + 4 * kq);
#pragma unroll
    for (int sb = 0; sb < 8; ++sb) { const int t = 16 * sb + t16; const u32x2 uw = *(const u32x2*)(US + (size_t)(row0 + t) * SSW + SG * g + 4 * kq);
        const f32x4 us4 = {bf_lo(uw.x), bf_hi(uw.x), bf_lo(uw.y), bf_hi(uw.y)};
        f32x4 y = yacc[sb] + dsk * us4;
#pragma unroll
        for (int e = 0; e < 4; ++e) y[e] = gelu_tanh_f(y[e]);
        u32x2 w; w.x = cvt_pk_bf16(y[0], y[1]); w.y = cvt_pk_bf16(y[2], y[3]);
        *(u32x2*)(YS + (size_t)(row0 + t) * SSW + SG * g + 4 * kq) = w; }
}

constexpr int NPH = 2 + 13 * DEPTH;
__global__ void __launch_bounds__(512, 2) fwd_kernel(Args args) {
    extern __shared__ __attribute__((aligned(16))) unsigned char lds_raw[];
    LAS unsigned char* lds = (LAS unsigned char*)lds_raw;
    volatile LAS unsigned* MISC = (volatile LAS unsigned*)(lds + MISC_OFF);
    for (int u = threadIdx.x; u < (LDS_BYTES - LDSCTL_OFF) / 4; u += 512) ((LAS unsigned*)(lds + LDSCTL_OFF))[u] = 0u;
    __syncthreads();
    const int lo = args.ph_lo, hi = args.ph_hi;
    const bool use_bar = (hi - lo) > 1;
    XcdBarrier bar; bar.bar = (unsigned*)(args.ws + WS_CTL) + CW_BAR; bar.x = 0; bar.st = nullptr;
    if (use_bar) bar = xcd_barrier_post((unsigned*)(args.ws + WS_CTL) + CW_BAR, MISC + 8);
#ifndef PH_MASK
#define PH_MASK 0xFFFFFFFFu
#endif
#define IN(k) ((PH_MASK >> ((k) < 2 ? (k) : 2 + ((k) - 2) % 13) & 1u) && lo <= (k) && (k) < hi)
#define SEAM(k) do { if (IN(k) && IN((k) + 1)) xcd_barrier(bar); } while (0)
#define PHASE_IDS() int tid = threadIdx.x; asm volatile("" : "+v"(tid)); const int lane = tid & 63, wid = __builtin_amdgcn_readfirstlane(tid >> 6); \
    int bx = blockIdx.x, G = gridDim.x; asm volatile("" : "+s"(bx), "+s"(G)); GAS unsigned char* wsg_ = (GAS unsigned char*)args.ws; asm volatile("" : "+s"(wsg_)); unsigned char* ws = (unsigned char*)wsg_; const int gw = bx * 8 + wid, NGW = G * 8; (void)lane; (void)gw; (void)NGW
#define X ((float*)(ws + WS_X))
#define H ((bf16*)(ws + WS_H))
#define ACT ((bf16*)(ws + WS_ACT))
#define QP ((bf16*)(ws + WS_QP))
#define QR ((bf16*)(ws + WS_QR))
#define KB ((bf16*)(ws + WS_KB))
#define VB ((bf16*)(ws + WS_VB))
#define ZB ((bf16*)(ws + WS_ZB))
#define US ((bf16*)(ws + WS_US))
#define GB ((bf16*)(ws + WS_GB))
#define ACAT ((bf16*)(ws + WS_ACAT))
#define YS ((bf16*)(ws + WS_YS))
#define MG ((bf16*)(ws + WS_MG))
#define YB ((bf16*)(ws + WS_Y))
#define XSRC_IN (l == 0 ? as_global(args.in[0]) : nullptr)
#define modv ((const float*)(ws + WS_MOD))
#define WL(off) ((const bf16*)(ws + WS_W + (size_t)l * LW_BYTES + (off)))
#define MODL (modv + (size_t)l * 3 * NMODC)
#define LNG(i) (as_global(args.in[6]) + (size_t)(l * 3 + (i)) * D)
#define LNB(i) (as_global(args.in[7]) + (size_t)(l * 3 + (i)) * D)
#define MEFF (l == DEPTH - 1 ? ML : M)
constexpr int NCTXU = (MC / 256) * (D / 256);
#define OVL(mrows_) (use_bar && (mrows_) == M && G >= 4 * NCTXU)

    if (IN(0)) {
        PHASE_IDS();
        p0_tables(args, bx * 512 + tid, G * 512);
        p0_mod(args, lds, wid, lane, tid, G, bx);
        p0_weights(args, lds, wid, lane, G, bx);
        __syncthreads();
    }
    SEAM(0);
    if (IN(1)) { PHASE_IDS(); thin_phase(0, as_global(args.in[0]), as_global(args.in[2]), X, nullptr, nullptr, nullptr, modv, 0, 1, H, nullptr, M, gw, NGW, lane, (LAS float*)lds, tid); }
    SEAM(1);

    for (int l = 0; l < DEPTH; ++l) {
        const int pb = 2 + 13 * l;
        if (pb >= hi || pb + 13 <= lo) continue;
        if (IN(pb + 0)) { PHASE_IDS(); pg8::Gemm g{H, WL(LW_W1IN), M, 2 * DFF, D, D, D}; pg8::StaticOrder S; S.init(M, 2 * DFF, G, bx, D); pg8::EpiSwiGLU E{ACT, DFF};
            pg8::gemm_phase<pg8::EpiSwiGLU, pg8::StaticOrder>(lds, g, S, E, tid); }
        SEAM(pb + 0);
        if (IN(pb + 1)) { PHASE_IDS(); const int mr = OVL(M) ? ML : M; pg8::Gemm g{ACT, WL(LW_W1OUT), mr, D, DFF, DFF, DFF}; pg8::StaticOrder S; S.init(mr, D, G, bx, DFF); pg8::EpiY E{YB, MODL, 2, 0.5f};
            pg8::gemm_phase<pg8::EpiY, pg8::StaticOrder>(lds, g, S, E, tid); }
        SEAM(pb + 1);
        if (IN(pb + 2)) { PHASE_IDS();
            if (OVL(M)) {
                if (bx < NCTXU) { pg8::Gemm g{ACT, WL(LW_W1OUT), M, D, DFF, DFF, DFF}; pg8::CtxOrder S; S.init(D, bx, DFF); pg8::EpiY E{YB, MODL, 2, 0.5f}; pg8::gemm_phase<pg8::EpiY, pg8::CtxOrder>(lds, g, S, E, tid); }
                else thin_phase(1, XSRC_IN, as_global(args.in[2]), X, YB, LNG(0), LNB(0), MODL, 3, 4, H, nullptr, ML, (bx - NCTXU) * 8 + wid, (G - NCTXU) * 8, lane, (LAS float*)lds, tid, (unsigned char*)ACT);
                xcd_barrier(bar);
                thin_phase(1, XSRC_IN, as_global(args.in[2]), X, YB, LNG(0), LNB(0), MODL, 3, 4, H, nullptr, M, gw, NGW, lane, (LAS float*)lds, tid, (unsigned char*)ACT, ML);
            } else thin_phase(1, XSRC_IN, as_global(args.in[2]), X, YB, LNG(0), LNB(0), MODL, 3, 4, H, nullptr, M, gw, NGW, lane, (LAS float*)lds, tid, (unsigned char*)ACT); }
        SEAM(pb + 2);
        if (IN(pb + 3)) {
            { PHASE_IDS(); pg8::Gemm g{H, WL(LW_WIN), M, 36 * 256, D, D, D}; pg8::StaticOrder S; S.init(M, 36 * 256, G, bx, D);
              pg8::EpiIn<false> E{ws, (const float*)(ws + WS_ROPE), 0, 1.0f};
              pg8::gemm_phase<pg8::EpiIn<false>, pg8::StaticOrder>(lds, g, S, E, tid); }
            { PHASE_IDS(); pg8::Gemm g{ACT, WL(LW_W8), MEFF, 48 * 256, D / 2, D / 2, D / 2}; pg8::StaticOrder S; S.init(MEFF, 48 * 256, G, (bx + G / 2) % G, D / 2);
              pg8::EpiIn<true> E{ws, (const float*)(ws + WS_ROPE), 36, 1.0f / 16384.0f};
              pg8::gemm_phase<pg8::EpiIn<true>, pg8::StaticOrder>(lds, g, S, E, tid); }
        }
        SEAM(pb + 3);
#ifndef M1_MASK
#define M1_MASK 7
#endif
        if (IN(pb + 4)) {
            if (M1_MASK & 1) { PHASE_IDS();
                const float* rpb_l = as_global(args.in[13]) + (size_t)l * NH * 465;
                for (int u = bx; u < (l == DEPTH - 1 ? 1024 : 1056); u += G) {
                    if (u < 1024) { const int rb = u & 31, h = (u >> 5) & 15, b = u >> 9; attn_unit(lds, QP, QR, KB, VB, ACAT, rpb_l, b, h, 4 * rb, tid, wid, lane); }
                    else { const int v = u - 1024; attn_unit(lds, QP, QR, KB, VB, ACAT, rpb_l, v >> 4, v & 15, -1, tid, wid, lane); }
                }
                __syncthreads(); }
            if (M1_MASK & 2) { PHASE_IDS();
                for (int u = (G - 1 - bx); u < 2 * (MEFF / 128); u += G)
                    gmlp_unit(lds, ZB, ACAT, as_global(args.in[14]) + (size_t)l * GMW, as_global(args.in[15]) + (size_t)l * GMW, (const bf16*)(ws + WS_GWS) + (size_t)l * 8 * 128 * 128, as_global(args.in[17]) + (size_t)l * 8 * 128, u, tid, wid, lane);
                __syncthreads(); }
            if (M1_MASK & 4) { PHASE_IDS();
                for (int u = gw; u < NCH * NG; u += NGW)
                    s5_pass1(lds + wid * S5_WAVE_LDS, US, (const f32x4*)(ws + WS_SA) + (size_t)l * 2 * NG * NP, (const bf16*)(ws + WS_SBB) + (size_t)l * 2 * NG * 128 * SG, (f32x2*)(ws + WS_HEND), u >> 6, u & 63, lane);
                __syncthreads(); }
        }
        SEAM(pb + 4);
        if (IN(pb + 5)) { PHASE_IDS();
            for (int u = gw; u < (MEFF / 128) * NG; u += NGW)
                s5_pass2(lds + wid * S5_WAVE_LDS, US, (const f32x4*)(ws + WS_SA) + (size_t)l * 2 * NG * NP, (const bf16*)(ws + WS_SBB) + (size_t)l * 2 * NG * 128 * SG, (const bf16*)(ws + WS_SC) + (size_t)l * 2 * NG * SG * 128,
                         (const f32x2*)(ws + WS_HEND), as_global(args.in[25]) + (size_t)l * SSW, YS, u >> 6, u & 63, lane);
            __syncthreads();
        }
        SEAM(pb + 5);
        if (IN(pb + 6)) { PHASE_IDS(); pg8::Gemm g{YS, WL(LW_WGLU), MEFF, SSW, SSW, SSW, SSW}; pg8::StaticOrder S; S.init(MEFF, SSW, G, bx, SSW); pg8::EpiGLU E{YS, ACAT + GMW + AW, as_global(args.in[27]) + (size_t)l * SSW};
            pg8::gemm_phase<pg8::EpiGLU, pg8::StaticOrder>(lds, g, S, E, tid); }
        SEAM(pb + 6);
        if (IN(pb + 7)) { PHASE_IDS(); pg8::Gemm g{ACAT, WL(LW_WCAT), MEFF, D, D, D, D}; pg8::MergeOrder S; S.init(MEFF, D, G, bx); pg8::EpiMerge1 E{GB, MG};
            pg8::gemm_phase<pg8::EpiMerge1, pg8::MergeOrder>(lds, g, S, E, tid); }
        SEAM(pb + 7);
        if (IN(pb + 8)) { PHASE_IDS(); const int mr = OVL(MEFF) ? ML : MEFF; pg8::Gemm g{MG, WL(LW_WO), mr, D, D, D, D}; pg8::StaticOrder S; S.init(mr, D, G, bx, D); pg8::EpiY E{YB, MODL, 5, 1.0f};
            pg8::gemm_phase<pg8::EpiY, pg8::StaticOrder>(lds, g, S, E, tid); }
        SEAM(pb + 8);
        if (IN(pb + 9)) { PHASE_IDS();
            if (OVL(MEFF)) {
                if (bx < NCTXU) { pg8::Gemm g{MG, WL(LW_WO), M, D, D, D, D}; pg8::CtxOrder S; S.init(D, bx, D); pg8::EpiY E{YB, MODL, 5, 1.0f}; pg8::gemm_phase<pg8::EpiY, pg8::CtxOrder>(lds, g, S, E, tid); }
                else thin_phase(1, nullptr, nullptr, X, YB, LNG(1), LNB(1), MODL, 6, 7, H, nullptr, ML, (bx - NCTXU) * 8 + wid, (G - NCTXU) * 8, lane, (LAS float*)lds, tid);
                xcd_barrier(bar);
                thin_phase(1, nullptr, nullptr, X, YB, LNG(1), LNB(1), MODL, 6, 7, H, nullptr, M, gw, NGW, lane, (LAS float*)lds, tid, nullptr, ML);
            } else thin_phase(1, nullptr, nullptr, X, YB, LNG(1), LNB(1), MODL, 6, 7, H, nullptr, MEFF, gw, NGW, lane, (LAS float*)lds, tid); }
        SEAM(pb + 9);
        if (IN(pb + 10)) { PHASE_IDS(); pg8::Gemm g{H, WL(LW_W2IN), MEFF, 2 * DFF, D, D, D}; pg8::StaticOrder S; S.init(MEFF, 2 * DFF, G, bx, D); pg8::EpiSwiGLU E{ACT, DFF};
            pg8::gemm_phase<pg8::EpiSwiGLU, pg8::StaticOrder>(lds, g, S, E, tid); }
        SEAM(pb + 10);
        if (IN(pb + 11)) { PHASE_IDS(); const int mr = OVL(MEFF) ? ML : MEFF; pg8::Gemm g{ACT, WL(LW_W2OUT), mr, D, DFF, DFF, DFF}; pg8::StaticOrder S; S.init(mr, D, G, bx, DFF); pg8::EpiY E{YB, MODL, 8, 0.5f};
            pg8::gemm_phase<pg8::EpiY, pg8::StaticOrder>(lds, g, S, E, tid); }
        SEAM(pb + 11);
        if (IN(pb + 12)) { PHASE_IDS();
            if (l + 1 < DEPTH && OVL(M)) {
                if (bx < NCTXU) { pg8::Gemm g{ACT, WL(LW_W2OUT), M, D, DFF, DFF, DFF}; pg8::CtxOrder S; S.init(D, bx, DFF); pg8::EpiY E{YB, MODL, 8, 0.5f}; pg8::gemm_phase<pg8::EpiY, pg8::CtxOrder>(lds, g, S, E, tid); }
                else thin_phase(1, nullptr, nullptr, X, YB, LNG(2), LNB(2), MODL + 3 * NMODC, 0, 1, H, nullptr, ML, (bx - NCTXU) * 8 + wid, (G - NCTXU) * 8, lane, (LAS float*)lds, tid);
                xcd_barrier(bar);
                thin_phase(1, nullptr, nullptr, X, YB, LNG(2), LNB(2), MODL + 3 * NMODC, 0, 1, H, nullptr, M, gw, NGW, lane, (LAS float*)lds, tid, nullptr, ML);
            } else if (l + 1 < DEPTH) thin_phase(1, nullptr, nullptr, X, YB, LNG(2), LNB(2), MODL + 3 * NMODC, 0, 1, H, nullptr, M, gw, NGW, lane, (LAS float*)lds, tid);
            else thin_phase(2, nullptr, nullptr, X, YB, LNG(2), LNB(2), MODL, 0, 1, H, as_global(args.out), ML, gw, NGW, lane, (LAS float*)lds, tid);
        }
        SEAM(pb + 12);
    }
}

extern "C" void kernel_launch(void* const* d_in, const int* in_sizes, int n_in, void* d_out, int out_size, void* d_ws, size_t ws_size, hipStream_t stream) {
    static int grid = 0;
    if (grid == 0) {
        if (n_in != 32 || out_size != ML * D || ws_size < WS_END) { fprintf(stderr, "kernel_launch: unexpected sizes (n_in %d, out %d, ws %zu, need %zu)\n", n_in, out_size, ws_size, (size_t)WS_END); grid = -1; return; }
        int dev = 0, cus = 0, per_cu = 0;
        if (hipGetDevice(&dev) != hipSuccess || hipDeviceGetAttribute(&cus, hipDeviceAttributeMultiprocessorCount, dev) != hipSuccess) { grid = -1; return; }
        if (hipFuncSetAttribute((const void*)fwd_kernel, hipFuncAttributeMaxDynamicSharedMemorySize, LDS_BYTES) != hipSuccess) { fprintf(stderr, "kernel_launch: hipFuncSetAttribute failed\n"); grid = -1; return; }
        if (hipOccupancyMaxActiveBlocksPerMultiprocessor(&per_cu, (const void*)fwd_kernel, 512, LDS_BYTES) != hipSuccess || per_cu < 1) fprintf(stderr, "kernel_launch: occupancy query says %d\n", per_cu);
        (void)hipGetLastError();
        grid = cus;
    }
    if (grid < 0) return;
    (void)hipMemsetAsync((char*)d_ws + WS_CTL, 0, CTL_ZERO_BYTES, stream);
    Args a{};
    for (int i = 0; i < 32; ++i) a.in[i] = (const float*)d_in[i];
    a.out = (float*)d_out; a.ws = (unsigned char*)d_ws;
#if MK_N_LAUNCHES == 1
    a.ph_lo = 0; a.ph_hi = NPH;
    hipLaunchKernelGGL(fwd_kernel, dim3(grid), dim3(512), LDS_BYTES, stream, a);
#else
    for (int p = 0; p < NPH; ++p) { a.ph_lo = p; a.ph_hi = p + 1; hipLaunchKernelGGL(fwd_kernel, dim3(grid), dim3(512), LDS_BYTES, stream, a); }
#endif
}
```

```cpp
#include <hip/hip_runtime.h>
#include <cstdio>
#include <cstdint>

#ifndef MK_N_LAUNCHES
#define MK_N_LAUNCHES 1
#endif

#define GAS __attribute__((address_space(1)))
#define LAS __attribute__((address_space(3)))
typedef unsigned short bf16;
typedef short bf16x8 __attribute__((ext_vector_type(8)));
typedef short s16x4 __attribute__((ext_vector_type(4)));
typedef float f32x2 __attribute__((ext_vector_type(2)));
typedef float f32x4 __attribute__((ext_vector_type(4)));
typedef float f32x16 __attribute__((ext_vector_type(16)));
typedef unsigned u32x2 __attribute__((ext_vector_type(2)));
typedef unsigned u32x4 __attribute__((ext_vector_type(4)));

constexpr int D = 4096, NB = 2, SEQ = 8192, CTXL = 256, DEPTH = 2;
constexpr int ML = NB * SEQ, MC = NB * CTXL, M = ML + MC;
constexpr int DFF = 6144, NMOD = 9, NMODC = NMOD * D;
constexpr int AW = 2048, NH = 16, HD = 128, GMW = 1024, SSW = 1024, NG = 64, NP = 64, SG = 16;
constexpr int NIN = 21504;
constexpr int NCH = M / 128;
constexpr int NK = 66;
constexpr float ALPHA = 1.4142135623730951f, LN_EPS = 1e-6f, LOG2E = 1.4426950408889634f;

constexpr size_t MiB = 1u << 20;
constexpr size_t WS_CTL = 0, CTL_ZERO_BYTES = 1 * MiB;
constexpr size_t WS_MOD = 1 * MiB;
constexpr size_t WS_ROPE = 2 * MiB;
constexpr size_t WS_SA = 3 * MiB;
constexpr size_t WS_SBB = 4 * MiB;
constexpr size_t WS_SC = 6 * MiB;
constexpr size_t WS_GWS = 7 * MiB;
constexpr size_t WS_HEND = 8 * MiB;
constexpr size_t WS_W = 32 * MiB;
constexpr size_t LW_W1IN = 0, LW_W1OUT = 96 * MiB, LW_W2IN = 144 * MiB, LW_W2OUT = 240 * MiB, LW_WIN = 288 * MiB, LW_WGLU = 456 * MiB, LW_WCAT = 458 * MiB, LW_WO = 490 * MiB, LW_W8 = 522 * MiB  , LW_BYTES = 570 * MiB;
constexpr size_t WS_X = WS_W + 2 * LW_BYTES;
constexpr size_t WS_H = WS_X + 264 * MiB;
constexpr size_t WS_ACT = WS_H + 132 * MiB;
constexpr size_t WS_QP = WS_ACT + 198 * MiB;
constexpr size_t WS_QR = WS_QP + 66 * MiB;
constexpr size_t WS_KB = WS_QR + 66 * MiB;
constexpr size_t WS_VB = WS_KB + 66 * MiB;
constexpr size_t WS_ZB = WS_VB + 66 * MiB;
constexpr size_t WS_US = WS_ZB + 66 * MiB;
constexpr size_t WS_GB = WS_US + 33 * MiB;
constexpr size_t WS_ACAT = WS_GB + 396 * MiB;
constexpr size_t WS_YS = WS_ACAT + 132 * MiB;
constexpr size_t WS_MG = WS_YS + 33 * MiB;
constexpr size_t WS_Y = WS_MG + 132 * MiB;
constexpr size_t WS_END = WS_Y + 132 * MiB;
constexpr int CW_BAR = 4096;

constexpr int RING_BYTES = 131072, LDSCTL_OFF = RING_BYTES, MISC_OFF = LDSCTL_OFF + 320, LDS_BYTES = 147456;

__device__ __forceinline__ unsigned cvt_pk_bf16(float lo, float hi) { unsigned r; asm volatile("v_cvt_pk_bf16_f32 %0, %1, %2" : "=v"(r) : "v"(lo), "v"(hi)); return r; }
__device__ __forceinline__ float bf_lo(unsigned w) { return __uint_as_float(w << 16); }
__device__ __forceinline__ float bf_hi(unsigned w) { return __uint_as_float(w & 0xffff0000u); }
__device__ __forceinline__ float fast_sigmoid(float x) { return __builtin_amdgcn_rcpf(1.0f + __builtin_amdgcn_exp2f(-LOG2E * x)); }
__device__ __forceinline__ float silu_f(float x) { return x * fast_sigmoid(x); }
__device__ __forceinline__ float gelu_tanh_f(float x) { const float u = 1.5957691216057308f * (x + 0.044715f * x * x * x); return x * fast_sigmoid(u); }
template <class T> __device__ __forceinline__ T* as_global(T* p) { return (T*)(GAS T*)p; }
#define LDS_WAIT() asm volatile("s_waitcnt lgkmcnt(0)" ::: "memory")
#define VM_WAIT() asm volatile("s_waitcnt vmcnt(0)" ::: "memory")

namespace pg8 {
constexpr int BM = 256, BK = 64, HALF = 128, HTB = HALF * BK * 2, STAGE_BYTES = 8 * HTB, NXCD = 8, WGM = 4;
__host__ __device__ __forceinline__ int lds_byte(int r, int c) { const int st = (r >> 4) * 2 + (c >> 5), rr = r & 15, cc = c & 31, ob = rr * 64 + cc * 2; return st * 1024 + (ob ^ (((ob >> 9) & 1) << 5)); }
__host__ __device__ __forceinline__ void stage_rc(int b, int& R, int& C) { const int st = b / 1024, sb = b % 1024, swz = sb ^ (((sb >> 9) & 1) << 5); R = (st >> 1) * 16 + swz / 64; C = (st & 1) * 32 + (swz % 64) / 2; }
__host__ __device__ __forceinline__ int perm32(int rho) { const int n = rho >> 4, i = rho & 15; return 8 * (i >> 2) + 4 * n + (i & 3); }
typedef int v8i __attribute__((ext_vector_type(8)));
typedef int v4i __attribute__((ext_vector_type(4)));
struct Unit { int pm, pn, k0, nt, seg; };
struct Gemm { const bf16* A; const bf16* Bt; int M, N, K, lda, ldb; };
struct StaticOrder {
    int nM, nN, nwg, G, c, ntk;
    __host__ __device__ void init(int M_, int N_, int G_, int c_, int K_) { nM = M_ / BM; nN = N_ / BM; nwg = nM * nN; G = G_; c = c_; ntk = K_ / BK; }
    __host__ __device__ __forceinline__ bool next(int i, Unit& u) const {
        u.pm = 0; u.pn = 0; u.k0 = 0; u.nt = ntk; u.seg = 0;
        const long L = (long)i * G + c; if (L >= nwg) return false;
        int wgid = (int)L; { const int q = nwg / NXCD, r = nwg % NXCD, xcd = wgid % NXCD, off = wgid / NXCD; wgid = (xcd < r ? xcd * (q + 1) : r * (q + 1) + (xcd - r) * q) + off; }
        const int nig = WGM * nN, gid = wgid / nig, fm = gid * WGM, gsz = (nM - fm) < WGM ? (nM - fm) : WGM;
        u.pm = fm + ((wgid % nig) % gsz); u.pn = (wgid % nig) / gsz; return true;
    }
    __device__ __forceinline__ void a_ready(const Unit&) const {}
    __device__ __forceinline__ void done(const Unit&) const {}
};

struct CtxOrder {
    int nN, c, ntk;
    __host__ __device__ void init(int N_, int c_, int K_) { nN = N_ / BM; c = c_; ntk = K_ / BK; }
    __host__ __device__ __forceinline__ bool next(int i, Unit& u) const { u.pm = ML / BM + c / nN; u.pn = c % nN; u.k0 = 0; u.nt = ntk; u.seg = 0; return i == 0 && c < (MC / BM) * nN; }
    __device__ __forceinline__ void a_ready(const Unit&) const {}
    __device__ __forceinline__ void done(const Unit&) const {}
};
struct MergeOrder {
    StaticOrder tiles;
    __host__ __device__ void init(int M_, int N_, int G_, int c_) { tiles.init(M_, N_, G_, c_, GMW + AW + SSW); }
    __host__ __device__ __forceinline__ bool next(int i, Unit& u) const {
        const int it = i / 3, sg = i - 3 * it; Unit t; const bool ok = tiles.next(it, t);
        u.pm = t.pm; u.pn = t.pn; u.seg = sg; u.k0 = sg == 0 ? 0 : (sg == 1 ? GMW : GMW + AW); u.nt = (sg == 1 ? AW : GMW) / BK; return ok;
    }
    __device__ __forceinline__ void a_ready(const Unit&) const {}
    __device__ __forceinline__ void done(const Unit&) const {}
};

template <class Epi, class Sched, bool ALIGN_EPI = true, bool SP2 = true>
__device__ __forceinline__ void gemm_phase(LAS unsigned char* lds, const Gemm g, const Sched& S, const Epi& E, const int tid) {
    const int wid = __builtin_amdgcn_readfirstlane(tid >> 6), lane = tid & 63, wr = wid >> 2, wc = wid & 3, fr = lane & 15, fq = lane >> 4;
    unsigned voffA[2], voffB[2];
#pragma unroll
    for (int i = 0; i < 2; ++i) { int R, C; stage_rc(tid * 16 + i * 8192, R, C); const int Rb = Epi::PERM ? ((R & ~31) + perm32(R & 31)) : R;
        voffA[i] = (unsigned)(R * g.lda + C) * 2u; voffB[i] = (unsigned)(Rb * g.ldb + C) * 2u; }
    const unsigned kstep = (unsigned)(BK * 2);
    const unsigned hA = (unsigned)HALF * (unsigned)g.lda * 2u, hB = (unsigned)HALF * (unsigned)g.ldb * 2u;
    const unsigned tA = 2 * hA, tB = 2 * hB;
    const __amdgpu_buffer_rsrc_t srd_voffA = __builtin_amdgcn_make_buffer_rsrc((void*)g.A, 0, 0x7ffffff0, 0x00020000);
    const __amdgpu_buffer_rsrc_t srd_voffB = __builtin_amdgcn_make_buffer_rsrc((void*)g.Bt, 0, 0x7ffffff0, 0x00020000);
    const unsigned ldsw = (unsigned)wid * 1024u;
    constexpr bool FP8 = Epi::FP8;
    const int aoff = FP8 ? lds_byte(wr * 64 + fr, fq * 16) : lds_byte(wr * 64 + fr, fq * 8), boff = FP8 ? lds_byte(wc * 32 + fr, fq * 16) : lds_byte(wc * 32 + fr, fq * 8);
    const int aoff1 = FP8 ? lds_byte(wr * 64 + fr, fq * 16 + 8) : aoff + 1024, boff1 = FP8 ? lds_byte(wc * 32 + fr, fq * 16 + 8) : boff + 1024;
#define PG8_SA(b, h) (((b) * 2 + (h)) * HTB)
#define PG8_SB(b, h) ((4 + (b) * 2 + (h)) * HTB)
#define PG8_STAGE(bufoff, gbase, voff) do { _Pragma("unroll") for (int _i = 0; _i < 2; ++_i) \
        __builtin_amdgcn_raw_ptr_buffer_load_lds(srd_##voff, (LAS void*)(lds + (bufoff) + ldsw + _i * 8192), 16, (int)(voff)[_i], (int)(gbase), 0, 0); } while (0)
#define PG8_LDA(dst, b, h) do { if constexpr (FP8) { _Pragma("unroll") for (int m = 0; m < 4; ++m) { dst##8[m].lo = *(const LAS v4i*)(lds + PG8_SA(b, h) + aoff + m * 2048); dst##8[m].hi = *(const LAS v4i*)(lds + PG8_SA(b, h) + aoff1 + m * 2048); } } \
        else { _Pragma("unroll") for (int m = 0; m < 4; ++m) _Pragma("unroll") for (int k = 0; k < 2; ++k) dst[m][k] = *(const LAS bf16x8*)(lds + PG8_SA(b, h) + (k ? aoff1 : aoff) + m * 2048); } } while (0)
#define PG8_LDB(dst, b, h) do { if constexpr (FP8) { _Pragma("unroll") for (int n = 0; n < 2; ++n) { dst##8[n].lo = *(const LAS v4i*)(lds + PG8_SB(b, h) + boff + n * 2048); dst##8[n].hi = *(const LAS v4i*)(lds + PG8_SB(b, h) + boff1 + n * 2048); } } \
        else { _Pragma("unroll") for (int n = 0; n < 2; ++n) _Pragma("unroll") for (int k = 0; k < 2; ++k) dst[n][k] = *(const LAS bf16x8*)(lds + PG8_SB(b, h) + (k ? boff1 : boff) + n * 2048); } } while (0)
#define PG8_MMA(ai, bj, At, Bt) do { __builtin_amdgcn_s_setprio(1); _Pragma("unroll") for (int m = 0; m < 4; ++m) _Pragma("unroll") for (int n = 0; n < 2; ++n) { \
        if constexpr (FP8) asm volatile("v_mfma_scale_f32_16x16x128_f8f6f4 %0, %1, %2, %0, %3, %3 op_sel_hi:[0,0,0]" : "+v"(acc[ai][bj][m][n]) : "v"(Bt##8[n]), "v"(At##8[m]), "v"(scale1));   \
        else { _Pragma("unroll") for (int k = 0; k < 2; ++k) acc[ai][bj][m][n] = __builtin_amdgcn_mfma_f32_16x16x32_bf16(Bt[n][k], At[m][k], acc[ai][bj][m][n], 0, 0, 0); } } __builtin_amdgcn_s_setprio(0); } while (0)
#define PG8_WAIT_V(n) asm volatile("s_waitcnt vmcnt(" #n ")" ::: "memory")
#define PG8_WAIT_L(n) asm volatile("s_waitcnt lgkmcnt(" #n ")" ::: "memory")
#define PG8_BAR __builtin_amdgcn_s_barrier()
#define PG8_SCHED __builtin_amdgcn_sched_barrier(0)
    Unit cur, nxt; int ui = 0;
    if (!S.next(0, cur)) return;
    f32x4 acc[2][2][4][2];
#pragma unroll
    for (int a = 0; a < 2; ++a)
#pragma unroll
        for (int b = 0; b < 2; ++b)
#pragma unroll
            for (int m = 0; m < 4; ++m)
#pragma unroll
                for (int n = 0; n < 2; ++n) acc[a][b][m][n] = (f32x4){0.f, 0.f, 0.f, 0.f};
    const int scale1 = 0x7f7f7f7f;
    bf16x8 At[4][2], B0[2][2], B1[2][2]; v8i At8[4], B08[2], B18[2];
    unsigned cA = (unsigned)cur.pm * tA + (unsigned)cur.k0 * 2u, cB = (unsigned)cur.pn * tB + (unsigned)cur.k0 * 2u;
    S.a_ready(cur);
    if constexpr (SP2) {
        PG8_STAGE(PG8_SB(0, 0), cB, voffB); PG8_STAGE(PG8_SB(0, 1), cB + hB, voffB); PG8_STAGE(PG8_SA(0, 0), cA, voffA); PG8_STAGE(PG8_SA(0, 1), cA + hA, voffA);
        if (wr == 1) PG8_BAR;
        PG8_WAIT_V(2); PG8_BAR;
        PG8_STAGE(PG8_SB(1, 0), cB + kstep, voffB); PG8_STAGE(PG8_SA(1, 0), cA + kstep, voffA); PG8_STAGE(PG8_SB(1, 1), cB + hB + kstep, voffB);
        PG8_WAIT_V(6); PG8_BAR;
    } else {
        PG8_STAGE(PG8_SB(0, 0), cB, voffB); PG8_STAGE(PG8_SA(0, 0), cA, voffA); PG8_STAGE(PG8_SB(0, 1), cB + hB, voffB); PG8_STAGE(PG8_SA(0, 1), cA + hA, voffA);
        if (wr == 1) PG8_BAR;
        PG8_WAIT_V(4); PG8_BAR;
        PG8_STAGE(PG8_SB(1, 0), cB + kstep, voffB); PG8_STAGE(PG8_SA(1, 0), cA + kstep, voffA); PG8_STAGE(PG8_SB(1, 1), cB + hB + kstep, voffB);
        PG8_WAIT_V(6); PG8_BAR;
    }
    for (;;) {
        const bool has_next = S.next(ui + 1, nxt);
        const unsigned nA = has_next ? (unsigned)nxt.pm * tA + (unsigned)nxt.k0 * 2u : cA, nB = has_next ? (unsigned)nxt.pn * tB + (unsigned)nxt.k0 * 2u : cB;
        const int nt = cur.nt;
        for (int t = 0; t < nt; t += 2) {
            const bool last = (t == nt - 2);
            const unsigned a1 = cA + (unsigned)(t + 1) * kstep;
            const unsigned a2 = last ? nA : cA + (unsigned)(t + 2) * kstep, b2 = last ? nB : cB + (unsigned)(t + 2) * kstep;
            const unsigned a3 = a2 + kstep, b3 = b2 + kstep;
            if (last && has_next) S.a_ready(nxt);
            if constexpr (SP2) {
            PG8_LDB(B0, 0, 0); PG8_LDB(B1, 0, 1); PG8_SCHED; PG8_LDA(At, 0, 0); PG8_STAGE(PG8_SA(1, 1), a1 + hA, voffA);
            PG8_WAIT_V(8); PG8_WAIT_L(0); PG8_BAR; PG8_MMA(0, 0, At, B0); PG8_MMA(0, 1, At, B1); PG8_BAR; PG8_SCHED;
            PG8_LDA(At, 0, 1); PG8_STAGE(PG8_SB(0, 0), b2, voffB); PG8_STAGE(PG8_SB(0, 1), b2 + hB, voffB); PG8_STAGE(PG8_SA(0, 0), a2, voffA);
            PG8_WAIT_V(8); PG8_WAIT_L(0); PG8_BAR; PG8_MMA(1, 0, At, B0); PG8_MMA(1, 1, At, B1); PG8_BAR; PG8_SCHED;
            PG8_LDB(B0, 1, 0); PG8_LDB(B1, 1, 1); PG8_SCHED; PG8_LDA(At, 1, 0); PG8_STAGE(PG8_SA(0, 1), a2 + hA, voffA);
            PG8_WAIT_V(8); PG8_WAIT_L(0); PG8_BAR; PG8_MMA(0, 0, At, B0); PG8_MMA(0, 1, At, B1); PG8_BAR; PG8_SCHED;
            PG8_LDA(At, 1, 1); PG8_STAGE(PG8_SB(1, 0), b3, voffB); PG8_STAGE(PG8_SB(1, 1), b3 + hB, voffB); PG8_STAGE(PG8_SA(1, 0), a3, voffA);
            PG8_WAIT_V(8); PG8_WAIT_L(0); PG8_BAR; PG8_MMA(1, 0, At, B0); PG8_MMA(1, 1, At, B1); PG8_BAR; PG8_SCHED;
            } else {
            PG8_LDB(B0, 0, 0); PG8_SCHED; PG8_LDA(At, 0, 0); PG8_STAGE(PG8_SA(1, 1), a1 + hA, voffA);
            PG8_WAIT_L(8); PG8_BAR; PG8_WAIT_L(0); PG8_MMA(0, 0, At, B0); PG8_BAR; PG8_SCHED;
            PG8_LDB(B1, 0, 1); PG8_STAGE(PG8_SB(0, 0), b2, voffB);
            PG8_BAR; PG8_WAIT_L(0); PG8_MMA(0, 1, At, B1); PG8_BAR;
            PG8_LDA(At, 0, 1); PG8_STAGE(PG8_SA(0, 0), a2, voffA);
            PG8_BAR; PG8_WAIT_L(0); PG8_MMA(1, 0, At, B0); PG8_BAR; PG8_SCHED;
            PG8_STAGE(PG8_SB(0, 1), b2 + hB, voffB);
            PG8_WAIT_V(6); PG8_BAR; PG8_MMA(1, 1, At, B1); PG8_BAR;
            PG8_LDB(B0, 1, 0); PG8_SCHED; PG8_LDA(At, 1, 0); PG8_STAGE(PG8_SA(0, 1), a2 + hA, voffA);
            PG8_WAIT_L(8); PG8_BAR; PG8_WAIT_L(0); PG8_MMA(0, 0, At, B0); PG8_BAR; PG8_SCHED;
            PG8_LDB(B1, 1, 1); PG8_STAGE(PG8_SB(1, 0), b3, voffB);
            PG8_BAR; PG8_WAIT_L(0); PG8_MMA(0, 1, At, B1); PG8_BAR;
            PG8_LDA(At, 1, 1); PG8_STAGE(PG8_SA(1, 0), a3, voffA);
            PG8_BAR; PG8_WAIT_L(0); PG8_MMA(1, 0, At, B0); PG8_BAR; PG8_SCHED;
            PG8_STAGE(PG8_SB(1, 1), b3 + hB, voffB);
            PG8_WAIT_V(6); PG8_BAR; PG8_MMA(1, 1, At, B1); PG8_BAR;
            }
        }
        if constexpr (ALIGN_EPI) { if (wr == 0) PG8_BAR; }
        if constexpr (FP8) asm volatile("s_nop 15\n\ts_nop 15" ::: "memory");
        E(acc, cur, wr, wc, fr, fq); S.done(cur);
        if (!has_next) break;
        if constexpr (!Epi::CARRY) {
#pragma unroll
        for (int a = 0; a < 2; ++a)
#pragma unroll
            for (int b = 0; b < 2; ++b)
#pragma unroll
                for (int m = 0; m < 4; ++m)
#pragma unroll
                    for (int n = 0; n < 2; ++n) acc[a][b][m][n] = (f32x4){0.f, 0.f, 0.f, 0.f};
        }
        cur = nxt; cA = nA; cB = nB; ++ui;
        if constexpr (ALIGN_EPI) { if (wr == 1) PG8_BAR; }
    }
    PG8_WAIT_V(0);
    if constexpr (!ALIGN_EPI) { if (wr == 0) PG8_BAR; }
    PG8_BAR;
#undef PG8_SA
#undef PG8_SB
#undef PG8_STAGE
#undef PG8_LDA
#undef PG8_LDB
#undef PG8_MMA
#undef PG8_WAIT_V
#undef PG8_WAIT_L
#undef PG8_BAR
#undef PG8_SCHED
}

__device__ __forceinline__ u32x4 pack8(const f32x4 a, const f32x4 b) { u32x4 w; w.x = cvt_pk_bf16(a[0], a[1]); w.y = cvt_pk_bf16(a[2], a[3]); w.z = cvt_pk_bf16(b[0], b[1]); w.w = cvt_pk_bf16(b[2], b[3]); return w; }

struct EpiSwiGLU {
    static constexpr bool PERM = true, CARRY = false, FP8 = false;
    bf16* O; int ldo;
    __device__ __forceinline__ void operator()(const f32x4 (&acc)[2][2][4][2], const Unit& u, int wr, int wc, int fr, int fq) const {
        const int row0 = u.pm * BM + wr * 64 + fr, col0 = u.pn * 128 + wc * 32 + 8 * fq;
#pragma unroll
        for (int ai = 0; ai < 2; ++ai)
#pragma unroll
            for (int m = 0; m < 4; ++m) {
                f32x4 v0, v1;
#pragma unroll
                for (int e = 0; e < 4; ++e) { v0[e] = silu_f(acc[ai][0][m][0][e]) * acc[ai][1][m][0][e]; v1[e] = silu_f(acc[ai][0][m][1][e]) * acc[ai][1][m][1][e]; }
                *(u32x4*)(O + (size_t)(row0 + ai * HALF + m * 16) * ldo + col0) = pack8(v0, v1);
            }
    }
};
struct EpiY {
    static constexpr bool PERM = true, CARRY = false, FP8 = false;
    bf16* Y; const float* modl; int gi; float cg;
    __device__ __forceinline__ void operator()(const f32x4 (&acc)[2][2][4][2], const Unit& u, int wr, int wc, int fr, int fq) const {
        const int row0 = u.pm * BM + wr * 64 + fr, col0 = u.pn * BM + wc * 32 + 8 * fq;
        const int s = u.pm < 32 ? 0 : (u.pm < 64 ? 1 : 2);
        const float* gate = modl + (size_t)(s * NMOD + gi) * D;
        f32x4 gv[2][2];
#pragma unroll
        for (int bj = 0; bj < 2; ++bj)
#pragma unroll
            for (int n = 0; n < 2; ++n) gv[bj][n] = *(const f32x4*)(gate + col0 + bj * HALF + 4 * n) * cg;
#pragma unroll
        for (int ai = 0; ai < 2; ++ai)
#pragma unroll
            for (int m = 0; m < 4; ++m) { bf16* rowp = Y + (size_t)(row0 + ai * HALF + m * 16) * D + col0;
#pragma unroll
                for (int bj = 0; bj < 2; ++bj) *(u32x4*)(rowp + bj * HALF) = pack8(gv[bj][0] * acc[ai][bj][m][0], gv[bj][1] * acc[ai][bj][m][1]); }
    }
};
template <bool FP8_> struct EpiIn {
    static constexpr bool PERM = true, CARRY = false, FP8 = FP8_;
    unsigned char* ws; const float* rope; int pn0; float ascale;
    __device__ __forceinline__ void operator()(const f32x4 (&acc)[2][2][4][2], const Unit& u0, int wr, int wc, int fr, int fq) const {
        Unit u; u.pm = u0.pm; u.pn = u0.pn + pn0;
        const int row0 = u.pm * BM + wr * 64 + fr;
        if (u.pn < 16) {
            const bool isq = u.pn < 8; const int head = 2 * (u.pn & 7) + (wc >> 1), rr = wc & 1, i0 = 8 * fq;
            const int colb = head * HD + rr * 64 + i0;
            const bool lat = u.pm < 64;
#pragma unroll
            for (int ai = 0; ai < 2; ++ai)
#pragma unroll
                for (int m = 0; m < 4; ++m) {
                    const int row = row0 + ai * HALF + m * 16;
                    const f32x4 a0 = acc[ai][0][m][0], a1 = acc[ai][0][m][1], b0 = acc[ai][1][m][0], b1 = acc[ai][1][m][1];
                    if (isq || !lat) { bf16* dst = (bf16*)(ws + (isq ? WS_QP : WS_KB)) + (size_t)row * AW + colb; *(u32x4*)dst = pack8(a0, a1); *(u32x4*)(dst + 32) = pack8(b0, b1); }
                    if (lat) {
                        const int t = row & (SEQ - 1), pos = rr ? (t & 63) : (t >> 6);
                        const float* cp = rope + pos * 32 + i0; const float* sp = cp + 128 * 32;
                        const f32x4 c0 = *(const f32x4*)cp, c1 = *(const f32x4*)(cp + 4), s0 = *(const f32x4*)sp, s1 = *(const f32x4*)(sp + 4);
                        const f32x4 o0 = a0 * c0 - b0 * s0, o1 = a1 * c1 - b1 * s1, p0 = a0 * s0 + b0 * c0, p1 = a1 * s1 + b1 * c1;
                        bf16* dst = (bf16*)(ws + (isq ? WS_QR : WS_KB)) + (size_t)row * AW + colb; *(u32x4*)dst = pack8(o0, o1); *(u32x4*)(dst + 32) = pack8(p0, p1);
                    }
                }
            return;
        }
        size_t boff; int ld, colt, act;
        if (u.pn < 24) { boff = WS_VB; ld = AW; colt = (u.pn - 16) * BM; act = 0; }
        else if (u.pn < 32) { boff = WS_ZB; ld = 2048; colt = (u.pn - 24) * BM; act = 1; }
        else if (u.pn < 36) { boff = WS_US; ld = SSW; colt = (u.pn - 32) * BM; act = 0; }
        else { boff = WS_GB; ld = 3 * D; colt = (u.pn - 36) * BM; act = 2; }
        bf16* base = (bf16*)(ws + boff);
        const int col0 = colt + wc * 32 + 8 * fq;
#pragma unroll
        for (int ai = 0; ai < 2; ++ai)
#pragma unroll
            for (int m = 0; m < 4; ++m) { bf16* rowp = base + (size_t)(row0 + ai * HALF + m * 16) * ld + col0;
#pragma unroll
                for (int bj = 0; bj < 2; ++bj) { f32x4 v0 = acc[ai][bj][m][0], v1 = acc[ai][bj][m][1];
                    if (act == 1) {
#pragma unroll
                        for (int e = 0; e < 4; ++e) { v0[e] = gelu_tanh_f(v0[e]); v1[e] = gelu_tanh_f(v1[e]); } }
                    else if (act == 2) {
#pragma unroll
                        for (int e = 0; e < 4; ++e) { v0[e] = fast_sigmoid(v0[e] * ascale); v1[e] = fast_sigmoid(v1[e] * ascale); } }
                    *(u32x4*)(rowp + bj * HALF) = pack8(v0, v1); } }
    }
};
__device__ __forceinline__ void unpack8(const u32x4 w, f32x4& a, f32x4& b) { a = (f32x4){bf_lo(w.x), bf_hi(w.x), bf_lo(w.y), bf_hi(w.y)}; b = (f32x4){bf_lo(w.z), bf_hi(w.z), bf_lo(w.w), bf_hi(w.w)}; }
struct EpiGLU {
    static constexpr bool PERM = true, CARRY = false, FP8 = false;
    const bf16* YS; bf16* O; const float* bias;
    __device__ __forceinline__ void operator()(const f32x4 (&acc)[2][2][4][2], const Unit& u, int wr, int wc, int fr, int fq) const {
        const int row0 = u.pm * BM + wr * 64 + fr, col0 = u.pn * BM + wc * 32 + 8 * fq;
        const f32x4 bv[2][2] = {{*(const f32x4*)(bias + col0), *(const f32x4*)(bias + col0 + 4)}, {*(const f32x4*)(bias + col0 + HALF), *(const f32x4*)(bias + col0 + HALF + 4)}};
        constexpr int PD = 7;
        u32x4 yr[PD + 1];
#define EG_ROW(s_) ((size_t)(row0 + ((s_) >> 3) * HALF + (((s_) >> 1) & 3) * 16))
#define EG_LOAD(s_) yr[(s_) % (PD + 1)] = *(const u32x4*)(YS + EG_ROW(s_) * SSW + col0 + ((s_) & 1) * HALF)
#pragma unroll
        for (int s = 0; s < PD; ++s) EG_LOAD(s);
#pragma unroll
        for (int s = 0; s < 16; ++s) {
            if (s + PD < 16) EG_LOAD(s + PD);
            const int ai = s >> 3, m = (s >> 1) & 3, bj = s & 1;
            f32x4 y0, y1; unpack8(yr[s % (PD + 1)], y0, y1);
            f32x4 v0 = acc[ai][bj][m][0] + bv[bj][0], v1 = acc[ai][bj][m][1] + bv[bj][1];
#pragma unroll
            for (int e = 0; e < 4; ++e) { v0[e] = y0[e] * fast_sigmoid(v0[e]); v1[e] = y1[e] * fast_sigmoid(v1[e]); }
            *(u32x4*)(O + EG_ROW(s) * D + col0 + bj * HALF) = pack8(v0, v1);
            asm volatile("" ::: "memory");
        }
#undef EG_LOAD
#undef EG_ROW
    }
};
#ifndef MERGE_PD
#define MERGE_PD 3
#endif
struct EpiMerge1 {
    static constexpr bool PERM = true, CARRY = true, FP8 = false;
    const bf16* GB; bf16* MG;
    __device__ __forceinline__ void operator()(f32x4 (&acc)[2][2][4][2], const Unit& u, int wr, int wc, int fr, int fq) const {
        const int row0 = u.pm * BM + wr * 64 + fr, col0 = u.pn * BM + wc * 32 + 8 * fq;
        const bool fin = u.seg == 2;
        const int noff = u.seg * D;
        const float keep = fin ? 0.f : 1.f;
        constexpr int PD = MERGE_PD;
        u32x4 nwr[PD + 1], dwr[PD + 1];
#define EM_ROW(s_) ((size_t)(row0 + ((s_) >> 3) * HALF + (((s_) >> 1) & 3) * 16))
#define EM_LOAD(s_) do { const bf16* gp_ = GB + EM_ROW(s_) * (3 * D) + noff + col0 + ((s_) & 1) * HALF; nwr[(s_) % (PD + 1)] = *(const u32x4*)gp_; dwr[(s_) % (PD + 1)] = *(const u32x4*)(gp_ + (fin ? 0 : D)); } while (0)
#pragma unroll
        for (int s = 0; s < PD; ++s) EM_LOAD(s);
#pragma unroll
        for (int s = 0; s < 16; ++s) {
            if (s + PD < 16) EM_LOAD(s + PD);
            const int ai = s >> 3, m = (s >> 1) & 3, bj = s & 1;
            f32x4 n0, n1, d0, d1; unpack8(nwr[s % (PD + 1)], n0, n1); unpack8(dwr[s % (PD + 1)], d0, d1);
            f32x4 r0, r1;
#pragma unroll
            for (int e = 0; e < 4; ++e) { const float q0 = __builtin_amdgcn_rcpf(fmaxf(d0[e], 1e-30f)), q1 = __builtin_amdgcn_rcpf(fmaxf(d1[e], 1e-30f));
                r0[e] = fmaxf(n0[e], 1e-30f) * (fin ? 1.0f : q0); r1[e] = fmaxf(n1[e], 1e-30f) * (fin ? 1.0f : q1); }
            const f32x4 v0 = acc[ai][bj][m][0] * r0, v1 = acc[ai][bj][m][1] * r1;
            if (fin) *(u32x4*)(MG + EM_ROW(s) * D + col0 + bj * HALF) = pack8(v0, v1);
            acc[ai][bj][m][0] = v0 * keep; acc[ai][bj][m][1] = v1 * keep;
            asm volatile("" : "+v"(acc[ai][bj][m][0]), "+v"(acc[ai][bj][m][1]) :: "memory");
        }
#undef EM_LOAD
#undef EM_ROW
    }
};
}
using pg8::unpack8; using pg8::pack8;

#define XB_TMO      128
#define XB_XCNT(j)  (256  + 64 * (j))
#define XB_XSUB(j)  (1280 + 64 * (j))
#define XB_XGEN(j)  (2304 + 64 * (j))
#define XB_TOP      3328
#define XB_TOPGEN   3392
#define XCD_BAR_WORDS 3456
#define XB_SPIN_CAP (1u << 18)
__device__ __forceinline__ unsigned xb_ld(unsigned* p)              { return __hip_atomic_load(p, __ATOMIC_RELAXED, __HIP_MEMORY_SCOPE_AGENT); }
__device__ __forceinline__ unsigned xb_add(unsigned* p, unsigned v) { return __hip_atomic_fetch_add(p, v, __ATOMIC_RELAXED, __HIP_MEMORY_SCOPE_AGENT); }
__device__ __forceinline__ unsigned xb_xcc_id() { return (unsigned)__builtin_amdgcn_s_getreg((3 << 11) | 20) & 0xFu; }
#define XB_SPIN(cond, bar) do { unsigned _sp = 0; while (cond) { __builtin_amdgcn_s_sleep(1); \
    if ((++_sp & 255u) == 0u) { if (xb_ld(&(bar)[XB_TMO])) break; if (_sp > XB_SPIN_CAP) { atomicAdd(&(bar)[XB_TMO], 1u); break; } } } } while (0)
struct XcdBarrier { unsigned* bar; unsigned x; volatile LAS unsigned* st; };
__device__ __forceinline__ XcdBarrier xcd_barrier_post(unsigned* bar, volatile LAS unsigned* st) {
    XcdBarrier b; b.bar = bar; b.x = xb_xcc_id(); b.st = st;
    if (threadIdx.x == 0) (void)xb_add(&bar[XB_XCNT(b.x)], 1u);
    return b;
}
__device__ __forceinline__ void xcd_barrier_complete(unsigned* bar, unsigned x, unsigned& nloc, unsigned& nx) {
    const unsigned G = gridDim.x * gridDim.y * gridDim.z;
    unsigned sum, cnt, mine, sp = 0u;
    for (;;) {
        sum = 0u; cnt = 0u; mine = 0u;
#pragma unroll
        for (unsigned j = 0; j < 16; ++j) { const unsigned c = xb_ld(&bar[XB_XCNT(j)]); sum += c; cnt += (c > 0u) ? 1u : 0u; mine = (j == x) ? c : mine; }
        if (sum == G) break;
        __builtin_amdgcn_s_sleep(1);
        if ((++sp & 255u) == 0u) { if (xb_ld(&bar[XB_TMO])) break; if (sp > XB_SPIN_CAP) { atomicAdd(&bar[XB_TMO], 1u); break; } }
    }
    nloc = mine > 0u ? mine : 1u; nx = cnt > 0u ? cnt : 1u;
}
__device__ __forceinline__ void xcd_barrier(const XcdBarrier& b) {
    asm volatile("s_waitcnt vmcnt(0)" ::: "memory");
    __syncthreads();
    if (threadIdx.x == 0) {
        unsigned* bar = b.bar;
        __builtin_amdgcn_s_waitcnt(0);
        unsigned nloc = b.st[0], nx = b.st[1];
        if (nloc == 0u) { xcd_barrier_complete(bar, b.x, nloc, nx); b.st[0] = nloc; b.st[1] = nx; }
        const unsigned old = xb_add(&bar[XB_XSUB(b.x)], 1u);
        const unsigned gen = old / nloc;
        if (old + 1u == (gen + 1u) * nloc) {
            __builtin_amdgcn_fence(__ATOMIC_RELEASE, "agent");
            asm volatile("s_waitcnt vmcnt(0)" ::: "memory");
            const unsigned og = xb_add(&bar[XB_TOP], 1u);
            const unsigned tg = og / nx;
            if (og + 1u == (tg + 1u) * nx) xb_add(&bar[XB_TOPGEN], 1u);
            else XB_SPIN(xb_ld(&bar[XB_TOPGEN]) == tg, bar);
            __builtin_amdgcn_fence(__ATOMIC_ACQUIRE, "agent");
            xb_add(&bar[XB_XGEN(b.x)], 1u);
            asm volatile("s_waitcnt vmcnt(0)" ::: "memory");
        } else {
            XB_SPIN(xb_ld(&bar[XB_XGEN(b.x)]) == gen, bar);
            __builtin_amdgcn_fence(__ATOMIC_ACQUIRE, "agent");
            asm volatile("s_waitcnt vmcnt(0)" ::: "memory");
        }
    }
    __syncthreads();
}

__device__ __forceinline__ float wave_sum(float v) {
#pragma unroll
    for (int o = 1; o < 64; o <<= 1) v += __shfl_xor(v, o);
    return v;
}
#define MFMA32(a, b, c) __builtin_amdgcn_mfma_f32_32x32x16_bf16((a), (b), (c), 0, 0, 0)
#define MFMA16(a, b, c) __builtin_amdgcn_mfma_f32_16x16x32_bf16((a), (b), (c), 0, 0, 0)
#define PACK_STEP(dst, x, s) do { u32x4 _p; asm volatile("v_cvt_pk_bf16_f32 %0, %4, %5\n\tv_cvt_pk_bf16_f32 %1, %6, %7\n\tv_cvt_pk_bf16_f32 %2, %8, %9\n\tv_cvt_pk_bf16_f32 %3, %10, %11\n\ts_nop 1" \
        : "=&v"(_p[0]), "=&v"(_p[1]), "=&v"(_p[2]), "=&v"(_p[3]) \
        : "v"(x[8 * (s)]), "v"(x[8 * (s) + 1]), "v"(x[8 * (s) + 2]), "v"(x[8 * (s) + 3]), "v"(x[8 * (s) + 4]), "v"(x[8 * (s) + 5]), "v"(x[8 * (s) + 6]), "v"(x[8 * (s) + 7])); \
        dst = __builtin_bit_cast(bf16x8, _p); } while (0)
template <int OFF_LO, int OFF_HI> __device__ __forceinline__ bf16x8 tr_read2(unsigned base) {
    s16x4 lo, hi;
    asm volatile("ds_read_b64_tr_b16 %0, %2 offset:%3\n\tds_read_b64_tr_b16 %1, %2 offset:%4\n\ts_waitcnt lgkmcnt(0)" : "=&v"(lo), "=&v"(hi) : "v"(base), "i"(OFF_LO), "i"(OFF_HI) : "memory");
    return __builtin_shufflevector(lo, hi, 0, 1, 2, 3, 4, 5, 6, 7);
}
__device__ __forceinline__ unsigned lds_addr(LAS unsigned char* p) { return (unsigned)(__UINTPTR_TYPE__)p; }

__device__ __forceinline__ void transpose_item(const float* W, int N, bf16* WT, int ldt, int k0, int src_n0, int dst_n0, LAS float* scr, int lane) {
#pragma unroll
    for (int i = 0; i < 32; ++i) { const int kk = 2 * i + (lane >> 5); scr[kk * 33 + (lane & 31)] = __builtin_nontemporal_load(W + (size_t)(k0 + kk) * N + src_n0 + (lane & 31)); }
    LDS_WAIT();
    const int c = lane & 7;
#pragma unroll
    for (int j = 0; j < 4; ++j) { const int n = (lane >> 3) + 8 * j; const LAS float* s = scr + (8 * c) * 33 + n;
        u32x4 o; o.x = cvt_pk_bf16(s[0 * 33], s[1 * 33]); o.y = cvt_pk_bf16(s[2 * 33], s[3 * 33]); o.z = cvt_pk_bf16(s[4 * 33], s[5 * 33]); o.w = cvt_pk_bf16(s[6 * 33], s[7 * 33]);
        *(u32x4*)(WT + (size_t)(dst_n0 + n) * ldt + k0 + 8 * c) = o; }
    LDS_WAIT();
}
__device__ __forceinline__ void transpose_item_fp8(const float* W, int N, unsigned char* WT8, int ldt, int k0, int src_n0, int dst_n0, LAS float* scr, int lane) {
#pragma unroll
    for (int i = 0; i < 32; ++i) { const int kk = 2 * i + (lane >> 5); scr[kk * 33 + (lane & 31)] = __builtin_nontemporal_load(W + (size_t)(k0 + kk) * N + src_n0 + (lane & 31)); }
    LDS_WAIT();
    const int c = lane & 7;
#pragma unroll
    for (int j = 0; j < 4; ++j) { const int n = (lane >> 3) + 8 * j; const LAS float* s = scr + (8 * c) * 33 + n;
        float e[8];
#pragma unroll
        for (int q = 0; q < 8; ++q) e[q] = fminf(fmaxf(s[q * 33] * 2048.f, -448.f), 448.f);
        int w0 = __builtin_amdgcn_cvt_pk_fp8_f32(e[0], e[1], 0, false); w0 = __builtin_amdgcn_cvt_pk_fp8_f32(e[2], e[3], w0, true);
        int w1 = __builtin_amdgcn_cvt_pk_fp8_f32(e[4], e[5], 0, false); w1 = __builtin_amdgcn_cvt_pk_fp8_f32(e[6], e[7], w1, true);
        *(u32x2*)(WT8 + (size_t)(dst_n0 + n) * ldt + k0 + 8 * c) = (u32x2){(unsigned)w0, (unsigned)w1}; }
    LDS_WAIT();
}
__device__ __forceinline__ int src_block(int mode, int nb) {
    if (mode == 1) { const int pn = nb >> 3, wb = nb & 7, bj = wb >> 2, jb = wb & 3; return bj * 192 + 4 * pn + jb; }
    if (mode == 2 && nb < 128) { const int tile = nb >> 3, wb = nb & 7, bj = wb >> 2, hh = (wb & 3) >> 1, rr = wb & 1; const int base = tile < 8 ? 0 : AW, head = 2 * (tile & 7) + hh; return (base + head * HD + rr * 64 + 32 * bj) >> 5; }
    return nb;
}
__device__ __forceinline__ void transpose_matrix_items(const float* W, int K, int N, bf16* WT, int ldt, int mode, int it, LAS float* scr, int lane, unsigned char* WT8 = nullptr) {
    const int nblk = N / 32, kb = it / nblk, nb = it % nblk;
    if (mode == 2 && nb >= 288) { transpose_item_fp8(W, N, WT8, K, 64 * kb, 32 * nb, 32 * (nb - 288), scr, lane); return; }
    transpose_item(W, N, WT, ldt, 64 * kb, 32 * src_block(mode, nb), 32 * nb, scr, lane);
}

struct Args { const float* in[32]; float* out; unsigned char* ws; int ph_lo, ph_hi; };

__device__ __forceinline__ void p0_tables(const Args& args, int gtid, int gthreads) {
    unsigned char* ws = args.ws;
    float* rope = (float*)(ws + WS_ROPE);
    for (int i = gtid; i < 128 * 32; i += gthreads) { const int pos = i >> 5, j = i & 31; const float inv = exp2f(-(float)j * (13.287712379549449f / 32.0f)); const float ang = (float)pos * inv; rope[i] = cosf(ang); rope[128 * 32 + i] = sinf(ang); }
    const float *lam_re = as_global(args.in[18]), *lam_im = as_global(args.in[19]), *log_dt = as_global(args.in[20]), *b_re = as_global(args.in[21]), *b_im = as_global(args.in[22]), *c_re = as_global(args.in[23]), *c_im = as_global(args.in[24]);
    f32x4* SA = (f32x4*)(ws + WS_SA); bf16* SBB = (bf16*)(ws + WS_SBB); bf16* SC = (bf16*)(ws + WS_SC);
    for (int i = gtid; i < DEPTH * 2 * NG * NP; i += gthreads) {
        const int p = i & 63, ldg = i >> 6;
        const float dt = expf(log_dt[ldg]), lr = lam_re[i], li = lam_im[i];
        const float x = lr * dt, y = li * dt, mag = expf(x), cs = cosf(y), sn = sinf(y), sh = sinf(0.5f * y);
        const float ar = mag * cs, ai = mag * sn, re1 = expm1f(x) * cs - 2.0f * sh * sh, den = lr * lr + li * li;
        const float fr = (re1 * lr + ai * li) / den, fi = (ai * lr - re1 * li) / den;
        float tr = ar, ti = ai;
#pragma unroll
        for (int q = 0; q < 7; ++q) { const float nr = tr * tr - ti * ti, ni = 2.0f * tr * ti; tr = nr; ti = ni; }
        SA[i] = (f32x4){ar, ai, tr, ti};
        { bf16* o_re = SBB + ((size_t)ldg * 128 + p) * SG; bf16* o_im = o_re + 64 * SG;
#pragma unroll
          for (int ch = 0; ch < SG; ch += 2) { const float br0 = b_re[(size_t)i * SG + ch], bi0 = b_im[(size_t)i * SG + ch], br1 = b_re[(size_t)i * SG + ch + 1], bi1 = b_im[(size_t)i * SG + ch + 1];
              *(unsigned*)(o_re + ch) = cvt_pk_bf16(fr * br0 - fi * bi0, fr * br1 - fi * bi1); *(unsigned*)(o_im + ch) = cvt_pk_bf16(fr * bi0 + fi * br0, fr * bi1 + fi * br1); } }
#pragma unroll
        for (int ch = 0; ch < SG; ++ch) { const size_t ci = ((size_t)ldg * SG + ch) * NP + p; const size_t o = ((size_t)ldg * SG + ch) * 128;
            SC[o + p] = (bf16)(cvt_pk_bf16(c_re[ci], 0.f) & 0xffffu); SC[o + 64 + p] = (bf16)(cvt_pk_bf16(-c_im[ci], 0.f) & 0xffffu); }
    }
    const float* gws = as_global(args.in[16]); bf16* GWS = (bf16*)(ws + WS_GWS);
    for (int i = gtid; i < DEPTH * 8 * 128 * 128 / 2; i += gthreads) ((unsigned*)GWS)[i] = cvt_pk_bf16(gws[2 * i], gws[2 * i + 1]);
}

__device__ __forceinline__ void p0_mod(const Args& args, LAS unsigned char* lds, int wid, int lane, int tid, int G, int bx) {
    LAS float* sv = (LAS float*)lds;
    LAS float* red = (LAS float*)(lds + 49152);
    const float *c = as_global(args.in[1]), *cctx = as_global(args.in[3]);
    for (int i = tid; i < 3 * D; i += 512) { const float v = i < 2 * D ? c[i] : cctx[i - 2 * D]; sv[i] = silu_f(v); }
    __syncthreads();
    float* modv = (float*)(args.ws + WS_MOD);
    constexpr int NCB = NMODC / 256;
    for (int u = bx; u < DEPTH * NCB; u += G) {
        const int l = u / NCB, cb = u % NCB;
        const float* W = as_global(args.in[4]) + (size_t)l * D * NMODC + (size_t)cb * 256 + 4 * lane;
        f32x4 a0 = {0.f, 0.f, 0.f, 0.f}, a1 = a0, a2 = a0;
        const int kbeg = wid * 512;
        for (int k = kbeg; k < kbeg + 512; k += 8) {
            f32x4 w[8];
#pragma unroll
            for (int i = 0; i < 8; ++i) w[i] = __builtin_nontemporal_load((const f32x4*)(W + (size_t)(k + i) * NMODC));
#pragma unroll
            for (int i = 0; i < 8; ++i) { a0 += w[i] * sv[k + i]; a1 += w[i] * sv[D + k + i]; a2 += w[i] * sv[2 * D + k + i]; }
        }
        *(LAS f32x4*)(red + (wid * 3 + 0) * 256 + 4 * lane) = a0; *(LAS f32x4*)(red + (wid * 3 + 1) * 256 + 4 * lane) = a1; *(LAS f32x4*)(red + (wid * 3 + 2) * 256 + 4 * lane) = a2;
        __syncthreads();
        for (int o = tid; o < 768; o += 512) { const int s = o >> 8, cc = o & 255; float sum = 0.f;
#pragma unroll
            for (int w8 = 0; w8 < 8; ++w8) sum += red[(w8 * 3 + s) * 256 + cc];
            modv[(size_t)(l * 3 + s) * NMODC + cb * 256 + cc] = sum + as_global(args.in[5])[(size_t)l * NMODC + cb * 256 + cc]; }
        __syncthreads();
    }
}

__device__ __forceinline__ void p0_weights(const Args& args, LAS unsigned char* lds, int wid, int lane, int G, int bx) {
    LAS float* scr = (LAS float*)(lds + wid * 16384);
    const int gw = bx * 8 + wid, NGW = G * 8;
    constexpr int I_FI = (D / 64) * (2 * DFF / 32), I_FO = (DFF / 64) * (D / 32), I_IN = (D / 64) * (NIN / 32), I_GL = (SSW / 64) * (SSW / 32), I_PA = (GMW / 64) * (D / 32), I_PB = (AW / 64) * (D / 32), I_PC = (SSW / 64) * (D / 32), I_O = (D / 64) * (D / 32);
    constexpr int PER_L = 2 * I_FI + 2 * I_FO + I_IN + I_GL + I_PA + I_PB + I_PC + I_O;
    constexpr int TOTAL = DEPTH * PER_L, MODU = (D * 256 * 4) / (12 * 1024) / 8;
    const int nheavy = (DEPTH * (NMODC / 256) > G && DEPTH * (NMODC / 256) < 2 * G) ? DEPTH * (NMODC / 256) - G : 0;
    const int X = nheavy > 0 && TOTAL > MODU * 8 * (G - nheavy) ? TOTAL - MODU * 8 * (G - nheavy) : TOTAL;
    for (int pass = 0; pass < 2; ++pass) {
        int it0, step;
        if (pass == 0) { it0 = gw; step = NGW; } else { if (bx < nheavy) break; it0 = X + (bx - nheavy) * 8 + wid; step = (G - nheavy) * 8; }
        const int itend = pass == 0 ? X : TOTAL;
    for (int it = it0; it < itend; it += step) {
        const int l = it / PER_L; int r = it % PER_L;
        unsigned char* wl = args.ws + WS_W + (size_t)l * LW_BYTES;
        if (r < I_FI) { transpose_matrix_items(as_global(args.in[8]) + (size_t)l * D * 2 * DFF, D, 2 * DFF, (bf16*)(wl + LW_W1IN), D, 1, r, scr, lane); continue; } r -= I_FI;
        if (r < I_FO) { transpose_matrix_items(as_global(args.in[9]) + (size_t)l * DFF * D, DFF, D, (bf16*)(wl + LW_W1OUT), DFF, 0, r, scr, lane); continue; } r -= I_FO;
        if (r < I_FI) { transpose_matrix_items(as_global(args.in[10]) + (size_t)l * D * 2 * DFF, D, 2 * DFF, (bf16*)(wl + LW_W2IN), D, 1, r, scr, lane); continue; } r -= I_FI;
        if (r < I_FO) { transpose_matrix_items(as_global(args.in[11]) + (size_t)l * DFF * D, DFF, D, (bf16*)(wl + LW_W2OUT), DFF, 0, r, scr, lane); continue; } r -= I_FO;
        if (r < I_IN) { transpose_matrix_items(as_global(args.in[12]) + (size_t)l * D * NIN, D, NIN, (bf16*)(wl + LW_WIN), D, 2, r, scr, lane, wl + LW_W8); continue; } r -= I_IN;
        if (r < I_GL) { transpose_matrix_items(as_global(args.in[26]) + (size_t)l * SSW * SSW, SSW, SSW, (bf16*)(wl + LW_WGLU), SSW, 0, r, scr, lane); continue; } r -= I_GL;
        if (r < I_PA) { transpose_matrix_items(as_global(args.in[28]) + (size_t)l * GMW * D, GMW, D, (bf16*)(wl + LW_WCAT), D, 0, r, scr, lane); continue; } r -= I_PA;
        if (r < I_PB) { transpose_matrix_items(as_global(args.in[29]) + (size_t)l * AW * D, AW, D, (bf16*)(wl + LW_WCAT) + GMW, D, 0, r, scr, lane); continue; } r -= I_PB;
        if (r < I_PC) { transpose_matrix_items(as_global(args.in[30]) + (size_t)l * SSW * D, SSW, D, (bf16*)(wl + LW_WCAT) + GMW + AW, D, 0, r, scr, lane); continue; } r -= I_PC;
        transpose_matrix_items(as_global(args.in[31]) + (size_t)l * D * D, D, D, (bf16*)(wl + LW_WO), D, 0, r, scr, lane);
    }
    }
}

__device__ __forceinline__ void thin_phase(int mode, const float* xin, const float* cin, float* X, const bf16* Y, const float* lng, const float* lnb, const float* modl, int sh_i, int sc_i, bf16* H, float* outp, int mrows, int gw, int NGW, int lane, LAS float* vl, int tid, unsigned char* H8 = nullptr, int row_lo = 0) {
    for (int i = tid; i < D / 4; i += 512) { const int c4 = 4 * i;
        if (mode != 0) { *(LAS f32x4*)(vl + c4) = *(const f32x4*)(lng + c4); *(LAS f32x4*)(vl + D + c4) = *(const f32x4*)(lnb + c4); }
        if (mode != 2) {
#pragma unroll
            for (int sx = 0; sx < 3; ++sx) { *(LAS f32x4*)(vl + (2 + sx) * D + c4) = *(const f32x4*)(modl + (size_t)(sx * NMOD + sh_i) * D + c4); *(LAS f32x4*)(vl + (5 + sx) * D + c4) = *(const f32x4*)(modl + (size_t)(sx * NMOD + sc_i) * D + c4) + 1.0f; } } }
    __syncthreads();
    if (row_lo + gw >= mrows) return;
    f32x4 v[16]; u32x2 y[16];
#define THIN_LOAD(dst, dsty, r) do { if (xin) { const float* src_ = (r) < ML ? xin + (size_t)(r) * D : cin + (size_t)((r) - ML) * D; \
        _Pragma("unroll") for (int j = 0; j < 16; ++j) dst[j] = __builtin_nontemporal_load((const f32x4*)(src_ + 256 * j + 4 * lane)); } \
        else { const unsigned* src_ = (const unsigned*)X + (size_t)(r) * (5 * D / 8); \
        _Pragma("unroll") for (int s_ = 0; s_ < 2; ++s_) { unsigned w_[20]; \
            _Pragma("unroll") for (int g = 0; g < 5; ++g) { const u32x4 t_ = __builtin_nontemporal_load((const u32x4*)(src_ + 256 * (5 * s_ + g) + 4 * lane)); w_[4 * g] = t_.x; w_[4 * g + 1] = t_.y; w_[4 * g + 2] = t_.z; w_[4 * g + 3] = t_.w; } \
            _Pragma("unroll") for (int p_ = 0; p_ < 4; ++p_) { const unsigned d0 = w_[5 * p_], d1 = w_[5 * p_ + 1], d2 = w_[5 * p_ + 2], d3 = w_[5 * p_ + 3], d4 = w_[5 * p_ + 4]; const int j0 = 8 * s_ + 2 * p_; \
                dst[j0][0] = __uint_as_float(d0 << 12); dst[j0][1] = __uint_as_float(__builtin_amdgcn_alignbit(d1, d0, 20) << 12); dst[j0][2] = __uint_as_float((d1 >> 8) << 12); dst[j0][3] = __uint_as_float(__builtin_amdgcn_alignbit(d2, d1, 28) << 12); \
                dst[j0 + 1][0] = __uint_as_float(__builtin_amdgcn_alignbit(d3, d2, 16) << 12); dst[j0 + 1][1] = __uint_as_float((d3 >> 4) << 12); dst[j0 + 1][2] = __uint_as_float(__builtin_amdgcn_alignbit(d4, d3, 24) << 12); dst[j0 + 1][3] = __uint_as_float(d4 & 0xfffff000u); } } } \
        if (mode != 0) { _Pragma("unroll") for (int j = 0; j < 16; ++j) dsty[j] = __builtin_nontemporal_load((const u32x2*)(Y + (size_t)(r) * D + 256 * j + 4 * lane)); } } while (0)
    for (int row = row_lo + gw; row < mrows; row += NGW) {
        THIN_LOAD(v, y, row);
        if (mode != 0) {
            float s = 0.f;
#pragma unroll
            for (int j = 0; j < 16; ++j) { v[j] = v[j] * ALPHA + (f32x4){bf_lo(y[j].x), bf_hi(y[j].x), bf_lo(y[j].y), bf_hi(y[j].y)}; s += (v[j][0] + v[j][1]) + (v[j][2] + v[j][3]); }
            const float mean = wave_sum(s) * (1.0f / D); float q = 0.f;
#pragma unroll
            for (int j = 0; j < 16; ++j) { v[j] = v[j] - mean; q += (v[j][0] * v[j][0] + v[j][1] * v[j][1]) + (v[j][2] * v[j][2] + v[j][3] * v[j][3]); }
            const float rstd = 1.0f / sqrtf(wave_sum(q) * (1.0f / D) + LN_EPS);
#pragma unroll
            for (int j = 0; j < 16; ++j) { const f32x4 g = *(const LAS f32x4*)(vl + 256 * j + 4 * lane), b = *(const LAS f32x4*)(vl + D + 256 * j + 4 * lane); v[j] = v[j] * rstd * g + b; }
            if (mode == 2) { float* dst = outp + (size_t)row * D;
#pragma unroll
                for (int j = 0; j < 16; ++j) __builtin_nontemporal_store(v[j], (f32x4*)(dst + 256 * j + 4 * lane)); }
            else { unsigned* dst = (unsigned*)X + (size_t)row * (5 * D / 8);
#pragma unroll
                for (int s_ = 0; s_ < 2; ++s_) { unsigned w_[20];
#pragma unroll
                    for (int p_ = 0; p_ < 4; ++p_) { const int j0 = 8 * s_ + 2 * p_; unsigned f[8];
#pragma unroll
                        for (int e = 0; e < 8; ++e) f[e] = (__float_as_uint(v[j0 + (e >> 2)][e & 3]) + 0x800u) >> 12;
                        w_[5 * p_] = f[0] | (f[1] << 20); w_[5 * p_ + 1] = (f[1] >> 12) | (f[2] << 8) | (f[3] << 28); w_[5 * p_ + 2] = (f[3] >> 4) | (f[4] << 16);
                        w_[5 * p_ + 3] = (f[4] >> 16) | (f[5] << 4) | (f[6] << 24); w_[5 * p_ + 4] = (f[6] >> 8) | (f[7] << 12); }
#pragma unroll
                    for (int g = 0; g < 5; ++g) { u32x4 t_; t_.x = w_[4 * g]; t_.y = w_[4 * g + 1]; t_.z = w_[4 * g + 2]; t_.w = w_[4 * g + 3]; __builtin_nontemporal_store(t_, (u32x4*)(dst + 256 * (5 * s_ + g) + 4 * lane)); } } }
        }
        if (mode != 2) {
            float s = 0.f;
#pragma unroll
            for (int j = 0; j < 16; ++j) s += (v[j][0] + v[j][1]) + (v[j][2] + v[j][3]);
            const float mean = wave_sum(s) * (1.0f / D); float q = 0.f;
#pragma unroll
            for (int j = 0; j < 16; ++j) { v[j] = v[j] - mean; q += (v[j][0] * v[j][0] + v[j][1] * v[j][1]) + (v[j][2] * v[j][2] + v[j][3] * v[j][3]); }
            const float rstd = 1.0f / sqrtf(wave_sum(q) * (1.0f / D) + LN_EPS);
            const int sidx = row < SEQ ? 0 : (row < ML ? 1 : 2);
            const LAS float* shp = vl + (2 + sidx) * D; const LAS float* scp = vl + (5 + sidx) * D;
#pragma unroll
            for (int j = 0; j < 16; ++j) { const f32x4 sh = *(const LAS f32x4*)(shp + 256 * j + 4 * lane), sc = *(const LAS f32x4*)(scp + 256 * j + 4 * lane);
                const f32x4 h = v[j] * rstd * sc + sh; u32x2 w; w.x = cvt_pk_bf16(h[0], h[1]); w.y = cvt_pk_bf16(h[2], h[3]);
                *(u32x2*)(H + (size_t)row * D + 256 * j + 4 * lane) = w;
                if (H8) { const f32x4 q = __builtin_elementwise_min(__builtin_elementwise_max(h * 8.f, (f32x4){-448.f, -448.f, -448.f, -448.f}), (f32x4){448.f, 448.f, 448.f, 448.f});
                    int w8 = __builtin_amdgcn_cvt_pk_fp8_f32(q[0], q[1], 0, false); w8 = __builtin_amdgcn_cvt_pk_fp8_f32(q[2], q[3], w8, true); *(unsigned*)(H8 + (size_t)row * D + 256 * j + 4 * lane) = (unsigned)w8; } }
        }
    }
#undef THIN_LOAD
}

constexpr int AT_KP = 272, AT_VP = 320, AT_VOFF = 64 * AT_KP, AT_BUF = AT_VOFF + 64 * AT_VP, AT_BOFF = 2 * AT_BUF + 256;
__device__ __forceinline__ int clampi(int v, int lo, int hi) { return v < lo ? lo : (v > hi ? hi : v); }
template <int OFF> __device__ __forceinline__ void tr_read_v4(unsigned base, bf16x8 (&f)[4]) {
    s16x4 l0, h0, l1, h1, l2, h2, l3, h3;
    asm volatile("ds_read_b64_tr_b16 %0, %8 offset:%9\n\tds_read_b64_tr_b16 %1, %8 offset:%10\n\tds_read_b64_tr_b16 %2, %8 offset:%11\n\tds_read_b64_tr_b16 %3, %8 offset:%12\n\t"
                 "ds_read_b64_tr_b16 %4, %8 offset:%13\n\tds_read_b64_tr_b16 %5, %8 offset:%14\n\tds_read_b64_tr_b16 %6, %8 offset:%15\n\tds_read_b64_tr_b16 %7, %8 offset:%16\n\ts_waitcnt lgkmcnt(0)"
                 : "=&v"(l0), "=&v"(h0), "=&v"(l1), "=&v"(h1), "=&v"(l2), "=&v"(h2), "=&v"(l3), "=&v"(h3)
                 : "v"(base), "i"(OFF), "i"(OFF + 8 * AT_VP), "i"(OFF + 64), "i"(OFF + 8 * AT_VP + 64), "i"(OFF + 128), "i"(OFF + 8 * AT_VP + 128), "i"(OFF + 192), "i"(OFF + 8 * AT_VP + 192) : "memory");
    f[0] = __builtin_shufflevector(l0, h0, 0, 1, 2, 3, 4, 5, 6, 7); f[1] = __builtin_shufflevector(l1, h1, 0, 1, 2, 3, 4, 5, 6, 7);
    f[2] = __builtin_shufflevector(l2, h2, 0, 1, 2, 3, 4, 5, 6, 7); f[3] = __builtin_shufflevector(l3, h3, 0, 1, 2, 3, 4, 5, 6, 7);
}
__device__ __forceinline__ void attn_unit(LAS unsigned char* lds, const bf16* QP, const bf16* QR, const bf16* KB, const bf16* VB, bf16* ACAT, const float* rpb_l, int b, int h, int r0, int tid, int wid, int lane) {
    const int hl = lane >> 5, l31 = lane & 31;
    const bool isctx = r0 < 0;
    const int r = isctx ? 0 : r0 + (wid >> 1), half = wid & 1;
    const int qrow = isctx ? ML + b * CTXL + 32 * wid + l31 : b * SEQ + r * 64 + 32 * half + l31;
    const int c = 32 * half + l31;
    int lo = 0, nloc = 0;
    if (!isctx) { lo = clampi(r0 - 4, 0, 120); nloc = clampi(r0 - 1, 0, 120) + 7 - lo + 1; }
    const int nt = nloc + 4, rs = clampi(r - 4, 0, 120);
    LAS float* bias = (LAS float*)(lds + AT_BOFF);
    const int skey = tid >> 3, spart = tid & 7;
    u32x4 kreg0, kreg1, vreg0, vreg1;
#define AT_GLOAD(it_) do { const int t_ = (it_); const size_t off = (size_t)((t_ < nloc ? b * SEQ + (lo + t_) * 64 : ML + b * CTXL + 64 * (t_ - nloc)) + skey) * AW + h * HD + 16 * spart; \
        kreg0 = *(const u32x4*)(KB + off); kreg1 = *(const u32x4*)(KB + off + 8); vreg0 = *(const u32x4*)(VB + off); vreg1 = *(const u32x4*)(VB + off + 8); } while (0)
#define AT_LWRITE(buf_) do { LAS unsigned char* kb_ = lds + (buf_) * AT_BUF; *(LAS u32x4*)(kb_ + skey * AT_KP + 32 * spart) = kreg0; *(LAS u32x4*)(kb_ + skey * AT_KP + 32 * spart + 16) = kreg1; \
        *(LAS u32x4*)(kb_ + AT_VOFF + skey * AT_VP + 32 * spart) = vreg0; *(LAS u32x4*)(kb_ + AT_VOFF + skey * AT_VP + 32 * spart + 16) = vreg1; } while (0)
    AT_GLOAD(0);
    bf16x8 qf[8];
    { const bf16* p2 = (isctx ? QP : QR) + (size_t)qrow * AW + h * HD + 8 * hl;
#pragma unroll
      for (int s = 0; s < 8; ++s) qf[s] = *(const bf16x8*)(p2 + 16 * s); }
    const float bias_w = tid < 15 * 31 ? rpb_l[h * 465 + tid] * LOG2E : 0.f;
    __syncthreads();
    if (tid < 15 * 31) bias[tid] = bias_w;
    AT_LWRITE(0);
    AT_GLOAD(1);
    {
#pragma unroll
      for (int s = 0; s < 8; ++s) asm volatile("" : "+v"(qf[s])); }
    f32x16 O[4];
#pragma unroll
    for (int cc = 0; cc < 4; ++cc)
#pragma unroll
        for (int i = 0; i < 16; ++i) O[cc][i] = 0.f;
    float mrun = -1e30f, lrun = 0.f;
    const float SC = 0.08838834764831845f * LOG2E;
    const int blk = (lane >> 4) & 1, q4 = (lane & 15) >> 2, p4 = lane & 3;
    const unsigned vtr0 = lds_addr(lds + AT_VOFF) + (unsigned)((4 * hl + q4) * AT_VP + 32 * blk + 8 * p4);
    __syncthreads();
    for (int it = 0; it < nt; ++it) {
        const int cur = it & 1;
        if (it + 1 < nt) { AT_LWRITE(cur ^ 1); if (it + 2 < nt) AT_GLOAD(it + 2); }
        const bool local = it < nloc; const int kr = lo + it;
        if (!(local && (kr < rs || kr > rs + 7))) {
            LAS unsigned char* kimg = lds + cur * AT_BUF;
            f32x16 s0, s1;
#pragma unroll
            for (int i = 0; i < 16; ++i) { s0[i] = 0.f; s1[i] = 0.f; }
            if (it == nloc && !isctx) {
                const bf16* p = QP + (size_t)qrow * AW + h * HD + 8 * hl;
#pragma unroll
                for (int s = 0; s < 8; ++s) qf[s] = *(const bf16x8*)(p + 16 * s);
#pragma unroll
                for (int s = 0; s < 8; ++s) asm volatile("" : "+v"(qf[s]));
            }
#pragma unroll
            for (int s = 0; s < 8; ++s) { const bf16x8 a0 = *(const LAS bf16x8*)(kimg + l31 * AT_KP + 32 * s + 16 * hl), a1 = *(const LAS bf16x8*)(kimg + (32 + l31) * AT_KP + 32 * s + 16 * hl);
                s0 = MFMA32(a0, qf[s], s0); s1 = MFMA32(a1, qf[s], s1); }
            float tmax = -INFINITY;
            if (local) {
                int cv = c; asm volatile("" : "+v"(cv));
                const int e0 = 4 * hl - clampi(cv - 8, 0, 48);
                const LAS float* bl = bias + ((kr - r + 7) * 31 + 4 * hl - cv + 15);
#pragma unroll
                for (int i = 0; i < 16; ++i) { const int ki = (i & 3) + 8 * (i >> 2);
                    const float x0 = s0[i] * SC + bl[ki], x1 = s1[i] * SC + bl[ki + 32];
                    s0[i] = ((unsigned)(ki + e0) < 16u) ? x0 : -INFINITY; s1[i] = ((unsigned)(ki + 32 + e0) < 16u) ? x1 : -INFINITY;
                    tmax = fmaxf(tmax, fmaxf(s0[i], s1[i])); }
            } else {
#pragma unroll
                for (int i = 0; i < 16; ++i) { s0[i] *= SC; s1[i] *= SC; tmax = fmaxf(tmax, fmaxf(s0[i], s1[i])); }
            }
            tmax = fmaxf(tmax, __shfl_xor(tmax, 32));
            const float mnew = fmaxf(mrun, tmax), alpha = __builtin_amdgcn_exp2f(mrun - mnew); mrun = mnew;
            float psum = 0.f;
#pragma unroll
            for (int i = 0; i < 16; ++i) { s0[i] = __builtin_amdgcn_exp2f(s0[i] - mnew); s1[i] = __builtin_amdgcn_exp2f(s1[i] - mnew); psum += s0[i] + s1[i]; }
            lrun = lrun * alpha + psum;
            if (!__all(alpha == 1.0f)) {
#pragma unroll
                for (int cc = 0; cc < 4; ++cc)
#pragma unroll
                    for (int i = 0; i < 16; ++i) O[cc][i] *= alpha;
            }
            const unsigned vtr = vtr0 + (unsigned)(cur * AT_BUF);
#define AT_PV(S16, SRC, ST) do { bf16x8 pf, vf[4]; PACK_STEP(pf, SRC, ST); tr_read_v4<16 * S16 * AT_VP>(vtr, vf); \
                O[0] = MFMA32(vf[0], pf, O[0]); O[1] = MFMA32(vf[1], pf, O[1]); O[2] = MFMA32(vf[2], pf, O[2]); O[3] = MFMA32(vf[3], pf, O[3]); } while (0)
            if (!(local && half == 1)) AT_PV(0, s0, 0);
            AT_PV(1, s0, 1); AT_PV(2, s1, 0);
            if (!(local && half == 0)) AT_PV(3, s1, 1);
#undef AT_PV
        }
        __syncthreads();
    }
#undef AT_GLOAD
#undef AT_LWRITE
    const float inv = 1.0f / (lrun + __shfl_xor(lrun, 32));
    bf16* orow = ACAT + (size_t)qrow * D + GMW + h * HD + 4 * hl;
#pragma unroll
    for (int cc = 0; cc < 4; ++cc)
#pragma unroll
        for (int g = 0; g < 4; ++g) { u32x2 w; w.x = cvt_pk_bf16(O[cc][4 * g] * inv, O[cc][4 * g + 1] * inv); w.y = cvt_pk_bf16(O[cc][4 * g + 2] * inv, O[cc][4 * g + 3] * inv);
            *(u32x2*)(orow + 32 * cc + 8 * g) = w; }
}

constexpr int GM_IMG = 128 * 96;
__device__ __forceinline__ void gmlp_unit(LAS unsigned char* lds, const bf16* ZB, bf16* ACAT, const float* lng, const float* lnb, const bf16* WSb, const float* bs, int unit, int tid, int wid, int lane) {
    const int chunk = unit >> 1, gh = unit & 1;
    const int hl = lane >> 5, l31 = lane & 31, row0 = 128 * chunk;
    LAS f32x2* stats = (LAS f32x2*)(lds + 8 * GM_IMG);
    __syncthreads();
    {
        u32x4 raw[16][2];
#pragma unroll
        for (int k = 0; k < 16; ++k) { const bf16* p = ZB + (size_t)(row0 + 16 * wid + k) * 2048 + 1024 + 8 * lane; raw[k][0] = *(const u32x4*)p; raw[k][1] = *(const u32x4*)(p + 512); }
#pragma unroll
        for (int k = 0; k < 16; ++k) {
            f32x4 v[4]; unpack8(raw[k][0], v[0], v[1]); unpack8(raw[k][1], v[2], v[3]);
            float s = 0.f;
#pragma unroll
            for (int j = 0; j < 4; ++j) s += (v[j][0] + v[j][1]) + (v[j][2] + v[j][3]);
            const float mean = wave_sum(s) * (1.0f / 1024.0f); float q = 0.f;
#pragma unroll
            for (int j = 0; j < 4; ++j) { const f32x4 d = v[j] - mean; q += (d[0] * d[0] + d[1] * d[1]) + (d[2] * d[2] + d[3] * d[3]); }
            const float rstd = 1.0f / sqrtf(wave_sum(q) * (1.0f / 1024.0f) + LN_EPS);
            if (lane == 0) stats[16 * wid + k] = (f32x2){mean, rstd};
        }
    }
    __syncthreads();
    const int g = 4 * gh + (wid & 3);
    LAS unsigned char* img = lds + wid * GM_IMG;
    const int blk = (lane >> 4) & 1, q4 = (lane & 15) >> 2, p4 = lane & 3;
    const unsigned itr = lds_addr(img) + (unsigned)((8 * hl + q4) * 96 + 32 * blk + 8 * p4);
    const bf16* wbase = WSb + ((size_t)(g * 128 + l31) * 128 + 8 * hl);
    for (int cbi = 0; cbi < 2; ++cbi) {
        const int cbase = 128 * g + 32 * (2 * (wid >> 2) + cbi);
        u32x4 vraw[2][4];
#pragma unroll
        for (int j2 = 0; j2 < 2; ++j2)
#pragma unroll
            for (int k4 = 0; k4 < 4; ++k4) vraw[j2][k4] = *(const u32x4*)(ZB + (size_t)(row0 + lane + 64 * j2) * 2048 + 1024 + cbase + 8 * k4);
        bf16x8 wf[4][4];
#pragma unroll
        for (int s4 = 0; s4 < 4; ++s4)
#pragma unroll
            for (int qb = 0; qb < 4; ++qb) wf[s4][qb] = *(const bf16x8*)(wbase + (size_t)(32 * qb) * 128 + 16 * s4);
#pragma unroll
        for (int j2 = 0; j2 < 2; ++j2) {
            const int p = lane + 64 * j2; const f32x2 st = stats[p];
#pragma unroll
            for (int k4 = 0; k4 < 4; ++k4) {
                f32x4 a, bq; unpack8(vraw[j2][k4], a, bq);
                const f32x4 g0 = *(const f32x4*)(lng + cbase + 8 * k4), g1 = *(const f32x4*)(lng + cbase + 8 * k4 + 4), b0 = *(const f32x4*)(lnb + cbase + 8 * k4), b1 = *(const f32x4*)(lnb + cbase + 8 * k4 + 4);
                a = (a - st.x) * st.y * g0 + b0; bq = (bq - st.x) * st.y * g1 + b1;
                *(LAS u32x4*)(img + p * 96 + 16 * k4) = pg8::pack8(a, bq);
            }
        }
        u32x2 uw[4][4]; float bqv[4];
#pragma unroll
        for (int qb = 0; qb < 4; ++qb) { bqv[qb] = bs[g * 128 + 32 * qb + l31];
#pragma unroll
            for (int gq = 0; gq < 4; ++gq) uw[qb][gq] = *(const u32x2*)(ZB + (size_t)(row0 + 32 * qb + l31) * 2048 + cbase + 8 * gq + 4 * hl); }
        LDS_WAIT();
        f32x16 acc[4];
#pragma unroll
        for (int qb = 0; qb < 4; ++qb)
#pragma unroll
            for (int i = 0; i < 16; ++i) acc[qb][i] = 0.f;
#define GM_STEP(S, WF) do { const bf16x8 vf = tr_read2<16 * S * 96, 16 * S * 96 + 4 * 96>(itr); \
            _Pragma("unroll") for (int qb = 0; qb < 4; ++qb) acc[qb] = MFMA32(vf, WF[S & 3][qb], acc[qb]); } while (0)
        GM_STEP(0, wf); GM_STEP(1, wf); GM_STEP(2, wf); GM_STEP(3, wf);
#pragma unroll
        for (int s4 = 0; s4 < 4; ++s4)
#pragma unroll
            for (int qb = 0; qb < 4; ++qb) wf[s4][qb] = *(const bf16x8*)(wbase + (size_t)(32 * qb) * 128 + 16 * (4 + s4));
        GM_STEP(4, wf); GM_STEP(5, wf); GM_STEP(6, wf); GM_STEP(7, wf);
#undef GM_STEP
#pragma unroll
        for (int qb = 0; qb < 4; ++qb) {
            const int q = 32 * qb + l31; const float bq = bqv[qb];
            const size_t row = (size_t)(row0 + q);
#pragma unroll
            for (int gq = 0; gq < 4; ++gq) { const int col = cbase + 8 * gq + 4 * hl;
                const u32x2 uwv = uw[qb][gq];
                u32x2 w; w.x = cvt_pk_bf16(bf_lo(uwv.x) * (acc[qb][4 * gq] + bq), bf_hi(uwv.x) * (acc[qb][4 * gq + 1] + bq)); w.y = cvt_pk_bf16(bf_lo(uwv.y) * (acc[qb][4 * gq + 2] + bq), bf_hi(uwv.y) * (acc[qb][4 * gq + 3] + bq));
                *(u32x2*)(ACAT + row * D + col) = w; }
        }
        LDS_WAIT();
    }
}

constexpr int S5_WAVE_LDS = 8192 + 16 * 272;
__device__ __forceinline__ void s5_chunk_ids(int ci, int& b, int& n, bool& isctx) { isctx = ci >= 128; if (isctx) { b = (ci - 128) >> 1; n = (ci - 128) & 1; } else { b = ci >> 6; n = ci & 63; } }
__device__ __forceinline__ int s5_scan_index(int d, int n, bool isctx) { return d == 0 ? (isctx ? n : 2 + n) : (isctx ? 1 - n : 2 + (63 - n)); }
__device__ __forceinline__ void s5_load_u(bf16x8 (&ufr)[4], const bf16* US, int row0, int g, int lane) {
#pragma unroll
    for (int tb = 0; tb < 4; ++tb) ufr[tb] = *(const bf16x8*)(US + (size_t)(row0 + 32 * tb + (lane & 31)) * SSW + SG * g + 8 * (lane >> 5));
}
__device__ __forceinline__ void s5_bu(f32x16 (&Dt)[4], const bf16x8 uf, const bf16x8 (&bfr)[4]) {
#pragma unroll
    for (int j = 0; j < 4; ++j) {
#pragma unroll
        for (int i = 0; i < 16; ++i) Dt[j][i] = 0.f;
        Dt[j] = MFMA32(uf, bfr[j], Dt[j]); }
}
template <int H2> __device__ __forceinline__ void s5_bu_to_lds(LAS float* bu, const f32x16 (&Dt)[4], int lane) {
    const int hl = lane >> 5, l31 = lane & 31;
#pragma unroll
    for (int j = 0; j < 4; ++j)
#pragma unroll
        for (int ii = 0; ii < 8; ++ii) { const int i = 8 * H2 + ii, tt = (ii & 3) + 8 * (ii >> 2) + 4 * hl; bu[tt * 128 + 32 * j + l31] = Dt[j][i]; }
    LDS_WAIT();
}
template <bool WRITE_H> __device__ __forceinline__ void s5_scan16(const LAS float* bu, LAS unsigned char* hs, int d, float ar, float ai, float& hr, float& hi, int lane) {
    for (int st = 0; st < 16; ++st) { const int tt = d ? 15 - st : st;
        const float br = bu[tt * 128 + lane], bi = bu[tt * 128 + 64 + lane];
        const float nr = ar * hr - ai * hi + br, ni = ar * hi + ai * hr + bi; hr = nr; hi = ni;
        if (WRITE_H) { const unsigned w = cvt_pk_bf16(hr, hi);
            *(LAS unsigned short*)(hs + tt * 272 + 2 * lane) = (unsigned short)(w & 0xffffu); *(LAS unsigned short*)(hs + tt * 272 + 128 + 2 * lane) = (unsigned short)(w >> 16); } }
    LDS_WAIT();
}
__device__ __forceinline__ void s5_pass1(LAS unsigned char* wl, const bf16* US, const f32x4* SA_l, const bf16* SBB_l, f32x2* HEND, int ci, int g, int lane) {
    LAS float* bu = (LAS float*)wl;
    int b, n; bool isctx; s5_chunk_ids(ci, b, n, isctx);
    const int row0 = 128 * ci;
    bf16x8 ufr[4]; s5_load_u(ufr, US, row0, g, lane);
#pragma unroll
    for (int d = 0; d < 2; ++d) {
        const int k = s5_scan_index(d, n, isctx);
        if (k == NK - 1) continue;
        const f32x4 A = SA_l[(d * NG + g) * NP + lane];
        bf16x8 bfr[4];
#pragma unroll
        for (int j = 0; j < 4; ++j) bfr[j] = *(const bf16x8*)(SBB_l + ((size_t)((d * NG + g) * 128 + 32 * j + (lane & 31)) * SG + 8 * (lane >> 5)));
        float hr = 0.f, hi = 0.f;
#pragma unroll
        for (int tbi = 0; tbi < 4; ++tbi) {
            const int tb = d ? 3 - tbi : tbi;
            f32x16 Dt[4]; s5_bu(Dt, ufr[tb], bfr);
            if (d == 0) { s5_bu_to_lds<0>(bu, Dt, lane); s5_scan16<false>(bu, nullptr, 0, A[0], A[1], hr, hi, lane); s5_bu_to_lds<1>(bu, Dt, lane); s5_scan16<false>(bu, nullptr, 0, A[0], A[1], hr, hi, lane); }
            else        { s5_bu_to_lds<1>(bu, Dt, lane); s5_scan16<false>(bu, nullptr, 1, A[0], A[1], hr, hi, lane); s5_bu_to_lds<0>(bu, Dt, lane); s5_scan16<false>(bu, nullptr, 1, A[0], A[1], hr, hi, lane); }
        }
        HEND[((size_t)((b * 2 + d) * NK + k) * NG + g) * NP + lane] = (f32x2){hr, hi};
    }
}
__device__ __forceinline__ void s5_pass2(LAS unsigned char* wl, const bf16* US, const f32x4* SA_l, const bf16* SBB_l, const bf16* SC_l, const f32x2* HEND, const float* dskip_l, bf16* YS, int ci, int g, int lane) {
    LAS float* bu = (LAS float*)wl; LAS unsigned char* hs = wl + 8192;
    int b, n; bool isctx; s5_chunk_ids(ci, b, n, isctx);
    const int row0 = 128 * ci;
    f32x4 yacc[8];
#pragma unroll
    for (int sb = 0; sb < 8; ++sb) yacc[sb] = (f32x4){0.f, 0.f, 0.f, 0.f};
    const int t16 = lane & 15, kq = lane >> 4;
    bf16x8 ufr[4]; s5_load_u(ufr, US, row0, g, lane);
#define S5_HALF(SB, H2, DIR) do { s5_bu_to_lds<H2>(bu, Dt, lane); s5_scan16<true>(bu, hs, DIR, A[0], A[1], hr, hi, lane); \
        _Pragma("unroll") for (int kb = 0; kb < 4; ++kb) { const bf16x8 hf = *(const LAS bf16x8*)(hs + t16 * 272 + 64 * kb + 16 * kq); yacc[SB] = MFMA16(cf[kb], hf, yacc[SB]); } \
        LDS_WAIT(); } while (0)
#pragma unroll
    for (int d = 0; d < 2; ++d) {
        const int k = s5_scan_index(d, n, isctx);
        const f32x4 A = SA_l[(d * NG + g) * NP + lane];
        bf16x8 bfr[4], cf[4];
#pragma unroll
        for (int j = 0; j < 4; ++j) bfr[j] = *(const bf16x8*)(SBB_l + ((size_t)((d * NG + g) * 128 + 32 * j + (lane & 31)) * SG + 8 * (lane >> 5)));
#pragma unroll
        for (int kb = 0; kb < 4; ++kb) cf[kb] = *(const bf16x8*)(SC_l + ((size_t)((d * NG + g) * SG + t16) * 128 + 32 * kb + 8 * kq));
        float hr = 0.f, hi = 0.f;
        const f32x2* he = HEND + ((size_t)((b * 2 + d) * NK) * NG + g) * NP + lane;
        for (int j0 = 0; j0 < k; j0 += 8) {
            f32x2 e[8];
#pragma unroll
            for (int q = 0; q < 8; ++q) { const int jj = (j0 + q < k) ? j0 + q : k - 1; e[q] = he[(size_t)jj * NG * NP]; }
#pragma unroll
            for (int q = 0; q < 8; ++q) if (j0 + q < k) { const float nr = A[2] * hr - A[3] * hi + e[q].x, ni = A[2] * hi + A[3] * hr + e[q].y; hr = nr; hi = ni; }
        }
        f32x16 Dt[4];
        if (d == 0) {
            s5_bu(Dt, ufr[0], bfr); S5_HALF(0, 0, 0); S5_HALF(1, 1, 0);
            s5_bu(Dt, ufr[1], bfr); S5_HALF(2, 0, 0); S5_HALF(3, 1, 0);
            s5_bu(Dt, ufr[2], bfr); S5_HALF(4, 0, 0); S5_HALF(5, 1, 0);
            s5_bu(Dt, ufr[3], bfr); S5_HALF(6, 0, 0); S5_HALF(7, 1, 0);
        } else {
            s5_bu(Dt, ufr[3], bfr); S5_HALF(7, 1, 1); S5_HALF(6, 0, 1);
            s5_bu(Dt, ufr[2], bfr); S5_HALF(5, 1, 1); S5_HALF(4, 0, 1);
            s5_bu(Dt, ufr[1], bfr); S5_HALF(3, 1, 1); S5_HALF(2, 0, 1);
            s5_bu(Dt, ufr[0], bfr); S5_HALF(1, 1, 1); S5_HALF(0, 0, 1);
        }
    }
#undef S5_HALF
    const f32x4 dsk = *(const f32x4*)(dskip_l + SG * g + 4 * kq);
#pragma unroll
    for (int sb = 0; sb < 8; ++sb) { const int t = 16 * sb + t16; const u32x2 uw = *(const u32x2*)(US + (size_t)(row0 + t) * SSW + SG * g + 4 * kq);
        const f32x4 us4 = {bf_lo(uw.x), bf_hi(uw.x), bf_lo(uw.y), bf_hi(uw.y)};
        f32x4 y = yacc[sb] + dsk * us4;
#pragma unroll
        for (int e = 0; e < 4; ++e) y[e] = gelu_tanh_f(y[e]);
        u32x2 w; w.x = cvt_pk_bf16(y[0], y[1]); w.y = cvt_pk_bf16(y[2], y[3]);
        *(u32x2*)(YS + (size_t)(row0 + t) * SSW + SG * g + 4 * kq) = w; }
}

constexpr int NPH = 2 + 13 * DEPTH;
__global__ void __launch_bounds__(512, 2) fwd_kernel(Args args) {
    extern __shared__ __attribute__((aligned(16))) unsigned char lds_raw[];
    LAS unsigned char* lds = (LAS unsigned char*)lds_raw;
    volatile LAS unsigned* MISC = (volatile LAS unsigned*)(lds + MISC_OFF);
    for (int u = threadIdx.x; u < (LDS_BYTES - LDSCTL_OFF) / 4; u += 512) ((LAS unsigned*)(lds + LDSCTL_OFF))[u] = 0u;
    __syncthreads();
    const int lo = args.ph_lo, hi = args.ph_hi;
    const bool use_bar = (hi - lo) > 1;
    XcdBarrier bar; bar.bar = (unsigned*)(args.ws + WS_CTL) + CW_BAR; bar.x = 0; bar.st = nullptr;
    if (use_bar) bar = xcd_barrier_post((unsigned*)(args.ws + WS_CTL) + CW_BAR, MISC + 8);
#ifndef PH_MASK
#define PH_MASK 0xFFFFFFFFu
#endif
#define IN(k) ((PH_MASK >> ((k) < 2 ? (k) : 2 + ((k) - 2) % 13) & 1u) && lo <= (k) && (k) < hi)
#define SEAM(k) do { if (IN(k) && IN((k) + 1)) xcd_barrier(bar); } while (0)
#define PHASE_IDS() int tid = threadIdx.x; asm volatile("" : "+v"(tid)); const int lane = tid & 63, wid = __builtin_amdgcn_readfirstlane(tid >> 6); \
    int bx = blockIdx.x, G = gridDim.x; asm volatile("" : "+s"(bx), "+s"(G)); GAS unsigned char* wsg_ = (GAS unsigned char*)args.ws; asm volatile("" : "+s"(wsg_)); unsigned char* ws = (unsigned char*)wsg_; const int gw = bx * 8 + wid, NGW = G * 8; (void)lane; (void)gw; (void)NGW
#define X ((float*)(ws + WS_X))
#define H ((bf16*)(ws + WS_H))
#define ACT ((bf16*)(ws + WS_ACT))
#define QP ((bf16*)(ws + WS_QP))
#define QR ((bf16*)(ws + WS_QR))
#define KB ((bf16*)(ws + WS_KB))
#define VB ((bf16*)(ws + WS_VB))
#define ZB ((bf16*)(ws + WS_ZB))
#define US ((bf16*)(ws + WS_US))
#define GB ((bf16*)(ws + WS_GB))
#define ACAT ((bf16*)(ws + WS_ACAT))
#define YS ((bf16*)(ws + WS_YS))
#define MG ((bf16*)(ws + WS_MG))
#define YB ((bf16*)(ws + WS_Y))
#define XSRC_IN (l == 0 ? as_global(args.in[0]) : nullptr)
#define modv ((const float*)(ws + WS_MOD))
#define WL(off) ((const bf16*)(ws + WS_W + (size_t)l * LW_BYTES + (off)))
#define MODL (modv + (size_t)l * 3 * NMODC)
#define LNG(i) (as_global(args.in[6]) + (size_t)(l * 3 + (i)) * D)
#define LNB(i) (as_global(args.in[7]) + (size_t)(l * 3 + (i)) * D)
#define MEFF (l == DEPTH - 1 ? ML : M)
constexpr int NCTXU = (MC / 256) * (D / 256);
#define OVL(mrows_) (use_bar && (mrows_) == M && G >= 4 * NCTXU)

    if (IN(0)) {
        PHASE_IDS();
        p0_tables(args, bx * 512 + tid, G * 512);
        p0_mod(args, lds, wid, lane, tid, G, bx);
        p0_weights(args, lds, wid, lane, G, bx);
        __syncthreads();
    }
    SEAM(0);
    if (IN(1)) { PHASE_IDS(); thin_phase(0, as_global(args.in[0]), as_global(args.in[2]), X, nullptr, nullptr, nullptr, modv, 0, 1, H, nullptr, M, gw, NGW, lane, (LAS float*)lds, tid); }
    SEAM(1);

    for (int l = 0; l < DEPTH; ++l) {
        const int pb = 2 + 13 * l;
        if (pb >= hi || pb + 13 <= lo) continue;
        if (IN(pb + 0)) { PHASE_IDS(); pg8::Gemm g{H, WL(LW_W1IN), M, 2 * DFF, D, D, D}; pg8::StaticOrder S; S.init(M, 2 * DFF, G, bx, D); pg8::EpiSwiGLU E{ACT, DFF};
            pg8::gemm_phase<pg8::EpiSwiGLU, pg8::StaticOrder>(lds, g, S, E, tid); }
        SEAM(pb + 0);
        if (IN(pb + 1)) { PHASE_IDS(); const int mr = OVL(M) ? ML : M; pg8::Gemm g{ACT, WL(LW_W1OUT), mr, D, DFF, DFF, DFF}; pg8::StaticOrder S; S.init(mr, D, G, bx, DFF); pg8::EpiY E{YB, MODL, 2, 0.5f};
            pg8::gemm_phase<pg8::EpiY, pg8::StaticOrder>(lds, g, S, E, tid); }
        SEAM(pb + 1);
        if (IN(pb + 2)) { PHASE_IDS();
            if (OVL(M)) {
                if (bx < NCTXU) { pg8::Gemm g{ACT, WL(LW_W1OUT), M, D, DFF, DFF, DFF}; pg8::CtxOrder S; S.init(D, bx, DFF); pg8::EpiY E{YB, MODL, 2, 0.5f}; pg8::gemm_phase<pg8::EpiY, pg8::CtxOrder>(lds, g, S, E, tid); }
                else thin_phase(1, XSRC_IN, as_global(args.in[2]), X, YB, LNG(0), LNB(0), MODL, 3, 4, H, nullptr, ML, (bx - NCTXU) * 8 + wid, (G - NCTXU) * 8, lane, (LAS float*)lds, tid, (unsigned char*)ACT);
                xcd_barrier(bar);
                thin_phase(1, XSRC_IN, as_global(args.in[2]), X, YB, LNG(0), LNB(0), MODL, 3, 4, H, nullptr, M, gw, NGW, lane, (LAS float*)lds, tid, (unsigned char*)ACT, ML);
            } else thin_phase(1, XSRC_IN, as_global(args.in[2]), X, YB, LNG(0), LNB(0), MODL, 3, 4, H, nullptr, M, gw, NGW, lane, (LAS float*)lds, tid, (unsigned char*)ACT); }
        SEAM(pb + 2);
        if (IN(pb + 3)) {
            { PHASE_IDS(); pg8::Gemm g{H, WL(LW_WIN), M, 36 * 256, D, D, D}; pg8::StaticOrder S; S.init(M, 36 * 256, G, bx, D);
              pg8::EpiIn<false> E{ws, (const float*)(ws + WS_ROPE), 0, 1.0f};
              pg8::gemm_phase<pg8::EpiIn<false>, pg8::StaticOrder>(lds, g, S, E, tid); }
            { PHASE_IDS(); pg8::Gemm g{ACT, WL(LW_W8), MEFF, 48 * 256, D / 2, D / 2, D / 2}; pg8::StaticOrder S; S.init(MEFF, 48 * 256, G, (bx + G / 2) % G, D / 2);
              pg8::EpiIn<true> E{ws, (const float*)(ws + WS_ROPE), 36, 1.0f / 16384.0f};
              pg8::gemm_phase<pg8::EpiIn<true>, pg8::StaticOrder>(lds, g, S, E, tid); }
        }
        SEAM(pb + 3);
#ifndef M1_MASK
#define M1_MASK 7
#endif
        if (IN(pb + 4)) {
            if (M1_MASK & 1) { PHASE_IDS();
                const float* rpb_l = as_global(args.in[13]) + (size_t)l * NH * 465;
                for (int u = bx; u < (l == DEPTH - 1 ? 1024 : 1056); u += G) {
                    if (u < 1024) { const int rb = u & 31, h = (u >> 5) & 15, b = u >> 9; attn_unit(lds, QP, QR, KB, VB, ACAT, rpb_l, b, h, 4 * rb, tid, wid, lane); }
                    else { const int v = u - 1024; attn_unit(lds, QP, QR, KB, VB, ACAT, rpb_l, v >> 4, v & 15, -1, tid, wid, lane); }
                }
                __syncthreads(); }
            if (M1_MASK & 2) { PHASE_IDS();
                for (int u = (G - 1 - bx); u < 2 * (MEFF / 128); u += G)
                    gmlp_unit(lds, ZB, ACAT, as_global(args.in[14]) + (size_t)l * GMW, as_global(args.in[15]) + (size_t)l * GMW, (const bf16*)(ws + WS_GWS) + (size_t)l * 8 * 128 * 128, as_global(args.in[17]) + (size_t)l * 8 * 128, u, tid, wid, lane);
                __syncthreads(); }
            if (M1_MASK & 4) { PHASE_IDS();
                for (int u = gw; u < NCH * NG; u += NGW)
                    s5_pass1(lds + wid * S5_WAVE_LDS, US, (const f32x4*)(ws + WS_SA) + (size_t)l * 2 * NG * NP, (const bf16*)(ws + WS_SBB) + (size_t)l * 2 * NG * 128 * SG, (f32x2*)(ws + WS_HEND), u >> 6, u & 63, lane);
                __syncthreads(); }
        }
        SEAM(pb + 4);
        if (IN(pb + 5)) { PHASE_IDS();
            for (int u = gw; u < (MEFF / 128) * NG; u += NGW)
                s5_pass2(lds + wid * S5_WAVE_LDS, US, (const f32x4*)(ws + WS_SA) + (size_t)l * 2 * NG * NP, (const bf16*)(ws + WS_SBB) + (size_t)l * 2 * NG * 128 * SG, (const bf16*)(ws + WS_SC) + (size_t)l * 2 * NG * SG * 128,
                         (const f32x2*)(ws + WS_HEND), as_global(args.in[25]) + (size_t)l * SSW, YS, u >> 6, u & 63, lane);
            __syncthreads();
        }
        SEAM(pb + 5);
        if (IN(pb + 6)) { PHASE_IDS(); pg8::Gemm g{YS, WL(LW_WGLU), MEFF, SSW, SSW, SSW, SSW}; pg8::StaticOrder S; S.init(MEFF, SSW, G, bx, SSW); pg8::EpiGLU E{YS, ACAT + GMW + AW, as_global(args.in[27]) + (size_t)l * SSW};
            pg8::gemm_phase<pg8::EpiGLU, pg8::StaticOrder>(lds, g, S, E, tid); }
        SEAM(pb + 6);
        if (IN(pb + 7)) { PHASE_IDS(); pg8::Gemm g{ACAT, WL(LW_WCAT), MEFF, D, D, D, D}; pg8::MergeOrder S; S.init(MEFF, D, G, bx); pg8::EpiMerge1 E{GB, MG};
            pg8::gemm_phase<pg8::EpiMerge1, pg8::MergeOrder>(lds, g, S, E, tid); }
        SEAM(pb + 7);
        if (IN(pb + 8)) { PHASE_IDS(); const int mr = OVL(MEFF) ? ML : MEFF; pg8::Gemm g{MG, WL(LW_WO), mr, D, D, D, D}; pg8::StaticOrder S; S.init(mr, D, G, bx, D); pg8::EpiY E{YB, MODL, 5, 1.0f};
            pg8::gemm_phase<pg8::EpiY, pg8::StaticOrder>(lds, g, S, E, tid); }
        SEAM(pb + 8);
        if (IN(pb + 9)) { PHASE_IDS();
            if (OVL(MEFF)) {
                if (bx < NCTXU) { pg8::Gemm g{MG, WL(LW_WO), M, D, D, D, D}; pg8::CtxOrder S; S.init(D, bx, D); pg8::EpiY E{YB, MODL, 5, 1.0f}; pg8::gemm_phase<pg8::EpiY, pg8::CtxOrder>(lds, g, S, E, tid); }
                else thin_phase(1, nullptr, nullptr, X, YB, LNG(1), LNB(1), MODL, 6, 7, H, nullptr, ML, (bx - NCTXU) * 8 + wid, (G - NCTXU) * 8, lane, (LAS float*)lds, tid);
                xcd_barrier(bar);
                thin_phase(1, nullptr, nullptr, X, YB, LNG(1), LNB(1), MODL, 6, 7, H, nullptr, M, gw, NGW, lane, (LAS float*)lds, tid, nullptr, ML);
            } else thin_phase(1, nullptr, nullptr, X, YB, LNG(1), LNB(1), MODL, 6, 7, H, nullptr, MEFF, gw, NGW, lane, (LAS float*)lds, tid); }
        SEAM(pb + 9);
        if (IN(pb + 10)) { PHASE_IDS(); pg8::Gemm g{H, WL(LW_W2IN), MEFF, 2 * DFF, D, D, D}; pg8::StaticOrder S; S.init(MEFF, 2 * DFF, G, bx, D); pg8::EpiSwiGLU E{ACT, DFF};
            pg8::gemm_phase<pg8::EpiSwiGLU, pg8::StaticOrder>(lds, g, S, E, tid); }
        SEAM(pb + 10);
        if (IN(pb + 11)) { PHASE_IDS(); const int mr = OVL(MEFF) ? ML : MEFF; pg8::Gemm g{ACT, WL(LW_W2OUT), mr, D, DFF, DFF, DFF}; pg8::StaticOrder S; S.init(mr, D, G, bx, DFF); pg8::EpiY E{YB, MODL, 8, 0.5f};
            pg8::gemm_phase<pg8::EpiY, pg8::StaticOrder>(lds, g, S, E, tid); }
        SEAM(pb + 11);
        if (IN(pb + 12)) { PHASE_IDS();
            if (l + 1 < DEPTH && OVL(M)) {
                if (bx < NCTXU) { pg8::Gemm g{ACT, WL(LW_W2OUT), M, D, DFF, DFF, DFF}; pg8::CtxOrder S; S.init(D, bx, DFF); pg8::EpiY E{YB, MODL, 8, 0.5f}; pg8::gemm_phase<pg8::EpiY, pg8::CtxOrder>(lds, g, S, E, tid); }
                else thin_phase(1, nullptr, nullptr, X, YB, LNG(2), LNB(2), MODL + 3 * NMODC, 0, 1, H, nullptr, ML, (bx - NCTXU) * 8 + wid, (G - NCTXU) * 8, lane, (LAS float*)lds, tid);
                xcd_barrier(bar);
                thin_phase(1, nullptr, nullptr, X, YB, LNG(2), LNB(2), MODL + 3 * NMODC, 0, 1, H, nullptr, M, gw, NGW, lane, (LAS float*)lds, tid, nullptr, ML);
            } else if (l + 1 < DEPTH) thin_phase(1, nullptr, nullptr, X, YB, LNG(2), LNB(2), MODL + 3 * NMODC, 0, 1, H, nullptr, M, gw, NGW, lane, (LAS float*)lds, tid);
            else thin_phase(2, nullptr, nullptr, X, YB, LNG(2), LNB(2), MODL, 0, 1, H, as_global(args.out), ML, gw, NGW, lane, (LAS float*)lds, tid);
        }
        SEAM(pb + 12);
    }
}

extern "C" void kernel_launch(void* const* d_in, const int* in_sizes, int n_in, void* d_out, int out_size, void* d_ws, size_t ws_size, hipStream_t stream) {
    static int grid = 0;
    if (grid == 0) {
        if (n_in != 32 || out_size != ML * D || ws_size < WS_END) { fprintf(stderr, "kernel_launch: unexpected sizes (n_in %d, out %d, ws %zu, need %zu)\n", n_in, out_size, ws_size, (size_t)WS_END); grid = -1; return; }
        int dev = 0, cus = 0, per_cu = 0;
        if (hipGetDevice(&dev) != hipSuccess || hipDeviceGetAttribute(&cus, hipDeviceAttributeMultiprocessorCount, dev) != hipSuccess) { grid = -1; return; }
        if (hipFuncSetAttribute((const void*)fwd_kernel, hipFuncAttributeMaxDynamicSharedMemorySize, LDS_BYTES) != hipSuccess) { fprintf(stderr, "kernel_launch: hipFuncSetAttribute failed\n"); grid = -1; return; }
        if (hipOccupancyMaxActiveBlocksPerMultiprocessor(&per_cu, (const void*)fwd_kernel, 512, LDS_BYTES) != hipSuccess || per_cu < 1) fprintf(stderr, "kernel_launch: occupancy query says %d\n", per_cu);
        (void)hipGetLastError();
        grid = cus;
    }
    if (grid < 0) return;
    (void)hipMemsetAsync((char*)d_ws + WS_CTL, 0, CTL_ZERO_BYTES, stream);
    Args a{};
    for (int i = 0; i < 32; ++i) a.in[i] = (const float*)d_in[i];
    a.out = (float*)d_out; a.ws = (unsigned char*)d_ws;
#if MK_N_LAUNCHES == 1
    a.ph_lo = 0; a.ph_hi = NPH;
    hipLaunchKernelGGL(fwd_kernel, dim3(grid), dim3(512), LDS_BYTES, stream, a);
#else
    for (int p = 0; p < NPH; ++p) { a.ph_lo = p; a.ph_hi = p + 1; hipLaunchKernelGGL(fwd_kernel, dim3(grid), dim3(512), LDS_BYTES, stream, a); }
#endif
}
```

```cpp
#include <hip/hip_runtime.h>
#include <cstdio>
#include <cstdint>

#ifndef MK_N_LAUNCHES
#define MK_N_LAUNCHES 1
#endif

#define GAS __attribute__((address_space(1)))
#define LAS __attribute__((address_space(3)))
typedef unsigned short bf16;
typedef short bf16x8 __attribute__((ext_vector_type(8)));
typedef short s16x4 __attribute__((ext_vector_type(4)));
typedef float f32x2 __attribute__((ext_vector_type(2)));
typedef float f32x4 __attribute__((ext_vector_type(4)));
typedef float f32x16 __attribute__((ext_vector_type(16)));
typedef unsigned u32x2 __attribute__((ext_vector_type(2)));
typedef unsigned u32x4 __attribute__((ext_vector_type(4)));

constexpr int D = 4096, NB = 2, SEQ = 8192, CTXL = 256, DEPTH = 2;
constexpr int ML = NB * SEQ, MC = NB * CTXL, M = ML + MC;
constexpr int DFF = 6144, NMOD = 9, NMODC = NMOD * D;
constexpr int AW = 2048, NH = 16, HD = 128, GMW = 1024, SSW = 1024, NG = 64, NP = 64, SG = 16;
constexpr int NIN = 21504;
constexpr int NCH = M / 128;
constexpr int NK = 66;
constexpr float ALPHA = 1.4142135623730951f, LN_EPS = 1e-6f, LOG2E = 1.4426950408889634f;

constexpr size_t MiB = 1u << 20;
constexpr size_t WS_CTL = 0, CTL_ZERO_BYTES = 1 * MiB;
constexpr size_t WS_MOD = 1 * MiB;
constexpr size_t WS_ROPE = 2 * MiB;
constexpr size_t WS_SA = 3 * MiB;
constexpr size_t WS_SBB = 4 * MiB;
constexpr size_t WS_SC = 6 * MiB;
constexpr size_t WS_GWS = 7 * MiB;
constexpr size_t WS_HEND = 8 * MiB;
constexpr size_t WS_W = 32 * MiB;
constexpr size_t LW_W1IN = 0, LW_W1OUT = 96 * MiB, LW_W2IN = 144 * MiB, LW_W2OUT = 240 * MiB, LW_WIN = 288 * MiB, LW_WGLU = 456 * MiB, LW_WCAT = 458 * MiB, LW_WO = 490 * MiB, LW_W8 = 522 * MiB  , LW_BYTES = 570 * MiB;
constexpr size_t WS_X = WS_W + 2 * LW_BYTES;
constexpr size_t WS_H = WS_X + 264 * MiB;
constexpr size_t WS_ACT = WS_H + 132 * MiB;
constexpr size_t WS_QP = WS_ACT + 198 * MiB;
constexpr size_t WS_QR = WS_QP + 66 * MiB;
constexpr size_t WS_KB = WS_QR + 66 * MiB;
constexpr size_t WS_VB = WS_KB + 66 * MiB;
constexpr size_t WS_ZB = WS_VB + 66 * MiB;
constexpr size_t WS_US = WS_ZB + 66 * MiB;
constexpr size_t WS_GB = WS_US + 33 * MiB;
constexpr size_t WS_ACAT = WS_GB + 396 * MiB;
constexpr size_t WS_YS = WS_ACAT + 132 * MiB;
constexpr size_t WS_MG = WS_YS + 33 * MiB;
constexpr size_t WS_Y = WS_MG + 132 * MiB;
constexpr size_t WS_END = WS_Y + 132 * MiB;
constexpr int CW_BAR = 4096;

constexpr int RING_BYTES = 131072, LDSCTL_OFF = RING_BYTES, MISC_OFF = LDSCTL_OFF + 320, LDS_BYTES = 147456;

__device__ __forceinline__ unsigned cvt_pk_bf16(float lo, float hi) { unsigned r; asm volatile("v_cvt_pk_bf16_f32 %0, %1, %2" : "=v"(r) : "v"(lo), "v"(hi)); return r; }
__device__ __forceinline__ float bf_lo(unsigned w) { return __uint_as_float(w << 16); }
__device__ __forceinline__ float bf_hi(unsigned w) { return __uint_as_float(w & 0xffff0000u); }
__device__ __forceinline__ float fast_sigmoid(float x) { return __builtin_amdgcn_rcpf(1.0f + __builtin_amdgcn_exp2f(-LOG2E * x)); }
__device__ __forceinline__ float silu_f(float x) { return x * fast_sigmoid(x); }
__device__ __forceinline__ float gelu_tanh_f(float x) { const float u = 1.5957691216057308f * (x + 0.044715f * x * x * x); return x * fast_sigmoid(u); }
template <class T> __device__ __forceinline__ T* as_global(T* p) { return (T*)(GAS T*)p; }
#define LDS_WAIT() asm volatile("s_waitcnt lgkmcnt(0)" ::: "memory")
#define VM_WAIT() asm volatile("s_waitcnt vmcnt(0)" ::: "memory")

namespace pg8 {
constexpr int BM = 256, BK = 64, HALF = 128, HTB = HALF * BK * 2, STAGE_BYTES = 8 * HTB, NXCD = 8, WGM = 4;
__host__ __device__ __forceinline__ int lds_byte(int r, int c) { const int st = (r >> 4) * 2 + (c >> 5), rr = r & 15, cc = c & 31, ob = rr * 64 + cc * 2; return st * 1024 + (ob ^ (((ob >> 9) & 1) << 5)); }
__host__ __device__ __forceinline__ void stage_rc(int b, int& R, int& C) { const int st = b / 1024, sb = b % 1024, swz = sb ^ (((sb >> 9) & 1) << 5); R = (st >> 1) * 16 + swz / 64; C = (st & 1) * 32 + (swz % 64) / 2; }
__host__ __device__ __forceinline__ int perm32(int rho) { const int n = rho >> 4, i = rho & 15; return 8 * (i >> 2) + 4 * n + (i & 3); }
typedef int v8i __attribute__((ext_vector_type(8)));
typedef int v4i __attribute__((ext_vector_type(4)));
struct Unit { int pm, pn, k0, nt, seg; };
struct Gemm { const bf16* A; const bf16* Bt; int M, N, K, lda, ldb; };
struct StaticOrder {
    int nM, nN, nwg, G, c, ntk;
    __host__ __device__ void init(int M_, int N_, int G_, int c_, int K_) { nM = M_ / BM; nN = N_ / BM; nwg = nM * nN; G = G_; c = c_; ntk = K_ / BK; }
    __host__ __device__ __forceinline__ bool next(int i, Unit& u) const {
        u.pm = 0; u.pn = 0; u.k0 = 0; u.nt = ntk; u.seg = 0;
        const long L = (long)i * G + c; if (L >= nwg) return false;
        int wgid = (int)L; { const int q = nwg / NXCD, r = nwg % NXCD, xcd = wgid % NXCD, off = wgid / NXCD; wgid = (xcd < r ? xcd * (q + 1) : r * (q + 1) + (xcd - r) * q) + off; }
        const int nig = WGM * nN, gid = wgid / nig, fm = gid * WGM, gsz = (nM - fm) < WGM ? (nM - fm) : WGM;
        u.pm = fm + ((wgid % nig) % gsz); u.pn = (wgid % nig) / gsz; return true;
    }
    __device__ __forceinline__ void a_ready(const Unit&) const {}
    __device__ __forceinline__ void done(const Unit&) const {}
};

struct CtxOrder {
    int nN, c, ntk;
    __host__ __device__ void init(int N_, int c_, int K_) { nN = N_ / BM; c = c_; ntk = K_ / BK; }
    __host__ __device__ __forceinline__ bool next(int i, Unit& u) const { u.pm = ML / BM + c / nN; u.pn = c % nN; u.k0 = 0; u.nt = ntk; u.seg = 0; return i == 0 && c < (MC / BM) * nN; }
    __device__ __forceinline__ void a_ready(const Unit&) const {}
    __device__ __forceinline__ void done(const Unit&) const {}
};
struct MergeOrder {
    StaticOrder tiles;
    __host__ __device__ void init(int M_, int N_, int G_, int c_) { tiles.init(M_, N_, G_, c_, GMW + AW + SSW); }
    __host__ __device__ __forceinline__ bool next(int i, Unit& u) const {
        const int it = i / 3, sg = i - 3 * it; Unit t; const bool ok = tiles.next(it, t);
        u.pm = t.pm; u.pn = t.pn; u.seg = sg; u.k0 = sg == 0 ? 0 : (sg == 1 ? GMW : GMW + AW); u.nt = (sg == 1 ? AW : GMW) / BK; return ok;
    }
    __device__ __forceinline__ void a_ready(const Unit&) const {}
    __device__ __forceinline__ void done(const Unit&) const {}
};

template <class Epi, class Sched, bool ALIGN_EPI = true, bool SP2 = true>
__device__ __forceinline__ void gemm_phase(LAS unsigned char* lds, const Gemm g, const Sched& S, const Epi& E, const int tid) {
    const int wid = __builtin_amdgcn_readfirstlane(tid >> 6), lane = tid & 63, wr = wid >> 2, wc = wid & 3, fr = lane & 15, fq = lane >> 4;
    unsigned voffA[2], voffB[2];
#pragma unroll
    for (int i = 0; i < 2; ++i) { int R, C; stage_rc(tid * 16 + i * 8192, R, C); const int Rb = Epi::PERM ? ((R & ~31) + perm32(R & 31)) : R;
        voffA[i] = (unsigned)(R * g.lda + C) * 2u; voffB[i] = (unsigned)(Rb * g.ldb + C) * 2u; }
    const unsigned kstep = (unsigned)(BK * 2);
    const unsigned hA = (unsigned)HALF * (unsigned)g.lda * 2u, hB = (unsigned)HALF * (unsigned)g.ldb * 2u;
    const unsigned tA = 2 * hA, tB = 2 * hB;
    const __amdgpu_buffer_rsrc_t srd_voffA = __builtin_amdgcn_make_buffer_rsrc((void*)g.A, 0, 0x7ffffff0, 0x00020000);
    const __amdgpu_buffer_rsrc_t srd_voffB = __builtin_amdgcn_make_buffer_rsrc((void*)g.Bt, 0, 0x7ffffff0, 0x00020000);
    const unsigned ldsw = (unsigned)wid * 1024u;
    constexpr bool FP8 = Epi::FP8;
    const int aoff = FP8 ? lds_byte(wr * 64 + fr, fq * 16) : lds_byte(wr * 64 + fr, fq * 8), boff = FP8 ? lds_byte(wc * 32 + fr, fq * 16) : lds_byte(wc * 32 + fr, fq * 8);
    const int aoff1 = FP8 ? lds_byte(wr * 64 + fr, fq * 16 + 8) : aoff + 1024, boff1 = FP8 ? lds_byte(wc * 32 + fr, fq * 16 + 8) : boff + 1024;
#define PG8_SA(b, h) (((b) * 2 + (h)) * HTB)
#define PG8_SB(b, h) ((4 + (b) * 2 + (h)) * HTB)
#define PG8_STAGE(bufoff, gbase, voff) do { _Pragma("unroll") for (int _i = 0; _i < 2; ++_i) \
        __builtin_amdgcn_raw_ptr_buffer_load_lds(srd_##voff, (LAS void*)(lds + (bufoff) + ldsw + _i * 8192), 16, (int)(voff)[_i], (int)(gbase), 0, 0); } while (0)
#define PG8_LDA(dst, b, h) do { if constexpr (FP8) { _Pragma("unroll") for (int m = 0; m < 4; ++m) { dst##8[m].lo = *(const LAS v4i*)(lds + PG8_SA(b, h) + aoff + m * 2048); dst##8[m].hi = *(const LAS v4i*)(lds + PG8_SA(b, h) + aoff1 + m * 2048); } } \
        else { _Pragma("unroll") for (int m = 0; m < 4; ++m) _Pragma("unroll") for (int k = 0; k < 2; ++k) dst[m][k] = *(const LAS bf16x8*)(lds + PG8_SA(b, h) + (k ? aoff1 : aoff) + m * 2048); } } while (0)
#define PG8_LDB(dst, b, h) do { if constexpr (FP8) { _Pragma("unroll") for (int n = 0; n < 2; ++n) { dst##8[n].lo = *(const LAS v4i*)(lds + PG8_SB(b, h) + boff + n * 2048); dst##8[n].hi = *(const LAS v4i*)(lds + PG8_SB(b, h) + boff1 + n * 2048); } } \
        else { _Pragma("unroll") for (int n = 0; n < 2; ++n) _Pragma("unroll") for (int k = 0; k < 2; ++k) dst[n][k] = *(const LAS bf16x8*)(lds + PG8_SB(b, h) + (k ? boff1 : boff) + n * 2048); } } while (0)
#define PG8_MMA(ai, bj, At, Bt) do { __builtin_amdgcn_s_setprio(1); _Pragma("unroll") for (int m = 0; m < 4; ++m) _Pragma("unroll") for (int n = 0; n < 2; ++n) { \
        if constexpr (FP8) asm volatile("v_mfma_scale_f32_16x16x128_f8f6f4 %0, %1, %2, %0, %3, %3 op_sel_hi:[0,0,0]" : "+v"(acc[ai][bj][m][n]) : "v"(Bt##8[n]), "v"(At##8[m]), "v"(scale1));   \
        else { _Pragma("unroll") for (int k = 0; k < 2; ++k) acc[ai][bj][m][n] = __builtin_amdgcn_mfma_f32_16x16x32_bf16(Bt[n][k], At[m][k], acc[ai][bj][m][n], 0, 0, 0); } } __builtin_amdgcn_s_setprio(0); } while (0)
#define PG8_WAIT_V(n) asm volatile("s_waitcnt vmcnt(" #n ")" ::: "memory")
#define PG8_WAIT_L(n) asm volatile("s_waitcnt lgkmcnt(" #n ")" ::: "memory")
#define PG8_BAR __builtin_amdgcn_s_barrier()
#define PG8_SCHED __builtin_amdgcn_sched_barrier(0)
    Unit cur, nxt; int ui = 0;
    if (!S.next(0, cur)) return;
    f32x4 acc[2][2][4][2];
#pragma unroll
    for (int a = 0; a < 2; ++a)
#pragma unroll
        for (int b = 0; b < 2; ++b)
#pragma unroll
            for (int m = 0; m < 4; ++m)
#pragma unroll
                for (int n = 0; n < 2; ++n) acc[a][b][m][n] = (f32x4){0.f, 0.f, 0.f, 0.f};
    const int scale1 = 0x7f7f7f7f;
    bf16x8 At[4][2], B0[2][2], B1[2][2]; v8i At8[4], B08[2], B18[2];
    unsigned cA = (unsigned)cur.pm * tA + (unsigned)cur.k0 * 2u, cB = (unsigned)cur.pn * tB + (unsigned)cur.k0 * 2u;
    S.a_ready(cur);
    if constexpr (SP2) {
        PG8_STAGE(PG8_SB(0, 0), cB, voffB); PG8_STAGE(PG8_SB(0, 1), cB + hB, voffB); PG8_STAGE(PG8_SA(0, 0), cA, voffA); PG8_STAGE(PG8_SA(0, 1), cA + hA, voffA);
        if (wr == 1) PG8_BAR;
        PG8_WAIT_V(2); PG8_BAR;
        PG8_STAGE(PG8_SB(1, 0), cB + kstep, voffB); PG8_STAGE(PG8_SA(1, 0), cA + kstep, voffA); PG8_STAGE(PG8_SB(1, 1), cB + hB + kstep, voffB);
        PG8_WAIT_V(6); PG8_BAR;
    } else {
        PG8_STAGE(PG8_SB(0, 0), cB, voffB); PG8_STAGE(PG8_SA(0, 0), cA, voffA); PG8_STAGE(PG8_SB(0, 1), cB + hB, voffB); PG8_STAGE(PG8_SA(0, 1), cA + hA, voffA);
        if (wr == 1) PG8_BAR;
        PG8_WAIT_V(4); PG8_BAR;
        PG8_STAGE(PG8_SB(1, 0), cB + kstep, voffB); PG8_STAGE(PG8_SA(1, 0), cA + kstep, voffA); PG8_STAGE(PG8_SB(1, 1), cB + hB + kstep, voffB);
        PG8_WAIT_V(6); PG8_BAR;
    }
    for (;;) {
        const bool has_next = S.next(ui + 1, nxt);
        const unsigned nA = has_next ? (unsigned)nxt.pm * tA + (unsigned)nxt.k0 * 2u : cA, nB = has_next ? (unsigned)nxt.pn * tB + (unsigned)nxt.k0 * 2u : cB;
        const int nt = cur.nt;
        for (int t = 0; t < nt; t += 2) {
            const bool last = (t == nt - 2);
            const unsigned a1 = cA + (unsigned)(t + 1) * kstep;
            const unsigned a2 = last ? nA : cA + (unsigned)(t + 2) * kstep, b2 = last ? nB : cB + (unsigned)(t + 2) * kstep;
            const unsigned a3 = a2 + kstep, b3 = b2 + kstep;
            if (last && has_next) S.a_ready(nxt);
            if constexpr (SP2) {
            PG8_LDB(B0, 0, 0); PG8_LDB(B1, 0, 1); PG8_SCHED; PG8_LDA(At, 0, 0); PG8_STAGE(PG8_SA(1, 1), a1 + hA, voffA);
            PG8_WAIT_V(8); PG8_WAIT_L(0); PG8_BAR; PG8_MMA(0, 0, At, B0); PG8_MMA(0, 1, At, B1); PG8_BAR; PG8_SCHED;
            PG8_LDA(At, 0, 1); PG8_STAGE(PG8_SB(0, 0), b2, voffB); PG8_STAGE(PG8_SB(0, 1), b2 + hB, voffB); PG8_STAGE(PG8_SA(0, 0), a2, voffA);
            PG8_WAIT_V(8); PG8_WAIT_L(0); PG8_BAR; PG8_MMA(1, 0, At, B0); PG8_MMA(1, 1, At, B1); PG8_BAR; PG8_SCHED;
            PG8_LDB(B0, 1, 0); PG8_LDB(B1, 1, 1); PG8_SCHED; PG8_LDA(At, 1, 0); PG8_STAGE(PG8_SA(0, 1), a2 + hA, voffA);
            PG8_WAIT_V(8); PG8_WAIT_L(0); PG8_BAR; PG8_MMA(0, 0, At, B0); PG8_MMA(0, 1, At, B1); PG8_BAR; PG8_SCHED;
            PG8_LDA(At, 1, 1); PG8_STAGE(PG8_SB(1, 0), b3, voffB); PG8_STAGE(PG8_SB(1, 1), b3 + hB, voffB); PG8_STAGE(PG8_SA(1, 0), a3, voffA);
            PG8_WAIT_V(8); PG8_WAIT_L(0); PG8_BAR; PG8_MMA(1, 0, At, B0); PG8_MMA(1, 1, At, B1); PG8_BAR; PG8_SCHED;
            } else {
            PG8_LDB(B0, 0, 0); PG8_SCHED; PG8_LDA(At, 0, 0); PG8_STAGE(PG8_SA(1, 1), a1 + hA, voffA);
            PG8_WAIT_L(8); PG8_BAR; PG8_WAIT_L(0); PG8_MMA(0, 0, At, B0); PG8_BAR; PG8_SCHED;
            PG8_LDB(B1, 0, 1); PG8_STAGE(PG8_SB(0, 0), b2, voffB);
            PG8_BAR; PG8_WAIT_L(0); PG8_MMA(0, 1, At, B1); PG8_BAR;
            PG8_LDA(At, 0, 1); PG8_STAGE(PG8_SA(0, 0), a2, voffA);
            PG8_BAR; PG8_WAIT_L(0); PG8_MMA(1, 0, At, B0); PG8_BAR; PG8_SCHED;
            PG8_STAGE(PG8_SB(0, 1), b2 + hB, voffB);
            PG8_WAIT_V(6); PG8_BAR; PG8_MMA(1, 1, At, B1); PG8_BAR;
            PG8_LDB(B0, 1, 0); PG8_SCHED; PG8_LDA(At, 1, 0); PG8_STAGE(PG8_SA(0, 1), a2 + hA, voffA);
            PG8_WAIT_L(8); PG8_BAR; PG8_WAIT_L(0); PG8_MMA(0, 0, At, B0); PG8_BAR; PG8_SCHED;
            PG8_LDB(B1, 1, 1); PG8_STAGE(PG8_SB(1, 0), b3, voffB);
            PG8_BAR; PG8_WAIT_L(0); PG8_MMA(0, 1, At, B1); PG8_BAR;
            PG8_LDA(At, 1, 1); PG8_STAGE(PG8_SA(1, 0), a3, voffA);
            PG8_BAR; PG8_WAIT_L(0); PG8_MMA(1, 0, At, B0); PG8_BAR; PG8_SCHED;
            PG8_STAGE(PG8_SB(1, 1), b3 + hB, voffB);
            PG8_WAIT_V(6); PG8_BAR; PG8_MMA(1, 1, At, B1); PG8_BAR;
            }
        }
        if constexpr (ALIGN_EPI) { if (wr == 0) PG8_BAR; }
        if constexpr (FP8) asm volatile("s_nop 15\n\ts_nop 15" ::: "memory");
        E(acc, cur, wr, wc, fr, fq); S.done(cur);
        if (!has_next) break;
        if constexpr (!Epi::CARRY) {
#pragma unroll
        for (int a = 0; a < 2; ++a)
#pragma unroll
            for (int b = 0; b < 2; ++b)
#pragma unroll
                for (int m = 0; m < 4; ++m)
#pragma unroll
                    for (int n = 0; n < 2; ++n) acc[a][b][m][n] = (f32x4){0.f, 0.f, 0.f, 0.f};
        }
        cur = nxt; cA = nA; cB = nB; ++ui;
        if constexpr (ALIGN_EPI) { if (wr == 1) PG8_BAR; }
    }
    PG8_WAIT_V(0);
    if constexpr (!ALIGN_EPI) { if (wr == 0) PG8_BAR; }
    PG8_BAR;
#undef PG8_SA
#undef PG8_SB
#undef PG8_STAGE
#undef PG8_LDA
#undef PG8_LDB
#undef PG8_MMA
#undef PG8_WAIT_V
#undef PG8_WAIT_L
#undef PG8_BAR
#undef PG8_SCHED
}

__device__ __forceinline__ u32x4 pack8(const f32x4 a, const f32x4 b) { u32x4 w; w.x = cvt_pk_bf16(a[0], a[1]); w.y = cvt_pk_bf16(a[2], a[3]); w.z = cvt_pk_bf16(b[0], b[1]); w.w = cvt_pk_bf16(b[2], b[3]); return w; }

struct EpiSwiGLU {
    static constexpr bool PERM = true, CARRY = false, FP8 = false;
    bf16* O; int ldo;
    __device__ __forceinline__ void operator()(const f32x4 (&acc)[2][2][4][2], const Unit& u, int wr, int wc, int fr, int fq) const {
        const int row0 = u.pm * BM + wr * 64 + fr, col0 = u.pn * 128 + wc * 32 + 8 * fq;
#pragma unroll
        for (int ai = 0; ai < 2; ++ai)
#pragma unroll
            for (int m = 0; m < 4; ++m) {
                f32x4 v0, v1;
#pragma unroll
                for (int e = 0; e < 4; ++e) { v0[e] = silu_f(acc[ai][0][m][0][e]) * acc[ai][1][m][0][e]; v1[e] = silu_f(acc[ai][0][m][1][e]) * acc[ai][1][m][1][e]; }
                *(u32x4*)(O + (size_t)(row0 + ai * HALF + m * 16) * ldo + col0) = pack8(v0, v1);
            }
    }
};
struct EpiY {
    static constexpr bool PERM = true, CARRY = false, FP8 = false;
    bf16* Y; const float* modl; int gi; float cg;
    __device__ __forceinline__ void operator()(const f32x4 (&acc)[2][2][4][2], const Unit& u, int wr, int wc, int fr, int fq) const {
        const int row0 = u.pm * BM + wr * 64 + fr, col0 = u.pn * BM + wc * 32 + 8 * fq;
        const int s = u.pm < 32 ? 0 : (u.pm < 64 ? 1 : 2);
        const float* gate = modl + (size_t)(s * NMOD + gi) * D;
        f32x4 gv[2][2];
#pragma unroll
        for (int bj = 0; bj < 2; ++bj)
#pragma unroll
            for (int n = 0; n < 2; ++n) gv[bj][n] = *(const f32x4*)(gate + col0 + bj * HALF + 4 * n) * cg;
#pragma unroll
        for (int ai = 0; ai < 2; ++ai)
#pragma unroll
            for (int m = 0; m < 4; ++m) { bf16* rowp = Y + (size_t)(row0 + ai * HALF + m * 16) * D + col0;
#pragma unroll
                for (int bj = 0; bj < 2; ++bj) *(u32x4*)(rowp + bj * HALF) = pack8(gv[bj][0] * acc[ai][bj][m][0], gv[bj][1] * acc[ai][bj][m][1]); }
    }
};
template <bool FP8_> struct EpiIn {
    static constexpr bool PERM = true, CARRY = false, FP8 = FP8_;
    unsigned char* ws; const float* rope; int pn0; float ascale;
    __device__ __forceinline__ void operator()(const f32x4 (&acc)[2][2][4][2], const Unit& u0, int wr, int wc, int fr, int fq) const {
        Unit u; u.pm = u0.pm; u.pn = u0.pn + pn0;
        const int row0 = u.pm * BM + wr * 64 + fr;
        if (u.pn < 16) {
            const bool isq = u.pn < 8; const int head = 2 * (u.pn & 7) + (wc >> 1), rr = wc & 1, i0 = 8 * fq;
            const int colb = head * HD + rr * 64 + i0;
            const bool lat = u.pm < 64;
#pragma unroll
            for (int ai = 0; ai < 2; ++ai)
#pragma unroll
                for (int m = 0; m < 4; ++m) {
                    const int row = row0 + ai * HALF + m * 16;
                    const f32x4 a0 = acc[ai][0][m][0], a1 = acc[ai][0][m][1], b0 = acc[ai][1][m][0], b1 = acc[ai][1][m][1];
                    if (isq || !lat) { bf16* dst = (bf16*)(ws + (isq ? WS_QP : WS_KB)) + (size_t)row * AW + colb; *(u32x4*)dst = pack8(a0, a1); *(u32x4*)(dst + 32) = pack8(b0, b1); }
                    if (lat) {
                        const int t = row & (SEQ - 1), pos = rr ? (t & 63) : (t >> 6);
                        const float* cp = rope + pos * 32 + i0; const float* sp = cp + 128 * 32;
                        const f32x4 c0 = *(const f32x4*)cp, c1 = *(const f32x4*)(cp + 4), s0 = *(const f32x4*)sp, s1 = *(const f32x4*)(sp + 4);
                        const f32x4 o0 = a0 * c0 - b0 * s0, o1 = a1 * c1 - b1 * s1, p0 = a0 * s0 + b0 * c0, p1 = a1 * s1 + b1 * c1;
                        bf16* dst = (bf16*)(ws + (isq ? WS_QR : WS_KB)) + (size_t)row * AW + colb; *(u32x4*)dst = pack8(o0, o1); *(u32x4*)(dst + 32) = pack8(p0, p1);
                    }
                }
            return;
        }
        size_t boff; int ld, colt, act;
        if (u.pn < 24) { boff = WS_VB; ld = AW; colt = (u.pn - 16) * BM; act = 0; }
        else if (u.pn < 32) { boff = WS_ZB; ld = 2048; colt = (u.pn - 24) * BM; act = 1; }
        else if (u.pn < 36) { boff = WS_US; ld = SSW; colt = (u.pn - 32) * BM; act = 0; }
        else { boff = WS_GB; ld = 3 * D; colt = (u.pn - 36) * BM; act = 2; }
        bf16* base = (bf16*)(ws + boff);
        const int col0 = colt + wc * 32 + 8 * fq;
#pragma unroll
        for (int ai = 0; ai < 2; ++ai)
#pragma unroll
            for (int m = 0; m < 4; ++m) { bf16* rowp = base + (size_t)(row0 + ai * HALF + m * 16) * ld + col0;
#pragma unroll
                for (int bj = 0; bj < 2; ++bj) { f32x4 v0 = acc[ai][bj][m][0], v1 = acc[ai][bj][m][1];
                    if (act == 1) {
#pragma unroll
                        for (int e = 0; e < 4; ++e) { v0[e] = gelu_tanh_f(v0[e]); v1[e] = gelu_tanh_f(v1[e]); } }
                    else if (act == 2) {
#pragma unroll
                        for (int e = 0; e < 4; ++e) { v0[e] = fast_sigmoid(v0[e] * ascale); v1[e] = fast_sigmoid(v1[e] * ascale); } }
                    *(u32x4*)(rowp + bj * HALF) = pack8(v0, v1); } }
    }
};
__device__ __forceinline__ void unpack8(const u32x4 w, f32x4& a, f32x4& b) { a = (f32x4){bf_lo(w.x), bf_hi(w.x), bf_lo(w.y), bf_hi(w.y)}; b = (f32x4){bf_lo(w.z), bf_hi(w.z), bf_lo(w.w), bf_hi(w.w)}; }
struct EpiGLU {
    static constexpr bool PERM = true, CARRY = false, FP8 = false;
    const bf16* YS; bf16* O; const float* bias;
    __device__ __forceinline__ void operator()(const f32x4 (&acc)[2][2][4][2], const Unit& u, int wr, int wc, int fr, int fq) const {
        const int row0 = u.pm * BM + wr * 64 + fr, col0 = u.pn * BM + wc * 32 + 8 * fq;
        const f32x4 bv[2][2] = {{*(const f32x4*)(bias + col0), *(const f32x4*)(bias + col0 + 4)}, {*(const f32x4*)(bias + col0 + HALF), *(const f32x4*)(bias + col0 + HALF + 4)}};
        constexpr int PD = 7;
        u32x4 yr[PD + 1];
#define EG_ROW(s_) ((size_t)(row0 + ((s_) >> 3) * HALF + (((s_) >> 1) & 3) * 16))
#define EG_LOAD(s_) yr[(s_) % (PD + 1)] = *(const u32x4*)(YS + EG_ROW(s_) * SSW + col0 + ((s_) & 1) * HALF)
#pragma unroll
        for (int s = 0; s < PD; ++s) EG_LOAD(s);
#pragma unroll
        for (int s = 0; s < 16; ++s) {
            if (s + PD < 16) EG_LOAD(s + PD);
            const int ai = s >> 3, m = (s >> 1) & 3, bj = s & 1;
            f32x4 y0, y1; unpack8(yr[s % (PD + 1)], y0, y1);
            f32x4 v0 = acc[ai][bj][m][0] + bv[bj][0], v1 = acc[ai][bj][m][1] + bv[bj][1];
#pragma unroll
            for (int e = 0; e < 4; ++e) { v0[e] = y0[e] * fast_sigmoid(v0[e]); v1[e] = y1[e] * fast_sigmoid(v1[e]); }
            *(u32x4*)(O + EG_ROW(s) * D + col0 + bj * HALF) = pack8(v0, v1);
            asm volatile("" ::: "memory");
        }
#undef EG_LOAD
#undef EG_ROW
    }
};
#ifndef MERGE_PD
#define MERGE_PD 3
#endif
struct EpiMerge1 {
    static constexpr bool PERM = true, CARRY = true, FP8 = false;
    const bf16* GB; bf16* MG;
    __device__ __forceinline__ void operator()(f32x4 (&acc)[2][2][4][2], const Unit& u, int wr, int wc, int fr, int fq) const {
        const int row0 = u.pm * BM + wr * 64 + fr, col0 = u.pn * BM + wc * 32 + 8 * fq;
        const bool fin = u.seg == 2;
        const int noff = u.seg * D;
        const float keep = fin ? 0.f : 1.f;
        constexpr int PD = MERGE_PD;
        u32x4 nwr[PD + 1], dwr[PD + 1];
#define EM_ROW(s_) ((size_t)(row0 + ((s_) >> 3) * HALF + (((s_) >> 1) & 3) * 16))
#define EM_LOAD(s_) do { const bf16* gp_ = GB + EM_ROW(s_) * (3 * D) + noff + col0 + ((s_) & 1) * HALF; nwr[(s_) % (PD + 1)] = *(const u32x4*)gp_; dwr[(s_) % (PD + 1)] = *(const u32x4*)(gp_ + (fin ? 0 : D)); } while (0)
#pragma unroll
        for (int s = 0; s < PD; ++s) EM_LOAD(s);
#pragma unroll
        for (int s = 0; s < 16; ++s) {
            if (s + PD < 16) EM_LOAD(s + PD);
            const int ai = s >> 3, m = (s >> 1) & 3, bj = s & 1;
            f32x4 n0, n1, d0, d1; unpack8(nwr[s % (PD + 1)], n0, n1); unpack8(dwr[s % (PD + 1)], d0, d1);
            f32x4 r0, r1;
#pragma unroll
            for (int e = 0; e < 4; ++e) { const float q0 = __builtin_amdgcn_rcpf(fmaxf(d0[e], 1e-30f)), q1 = __builtin_amdgcn_rcpf(fmaxf(d1[e], 1e-30f));
                r0[e] = fmaxf(n0[e], 1e-30f) * (fin ? 1.0f : q0); r1[e] = fmaxf(n1[e], 1e-30f) * (fin ? 1.0f : q1); }
            const f32x4 v0 = acc[ai][bj][m][0] * r0, v1 = acc[ai][bj][m][1] * r1;
            if (fin) *(u32x4*)(MG + EM_ROW(s) * D + col0 + bj * HALF) = pack8(v0, v1);
            acc[ai][bj][m][0] = v0 * keep; acc[ai][bj][m][1] = v1 * keep;
            asm volatile("" : "+v"(acc[ai][bj][m][0]), "+v"(acc[ai][bj][m][1]) :: "memory");
        }
#undef EM_LOAD
#undef EM_ROW
    }
};
}
using pg8::unpack8; using pg8::pack8;

#define XB_TMO      128
#define XB_XCNT(j)  (256  + 64 * (j))
#define XB_XSUB(j)  (1280 + 64 * (j))
#define XB_XGEN(j)  (2304 + 64 * (j))
#define XB_TOP      3328
#define XB_TOPGEN   3392
#define XCD_BAR_WORDS 3456
#define XB_SPIN_CAP (1u << 18)
__device__ __forceinline__ unsigned xb_ld(unsigned* p)              { return __hip_atomic_load(p, __ATOMIC_RELAXED, __HIP_MEMORY_SCOPE_AGENT); }
__device__ __forceinline__ unsigned xb_add(unsigned* p, unsigned v) { return __hip_atomic_fetch_add(p, v, __ATOMIC_RELAXED, __HIP_MEMORY_SCOPE_AGENT); }
__device__ __forceinline__ unsigned xb_xcc_id() { return (unsigned)__builtin_amdgcn_s_getreg((3 << 11) | 20) & 0xFu; }
#define XB_SPIN(cond, bar) do { unsigned _sp = 0; while (cond) { __builtin_amdgcn_s_sleep(1); \
    if ((++_sp & 255u) == 0u) { if (xb_ld(&(bar)[XB_TMO])) break; if (_sp > XB_SPIN_CAP) { atomicAdd(&(bar)[XB_TMO], 1u); break; } } } } while (0)
struct XcdBarrier { unsigned* bar; unsigned x; volatile LAS unsigned* st; };
__device__ __forceinline__ XcdBarrier xcd_barrier_post(unsigned* bar, volatile LAS unsigned* st) {
    XcdBarrier b; b.bar = bar; b.x = xb_xcc_id(); b.st = st;
    if (threadIdx.x == 0) (void)xb_add(&bar[XB_XCNT(b.x)], 1u);
    return b;
}
__device__ __forceinline__ void xcd_barrier_complete(unsigned* bar, unsigned x, unsigned& nloc, unsigned& nx) {
    const unsigned G = gridDim.x * gridDim.y * gridDim.z;
    unsigned sum, cnt, mine, sp = 0u;
    for (;;) {
        sum = 0u; cnt = 0u; mine = 0u;
#pragma unroll
        for (unsigned j = 0; j < 16; ++j) { const unsigned c = xb_ld(&bar[XB_XCNT(j)]); sum += c; cnt += (c > 0u) ? 1u : 0u; mine = (j == x) ? c : mine; }
        if (sum == G) break;
        __builtin_amdgcn_s_sleep(1);
        if ((++sp & 255u) == 0u) { if (xb_ld(&bar[XB_TMO])) break; if (sp > XB_SPIN_CAP) { atomicAdd(&bar[XB_TMO], 1u); break; } }
    }
    nloc = mine > 0u ? mine : 1u; nx = cnt > 0u ? cnt : 1u;
}
__device__ __forceinline__ void xcd_barrier(const XcdBarrier& b) {
    asm volatile("s_waitcnt vmcnt(0)" ::: "memory");
    __syncthreads();
    if (threadIdx.x == 0) {
        unsigned* bar = b.bar;
        __builtin_amdgcn_s_waitcnt(0);
        unsigned nloc = b.st[0], nx = b.st[1];
        if (nloc == 0u) { xcd_barrier_complete(bar, b.x, nloc, nx); b.st[0] = nloc; b.st[1] = nx; }
        const unsigned old = xb_add(&bar[XB_XSUB(b.x)], 1u);
        const unsigned gen = old / nloc;
        if (old + 1u == (gen + 1u) * nloc) {
            __builtin_amdgcn_fence(__ATOMIC_RELEASE, "agent");
            asm volatile("s_waitcnt vmcnt(0)" ::: "memory");
            const unsigned og = xb_add(&bar[XB_TOP], 1u);
            const unsigned tg = og / nx;
            if (og + 1u == (tg + 1u) * nx) xb_add(&bar[XB_TOPGEN], 1u);
            else XB_SPIN(xb_ld(&bar[XB_TOPGEN]) == tg, bar);
            __builtin_amdgcn_fence(__ATOMIC_ACQUIRE, "agent");
            xb_add(&bar[XB_XGEN(b.x)], 1u);
            asm volatile("s_waitcnt vmcnt(0)" ::: "memory");
        } else {
            XB_SPIN(xb_ld(&bar[XB_XGEN(b.x)]) == gen, bar);
            __builtin_amdgcn_fence(__ATOMIC_ACQUIRE, "agent");
            asm volatile("s_waitcnt vmcnt(0)" ::: "memory");
        }
    }
    __syncthreads();
}

__device__ __forceinline__ float wave_sum(float v) {
#pragma unroll
    for (int o = 1; o < 64; o <<= 1) v += __shfl_xor(v, o);
    return v;
}
#define MFMA32(a, b, c) __builtin_amdgcn_mfma_f32_32x32x16_bf16((a), (b), (c), 0, 0, 0)
#define MFMA16(a, b, c) __builtin_amdgcn_mfma_f32_16x16x32_bf16((a), (b), (c), 0, 0, 0)
#define PACK_STEP(dst, x, s) do { u32x4 _p; asm volatile("v_cvt_pk_bf16_f32 %0, %4, %5\n\tv_cvt_pk_bf16_f32 %1, %6, %7\n\tv_cvt_pk_bf16_f32 %2, %8, %9\n\tv_cvt_pk_bf16_f32 %3, %10, %11\n\ts_nop 1" \
        : "=&v"(_p[0]), "=&v"(_p[1]), "=&v"(_p[2]), "=&v"(_p[3]) \
        : "v"(x[8 * (s)]), "v"(x[8 * (s) + 1]), "v"(x[8 * (s) + 2]), "v"(x[8 * (s) + 3]), "v"(x[8 * (s) + 4]), "v"(x[8 * (s) + 5]), "v"(x[8 * (s) + 6]), "v"(x[8 * (s) + 7])); \
        dst = __builtin_bit_cast(bf16x8, _p); } while (0)
template <int OFF_LO, int OFF_HI> __device__ __forceinline__ bf16x8 tr_read2(unsigned base) {
    s16x4 lo, hi;
    asm volatile("ds_read_b64_tr_b16 %0, %2 offset:%3\n\tds_read_b64_tr_b16 %1, %2 offset:%4\n\ts_waitcnt lgkmcnt(0)" : "=&v"(lo), "=&v"(hi) : "v"(base), "i"(OFF_LO), "i"(OFF_HI) : "memory");
    return __builtin_shufflevector(lo, hi, 0, 1, 2, 3, 4, 5, 6, 7);
}
__device__ __forceinline__ unsigned lds_addr(LAS unsigned char* p) { return (unsigned)(__UINTPTR_TYPE__)p; }

__device__ __forceinline__ void transpose_item(const float* W, int N, bf16* WT, int ldt, int k0, int src_n0, int dst_n0, LAS float* scr, int lane) {
#pragma unroll
    for (int i = 0; i < 32; ++i) { const int kk = 2 * i + (lane >> 5); scr[kk * 33 + (lane & 31)] = __builtin_nontemporal_load(W + (size_t)(k0 + kk) * N + src_n0 + (lane & 31)); }
    LDS_WAIT();
    const int c = lane & 7;
#pragma unroll
    for (int j = 0; j < 4; ++j) { const int n = (lane >> 3) + 8 * j; const LAS float* s = scr + (8 * c) * 33 + n;
        u32x4 o; o.x = cvt_pk_bf16(s[0 * 33], s[1 * 33]); o.y = cvt_pk_bf16(s[2 * 33], s[3 * 33]); o.z = cvt_pk_bf16(s[4 * 33], s[5 * 33]); o.w = cvt_pk_bf16(s[6 * 33], s[7 * 33]);
        *(u32x4*)(WT + (size_t)(dst_n0 + n) * ldt + k0 + 8 * c) = o; }
    LDS_WAIT();
}
__device__ __forceinline__ void transpose_item_fp8(const float* W, int N, unsigned char* WT8, int ldt, int k0, int src_n0, int dst_n0, LAS float* scr, int lane) {
#pragma unroll
    for (int i = 0; i < 32; ++i) { const int kk = 2 * i + (lane >> 5); scr[kk * 33 + (lane & 31)] = __builtin_nontemporal_load(W + (size_t)(k0 + kk) * N + src_n0 + (lane & 31)); }
    LDS_WAIT();
    const int c = lane & 7;
#pragma unroll
    for (int j = 0; j < 4; ++j) { const int n = (lane >> 3) + 8 * j; const LAS float* s = scr + (8 * c) * 33 + n;
        float e[8];
#pragma unroll
        for (int q = 0; q < 8; ++q) e[q] = fminf(fmaxf(s[q * 33] * 2048.f, -448.f), 448.f);
        int w0 = __builtin_amdgcn_cvt_pk_fp8_f32(e[0], e[1], 0, false); w0 = __builtin_amdgcn_cvt_pk_fp8_f32(e[2], e[3], w0, true);
        int w1 = __builtin_amdgcn_cvt_pk_fp8_f32(e[4], e[5], 0, false); w1 = __builtin_amdgcn_cvt_pk_fp8_f32(e[6], e[7], w1, true);
        *(u32x2*)(WT8 + (size_t)(dst_n0 + n) * ldt + k0 + 8 * c) = (u32x2){(unsigned)w0, (unsigned)w1}; }
    LDS_WAIT();
}
__device__ __forceinline__ int src_block(int mode, int nb) {
    if (mode == 1) { const int pn = nb >> 3, wb = nb & 7, bj = wb >> 2, jb = wb & 3; return bj * 192 + 4 * pn + jb; }
    if (mode == 2 && nb < 128) { const int tile = nb >> 3, wb = nb & 7, bj = wb >> 2, hh = (wb & 3) >> 1, rr = wb & 1; const int base = tile < 8 ? 0 : AW, head = 2 * (tile & 7) + hh; return (base + head * HD + rr * 64 + 32 * bj) >> 5; }
    return nb;
}
__device__ __forceinline__ void transpose_matrix_items(const float* W, int K, int N, bf16* WT, int ldt, int mode, int it, LAS float* scr, int lane, unsigned char* WT8 = nullptr) {
    const int nblk = N / 32, kb = it / nblk, nb = it % nblk;
    if (mode == 2 && nb >= 288) { transpose_item_fp8(W, N, WT8, K, 64 * kb, 32 * nb, 32 * (nb - 288), scr, lane); return; }
    transpose_item(W, N, WT, ldt, 64 * kb, 32 * src_block(mode, nb), 32 * nb, scr, lane);
}

struct Args { const float* in[32]; float* out; unsigned char* ws; int ph_lo, ph_hi; };

__device__ __forceinline__ void p0_tables(const Args& args, int gtid, int gthreads) {
    unsigned char* ws = args.ws;
    float* rope = (float*)(ws + WS_ROPE);
    for (int i = gtid; i < 128 * 32; i += gthreads) { const int pos = i >> 5, j = i & 31; const float inv = exp2f(-(float)j * (13.287712379549449f / 32.0f)); const float ang = (float)pos * inv; rope[i] = cosf(ang); rope[128 * 32 + i] = sinf(ang); }
    const float *lam_re = as_global(args.in[18]), *lam_im = as_global(args.in[19]), *log_dt = as_global(args.in[20]), *b_re = as_global(args.in[21]), *b_im = as_global(args.in[22]), *c_re = as_global(args.in[23]), *c_im = as_global(args.in[24]);
    f32x4* SA = (f32x4*)(ws + WS_SA); bf16* SBB = (bf16*)(ws + WS_SBB); bf16* SC = (bf16*)(ws + WS_SC);
    for (int i = gtid; i < DEPTH * 2 * NG * NP; i += gthreads) {
        const int p = i & 63, ldg = i >> 6;
        const float dt = expf(log_dt[ldg]), lr = lam_re[i], li = lam_im[i];
        const float x = lr * dt, y = li * dt, mag = expf(x), cs = cosf(y), sn = sinf(y), sh = sinf(0.5f * y);
        const float ar = mag * cs, ai = mag * sn, re1 = expm1f(x) * cs - 2.0f * sh * sh, den = lr * lr + li * li;
        const float fr = (re1 * lr + ai * li) / den, fi = (ai * lr - re1 * li) / den;
        float tr = ar, ti = ai;
#pragma unroll
        for (int q = 0; q < 7; ++q) { const float nr = tr * tr - ti * ti, ni = 2.0f * tr * ti; tr = nr; ti = ni; }
        SA[i] = (f32x4){ar, ai, tr, ti};
        { bf16* o_re = SBB + ((size_t)ldg * 128 + p) * SG; bf16* o_im = o_re + 64 * SG;
#pragma unroll
          for (int ch = 0; ch < SG; ch += 2) { const float br0 = b_re[(size_t)i * SG + ch], bi0 = b_im[(size_t)i * SG + ch], br1 = b_re[(size_t)i * SG + ch + 1], bi1 = b_im[(size_t)i * SG + ch + 1];
              *(unsigned*)(o_re + ch) = cvt_pk_bf16(fr * br0 - fi * bi0, fr * br1 - fi * bi1); *(unsigned*)(o_im + ch) = cvt_pk_bf16(fr * bi0 + fi * br0, fr * bi1 + fi * br1); } }
#pragma unroll
        for (int ch = 0; ch < SG; ++ch) { const size_t ci = ((size_t)ldg * SG + ch) * NP + p; const size_t o = ((size_t)ldg * SG + ch) * 128;
            SC[o + p] = (bf16)(cvt_pk_bf16(c_re[ci], 0.f) & 0xffffu); SC[o + 64 + p] = (bf16)(cvt_pk_bf16(-c_im[ci], 0.f) & 0xffffu); }
    }
    const float* gws = as_global(args.in[16]); bf16* GWS = (bf16*)(ws + WS_GWS);
    for (int i = gtid; i < DEPTH * 8 * 128 * 128 / 2; i += gthreads) ((unsigned*)GWS)[i] = cvt_pk_bf16(gws[2 * i], gws[2 * i + 1]);
}

__device__ __forceinline__ void p0_mod(const Args& args, LAS unsigned char* lds, int wid, int lane, int tid, int G, int bx) {
    LAS float* sv = (LAS float*)lds;
    LAS float* red = (LAS float*)(lds + 49152);
    const float *c = as_global(args.in[1]), *cctx = as_global(args.in[3]);
    for (int i = tid; i < 3 * D; i += 512) { const float v = i < 2 * D ? c[i] : cctx[i - 2 * D]; sv[i] = silu_f(v); }
    __syncthreads();
    float* modv = (float*)(args.ws + WS_MOD);
    constexpr int NCB = NMODC / 256;
    for (int u = bx; u < DEPTH * NCB; u += G) {
        const int l = u / NCB, cb = u % NCB;
        const float* W = as_global(args.in[4]) + (size_t)l * D * NMODC + (size_t)cb * 256 + 4 * lane;
        f32x4 a0 = {0.f, 0.f, 0.f, 0.f}, a1 = a0, a2 = a0;
        const int kbeg = wid * 512;
        for (int k = kbeg; k < kbeg + 512; k += 8) {
            f32x4 w[8];
#pragma unroll
            for (int i = 0; i < 8; ++i) w[i] = __builtin_nontemporal_load((const f32x4*)(W + (size_t)(k + i) * NMODC));
#pragma unroll
            for (int i = 0; i < 8; ++i) { a0 += w[i] * sv[k + i]; a1 += w[i] * sv[D + k + i]; a2 += w[i] * sv[2 * D + k + i]; }
        }
        *(LAS f32x4*)(red + (wid * 3 + 0) * 256 + 4 * lane) = a0; *(LAS f32x4*)(red + (wid * 3 + 1) * 256 + 4 * lane) = a1; *(LAS f32x4*)(red + (wid * 3 + 2) * 256 + 4 * lane) = a2;
        __syncthreads();
        for (int o = tid; o < 768; o += 512) { const int s = o >> 8, cc = o & 255; float sum = 0.f;
#pragma unroll
            for (int w8 = 0; w8 < 8; ++w8) sum += red[(w8 * 3 + s) * 256 + cc];
            modv[(size_t)(l * 3 + s) * NMODC + cb * 256 + cc] = sum + as_global(args.in[5])[(size_t)l * NMODC + cb * 256 + cc]; }
        __syncthreads();
    }
}

__device__ __forceinline__ void p0_item_finish(const f32x4 (&rg)[8], unsigned char* dst, int ldt, bool f8, LAS float* scr, int lane) {
#pragma unroll
    for (int i = 0; i < 8; ++i) { const int kk = 8 * i + (lane >> 3), ch = lane & 7; *(LAS f32x4*)(scr + kk * 32 + ((ch ^ i) << 2)) = rg[i]; }
    LDS_WAIT();
    const int c = lane & 7;
#pragma unroll
    for (int j = 0; j < 4; ++j) { const int n = (lane >> 3) + 8 * j; const LAS float* s = scr + (8 * c) * 32 + ((((n >> 2) ^ c)) << 2) + (n & 3);
        float e[8];
#pragma unroll
        for (int q = 0; q < 8; ++q) e[q] = s[q * 32];
        if (f8) {
#pragma unroll
            for (int q = 0; q < 8; ++q) e[q] = fminf(fmaxf(e[q] * 2048.f, -448.f), 448.f);
            int w0 = __builtin_amdgcn_cvt_pk_fp8_f32(e[0], e[1], 0, false); w0 = __builtin_amdgcn_cvt_pk_fp8_f32(e[2], e[3], w0, true);
            int w1 = __builtin_amdgcn_cvt_pk_fp8_f32(e[4], e[5], 0, false); w1 = __builtin_amdgcn_cvt_pk_fp8_f32(e[6], e[7], w1, true);
            __builtin_nontemporal_store((u32x2){(unsigned)w0, (unsigned)w1}, (u32x2*)(dst + (size_t)n * ldt + 8 * c));
        } else {
            u32x4 o; o.x = cvt_pk_bf16(e[0], e[1]); o.y = cvt_pk_bf16(e[2], e[3]); o.z = cvt_pk_bf16(e[4], e[5]); o.w = cvt_pk_bf16(e[6], e[7]);
            __builtin_nontemporal_store(o, (u32x4*)(dst + ((size_t)n * ldt + 8 * c) * 2)); } }
    LDS_WAIT();
}
__device__ __forceinline__ void p0_weights(const Args& args, LAS unsigned char* lds, int wid, int lane, int G, int bx) {
    LAS float* scr = (LAS float*)(lds + wid * 16384);
    const int gw = bx * 8 + wid, NGW = G * 8;
    constexpr int I_FI = (D / 64) * (2 * DFF / 32), I_FO = (DFF / 64) * (D / 32), I_IN = (D / 64) * (NIN / 32), I_GL = (SSW / 64) * (SSW / 32), I_PA = (GMW / 64) * (D / 32), I_PB = (AW / 64) * (D / 32), I_PC = (SSW / 64) * (D / 32), I_O = (D / 64) * (D / 32);
    constexpr int PER_L = 2 * I_FI + 2 * I_FO + I_IN + I_GL + I_PA + I_PB + I_PC + I_O;
    constexpr int TOTAL = DEPTH * PER_L, MODU = (D * 256 * 4) / (12 * 1024) / 8;
    const int nheavy = (DEPTH * (NMODC / 256) > G && DEPTH * (NMODC / 256) < 2 * G) ? DEPTH * (NMODC / 256) - G : 0;
    const int X = nheavy > 0 && TOTAL > MODU * 8 * (G - nheavy) ? TOTAL - MODU * 8 * (G - nheavy) : TOTAL;
    const int c0 = gw < X ? (X - gw + NGW - 1) / NGW : 0;
    const int st1 = (G - nheavy) * 8, i1 = X + (bx - nheavy) * 8 + wid;
    const int c1 = (bx >= nheavy && i1 < TOTAL) ? (TOTAL - i1 + st1 - 1) / st1 : 0;
    const int cnt = c0 + c1;
    if (cnt == 0) return;
#define P0_ITEM(k_) ((k_) < c0 ? gw + (k_) * NGW : i1 + ((k_) - c0) * st1)
#define P0_DECODE(it_, SRC, NN, DST, LDT, F8) do { const int l_ = (it_) / PER_L; int r_ = (it_) % PER_L; unsigned char* wl_ = args.ws + WS_W + (size_t)l_ * LW_BYTES; \
        const float* W_; int K_, N_, md_; unsigned char* T_; int lt_; \
        if (r_ < I_FI) { W_ = as_global(args.in[8]) + (size_t)l_ * D * 2 * DFF; K_ = D; N_ = 2 * DFF; T_ = wl_ + LW_W1IN; lt_ = D; md_ = 1; } \
        else if ((r_ -= I_FI) < I_FO) { W_ = as_global(args.in[9]) + (size_t)l_ * DFF * D; K_ = DFF; N_ = D; T_ = wl_ + LW_W1OUT; lt_ = DFF; md_ = 0; } \
        else if ((r_ -= I_FO) < I_FI) { W_ = as_global(args.in[10]) + (size_t)l_ * D * 2 * DFF; K_ = D; N_ = 2 * DFF; T_ = wl_ + LW_W2IN; lt_ = D; md_ = 1; } \
        else if ((r_ -= I_FI) < I_FO) { W_ = as_global(args.in[11]) + (size_t)l_ * DFF * D; K_ = DFF; N_ = D; T_ = wl_ + LW_W2OUT; lt_ = DFF; md_ = 0; } \
        else if ((r_ -= I_FO) < I_IN) { W_ = as_global(args.in[12]) + (size_t)l_ * D * NIN; K_ = D; N_ = NIN; T_ = wl_ + LW_WIN; lt_ = D; md_ = 2; } \
        else if ((r_ -= I_IN) < I_GL) { W_ = as_global(args.in[26]) + (size_t)l_ * SSW * SSW; K_ = SSW; N_ = SSW; T_ = wl_ + LW_WGLU; lt_ = SSW; md_ = 0; } \
        else if ((r_ -= I_GL) < I_PA) { W_ = as_global(args.in[28]) + (size_t)l_ * GMW * D; K_ = GMW; N_ = D; T_ = wl_ + LW_WCAT; lt_ = D; md_ = 0; } \
        else if ((r_ -= I_PA) < I_PB) { W_ = as_global(args.in[29]) + (size_t)l_ * AW * D; K_ = AW; N_ = D; T_ = wl_ + LW_WCAT + 2 * GMW; lt_ = D; md_ = 0; } \
        else if ((r_ -= I_PB) < I_PC) { W_ = as_global(args.in[30]) + (size_t)l_ * SSW * D; K_ = SSW; N_ = D; T_ = wl_ + LW_WCAT + 2 * (GMW + AW); lt_ = D; md_ = 0; } \
        else { r_ -= I_PC; W_ = as_global(args.in[31]) + (size_t)l_ * D * D; K_ = D; N_ = D; T_ = wl_ + LW_WO; lt_ = D; md_ = 0; } \
        const int nblk_ = N_ / 32, kb_ = r_ / nblk_, nb_ = r_ % nblk_; NN = N_; \
        if (md_ == 2 && nb_ >= 288) { F8 = true; SRC = W_ + (size_t)(64 * kb_) * N_ + 32 * nb_; DST = wl_ + LW_W8 + (size_t)(32 * (nb_ - 288)) * K_ + 64 * kb_; LDT = K_; }     \
        else { F8 = false; SRC = W_ + (size_t)(64 * kb_) * N_ + 32 * src_block(md_, nb_); DST = T_ + ((size_t)(32 * nb_) * lt_ + 64 * kb_) * 2; LDT = lt_; } } while (0)
#define P0_LOAD(RG, SRC, NN) do { _Pragma("unroll") for (int i = 0; i < 8; ++i) RG[i] = __builtin_nontemporal_load((const f32x4*)((SRC) + (size_t)(8 * i + (lane >> 3)) * (NN) + 4 * (lane & 7))); } while (0)
    f32x4 ra[8], rb[8];
    const float* srcA; const float* srcB; int nnA, nnB, ldA, ldB; unsigned char* dstA; unsigned char* dstB; bool f8A, f8B;
    P0_DECODE(P0_ITEM(0), srcA, nnA, dstA, ldA, f8A);
    P0_LOAD(ra, srcA, nnA);
#pragma unroll
    for (int i = 0; i < 8; ++i) asm volatile("" : "+v"(ra[i]));
    for (int k = 0; k < cnt; k += 2) {
        { const int kn = k + 1 < cnt ? k + 1 : k; P0_DECODE(P0_ITEM(kn), srcB, nnB, dstB, ldB, f8B); P0_LOAD(rb, srcB, nnB); }
        p0_item_finish(ra, dstA, ldA, f8A, scr, lane);
        if (k + 1 >= cnt) break;
        { const int kn = k + 2 < cnt ? k + 2 : k + 1; P0_DECODE(P0_ITEM(kn), srcA, nnA, dstA, ldA, f8A); P0_LOAD(ra, srcA, nnA); }
        p0_item_finish(rb, dstB, ldB, f8B, scr, lane);
    }
#undef P0_LOAD
#undef P0_DECODE
#undef P0_ITEM
}

__device__ __forceinline__ void thin_phase(int mode, const float* xin, const float* cin, float* X, const bf16* Y, const float* lng, const float* lnb, const float* modl, int sh_i, int sc_i, bf16* H, float* outp, int mrows, int gw, int NGW, int lane, LAS float* vl, int tid, unsigned char* H8 = nullptr, int row_lo = 0) {
    for (int i = tid; i < D / 4; i += 512) { const int c4 = 4 * i;
        if (mode != 0) { *(LAS f32x4*)(vl + c4) = *(const f32x4*)(lng + c4); *(LAS f32x4*)(vl + D + c4) = *(const f32x4*)(lnb + c4); }
        if (mode != 2) {
#pragma unroll
            for (int sx = 0; sx < 3; ++sx) { *(LAS f32x4*)(vl + (2 + sx) * D + c4) = *(const f32x4*)(modl + (size_t)(sx * NMOD + sh_i) * D + c4); *(LAS f32x4*)(vl + (5 + sx) * D + c4) = *(const f32x4*)(modl + (size_t)(sx * NMOD + sc_i) * D + c4) + 1.0f; } } }
    __syncthreads();
    if (row_lo + gw >= mrows) return;
    f32x4 v[16]; u32x2 y[16];
#define THIN_LOAD(dst, dsty, r) do { if (xin) { const float* src_ = (r) < ML ? xin + (size_t)(r) * D : cin + (size_t)((r) - ML) * D; \
        _Pragma("unroll") for (int j = 0; j < 16; ++j) dst[j] = __builtin_nontemporal_load((const f32x4*)(src_ + 256 * j + 4 * lane)); } \
        else { const unsigned* src_ = (const unsigned*)X + (size_t)(r) * (5 * D / 8); \
        _Pragma("unroll") for (int s_ = 0; s_ < 2; ++s_) { unsigned w_[20]; \
            _Pragma("unroll") for (int g = 0; g < 5; ++g) { const u32x4 t_ = __builtin_nontemporal_load((const u32x4*)(src_ + 256 * (5 * s_ + g) + 4 * lane)); w_[4 * g] = t_.x; w_[4 * g + 1] = t_.y; w_[4 * g + 2] = t_.z; w_[4 * g + 3] = t_.w; } \
            _Pragma("unroll") for (int p_ = 0; p_ < 4; ++p_) { const unsigned d0 = w_[5 * p_], d1 = w_[5 * p_ + 1], d2 = w_[5 * p_ + 2], d3 = w_[5 * p_ + 3], d4 = w_[5 * p_ + 4]; const int j0 = 8 * s_ + 2 * p_; \
                dst[j0][0] = __uint_as_float(d0 << 12); dst[j0][1] = __uint_as_float(__builtin_amdgcn_alignbit(d1, d0, 20) << 12); dst[j0][2] = __uint_as_float((d1 >> 8) << 12); dst[j0][3] = __uint_as_float(__builtin_amdgcn_alignbit(d2, d1, 28) << 12); \
                dst[j0 + 1][0] = __uint_as_float(__builtin_amdgcn_alignbit(d3, d2, 16) << 12); dst[j0 + 1][1] = __uint_as_float((d3 >> 4) << 12); dst[j0 + 1][2] = __uint_as_float(__builtin_amdgcn_alignbit(d4, d3, 24) << 12); dst[j0 + 1][3] = __uint_as_float(d4 & 0xfffff000u); } } } \
        if (mode != 0) { _Pragma("unroll") for (int j = 0; j < 16; ++j) dsty[j] = __builtin_nontemporal_load((const u32x2*)(Y + (size_t)(r) * D + 256 * j + 4 * lane)); } } while (0)
    for (int row = row_lo + gw; row < mrows; row += NGW) {
        THIN_LOAD(v, y, row);
        if (mode != 0) {
            float s = 0.f;
#pragma unroll
            for (int j = 0; j < 16; ++j) { v[j] = v[j] * ALPHA + (f32x4){bf_lo(y[j].x), bf_hi(y[j].x), bf_lo(y[j].y), bf_hi(y[j].y)}; s += (v[j][0] + v[j][1]) + (v[j][2] + v[j][3]); }
            const float mean = wave_sum(s) * (1.0f / D); float q = 0.f;
#pragma unroll
            for (int j = 0; j < 16; ++j) { v[j] = v[j] - mean; q += (v[j][0] * v[j][0] + v[j][1] * v[j][1]) + (v[j][2] * v[j][2] + v[j][3] * v[j][3]); }
            const float rstd = 1.0f / sqrtf(wave_sum(q) * (1.0f / D) + LN_EPS);
#pragma unroll
            for (int j = 0; j < 16; ++j) { const f32x4 g = *(const LAS f32x4*)(vl + 256 * j + 4 * lane), b = *(const LAS f32x4*)(vl + D + 256 * j + 4 * lane); v[j] = v[j] * rstd * g + b; }
            if (mode == 2) { float* dst = outp + (size_t)row * D;
#pragma unroll
                for (int j = 0; j < 16; ++j) __builtin_nontemporal_store(v[j], (f32x4*)(dst + 256 * j + 4 * lane)); }
            else { unsigned* dst = (unsigned*)X + (size_t)row * (5 * D / 8);
#pragma unroll
                for (int s_ = 0; s_ < 2; ++s_) { unsigned w_[20];
#pragma unroll
                    for (int p_ = 0; p_ < 4; ++p_) { const int j0 = 8 * s_ + 2 * p_; unsigned f[8];
#pragma unroll
                        for (int e = 0; e < 8; ++e) f[e] = (__float_as_uint(v[j0 + (e >> 2)][e & 3]) + 0x800u) >> 12;
                        w_[5 * p_] = f[0] | (f[1] << 20); w_[5 * p_ + 1] = (f[1] >> 12) | (f[2] << 8) | (f[3] << 28); w_[5 * p_ + 2] = (f[3] >> 4) | (f[4] << 16);
                        w_[5 * p_ + 3] = (f[4] >> 16) | (f[5] << 4) | (f[6] << 24); w_[5 * p_ + 4] = (f[6] >> 8) | (f[7] << 12); }
#pragma unroll
                    for (int g = 0; g < 5; ++g) { u32x4 t_; t_.x = w_[4 * g]; t_.y = w_[4 * g + 1]; t_.z = w_[4 * g + 2]; t_.w = w_[4 * g + 3]; __builtin_nontemporal_store(t_, (u32x4*)(dst + 256 * (5 * s_ + g) + 4 * lane)); } } }
        }
        if (mode != 2) {
            float s = 0.f;
#pragma unroll
            for (int j = 0; j < 16; ++j) s += (v[j][0] + v[j][1]) + (v[j][2] + v[j][3]);
            const float mean = wave_sum(s) * (1.0f / D); float q = 0.f;
#pragma unroll
            for (int j = 0; j < 16; ++j) { v[j] = v[j] - mean; q += (v[j][0] * v[j][0] + v[j][1] * v[j][1]) + (v[j][2] * v[j][2] + v[j][3] * v[j][3]); }
            const float rstd = 1.0f / sqrtf(wave_sum(q) * (1.0f / D) + LN_EPS);
            const int sidx = row < SEQ ? 0 : (row < ML ? 1 : 2);
            const LAS float* shp = vl + (2 + sidx) * D; const LAS float* scp = vl + (5 + sidx) * D;
#pragma unroll
            for (int j = 0; j < 16; ++j) { const f32x4 sh = *(const LAS f32x4*)(shp + 256 * j + 4 * lane), sc = *(const LAS f32x4*)(scp + 256 * j + 4 * lane);
                const f32x4 h = v[j] * rstd * sc + sh; u32x2 w; w.x = cvt_pk_bf16(h[0], h[1]); w.y = cvt_pk_bf16(h[2], h[3]);
                *(u32x2*)(H + (size_t)row * D + 256 * j + 4 * lane) = w;
                if (H8) { const f32x4 q = __builtin_elementwise_min(__builtin_elementwise_max(h * 8.f, (f32x4){-448.f, -448.f, -448.f, -448.f}), (f32x4){448.f, 448.f, 448.f, 448.f});
                    int w8 = __builtin_amdgcn_cvt_pk_fp8_f32(q[0], q[1], 0, false); w8 = __builtin_amdgcn_cvt_pk_fp8_f32(q[2], q[3], w8, true); *(unsigned*)(H8 + (size_t)row * D + 256 * j + 4 * lane) = (unsigned)w8; } }
        }
    }
#undef THIN_LOAD
}

constexpr int AT_KP = 272, AT_VP = 320, AT_VOFF = 64 * AT_KP, AT_BUF = AT_VOFF + 64 * AT_VP, AT_BOFF = 2 * AT_BUF + 256;
__device__ __forceinline__ int clampi(int v, int lo, int hi) { return v < lo ? lo : (v > hi ? hi : v); }
template <int OFF> __device__ __forceinline__ void tr_read_v4(unsigned base, bf16x8 (&f)[4]) {
    s16x4 l0, h0, l1, h1, l2, h2, l3, h3;
    asm volatile("ds_read_b64_tr_b16 %0, %8 offset:%9\n\tds_read_b64_tr_b16 %1, %8 offset:%10\n\tds_read_b64_tr_b16 %2, %8 offset:%11\n\tds_read_b64_tr_b16 %3, %8 offset:%12\n\t"
                 "ds_read_b64_tr_b16 %4, %8 offset:%13\n\tds_read_b64_tr_b16 %5, %8 offset:%14\n\tds_read_b64_tr_b16 %6, %8 offset:%15\n\tds_read_b64_tr_b16 %7, %8 offset:%16\n\ts_waitcnt lgkmcnt(0)"
                 : "=&v"(l0), "=&v"(h0), "=&v"(l1), "=&v"(h1), "=&v"(l2), "=&v"(h2), "=&v"(l3), "=&v"(h3)
                 : "v"(base), "i"(OFF), "i"(OFF + 8 * AT_VP), "i"(OFF + 64), "i"(OFF + 8 * AT_VP + 64), "i"(OFF + 128), "i"(OFF + 8 * AT_VP + 128), "i"(OFF + 192), "i"(OFF + 8 * AT_VP + 192) : "memory");
    f[0] = __builtin_shufflevector(l0, h0, 0, 1, 2, 3, 4, 5, 6, 7); f[1] = __builtin_shufflevector(l1, h1, 0, 1, 2, 3, 4, 5, 6, 7);
    f[2] = __builtin_shufflevector(l2, h2, 0, 1, 2, 3, 4, 5, 6, 7); f[3] = __builtin_shufflevector(l3, h3, 0, 1, 2, 3, 4, 5, 6, 7);
}
__device__ __forceinline__ void attn_unit(LAS unsigned char* lds, const bf16* QP, const bf16* QR, const bf16* KB, const bf16* VB, bf16* ACAT, const float* rpb_l, int b, int h, int r0, int tid, int wid, int lane) {
    const int hl = lane >> 5, l31 = lane & 31;
    const bool isctx = r0 < 0;
    const int r = isctx ? 0 : r0 + (wid >> 1), half = wid & 1;
    const int qrow = isctx ? ML + b * CTXL + 32 * wid + l31 : b * SEQ + r * 64 + 32 * half + l31;
    const int c = 32 * half + l31;
    int lo = 0, nloc = 0;
    if (!isctx) { lo = clampi(r0 - 4, 0, 120); nloc = clampi(r0 - 1, 0, 120) + 7 - lo + 1; }
    const int nt = nloc + 4, rs = clampi(r - 4, 0, 120);
    LAS float* bias = (LAS float*)(lds + AT_BOFF);
    const int skey = tid >> 3, spart = tid & 7;
    u32x4 kreg0, kreg1, vreg0, vreg1;
#define AT_GLOAD(it_) do { const int t_ = (it_); const size_t off = (size_t)((t_ < nloc ? b * SEQ + (lo + t_) * 64 : ML + b * CTXL + 64 * (t_ - nloc)) + skey) * AW + h * HD + 16 * spart; \
        kreg0 = *(const u32x4*)(KB + off); kreg1 = *(const u32x4*)(KB + off + 8); vreg0 = *(const u32x4*)(VB + off); vreg1 = *(const u32x4*)(VB + off + 8); } while (0)
#define AT_LWRITE(buf_) do { LAS unsigned char* kb_ = lds + (buf_) * AT_BUF; *(LAS u32x4*)(kb_ + skey * AT_KP + 32 * spart) = kreg0; *(LAS u32x4*)(kb_ + skey * AT_KP + 32 * spart + 16) = kreg1; \
        *(LAS u32x4*)(kb_ + AT_VOFF + skey * AT_VP + 32 * spart) = vreg0; *(LAS u32x4*)(kb_ + AT_VOFF + skey * AT_VP + 32 * spart + 16) = vreg1; } while (0)
    AT_GLOAD(0);
    bf16x8 qf[8];
    { const bf16* p2 = (isctx ? QP : QR) + (size_t)qrow * AW + h * HD + 8 * hl;
#pragma unroll
      for (int s = 0; s < 8; ++s) qf[s] = *(const bf16x8*)(p2 + 16 * s); }
    const float bias_w = tid < 15 * 31 ? rpb_l[h * 465 + tid] * LOG2E : 0.f;
    __syncthreads();
    if (tid < 15 * 31) bias[tid] = bias_w;
    AT_LWRITE(0);
    AT_GLOAD(1);
    {
#pragma unroll
      for (int s = 0; s < 8; ++s) asm volatile("" : "+v"(qf[s])); }
    f32x16 O[4];
#pragma unroll
    for (int cc = 0; cc < 4; ++cc)
#pragma unroll
        for (int i = 0; i < 16; ++i) O[cc][i] = 0.f;
    float mrun = -1e30f, lrun = 0.f;
    const float SC = 0.08838834764831845f * LOG2E;
    const int blk = (lane >> 4) & 1, q4 = (lane & 15) >> 2, p4 = lane & 3;
    const unsigned vtr0 = lds_addr(lds + AT_VOFF) + (unsigned)((4 * hl + q4) * AT_VP + 32 * blk + 8 * p4);
    __syncthreads();
    for (int it = 0; it < nt; ++it) {
        const int cur = it & 1;
        if (it + 1 < nt) { AT_LWRITE(cur ^ 1); if (it + 2 < nt) AT_GLOAD(it + 2); }
        const bool local = it < nloc; const int kr = lo + it;
        if (!(local && (kr < rs || kr > rs + 7))) {
            LAS unsigned char* kimg = lds + cur * AT_BUF;
            f32x16 s0, s1;
#pragma unroll
            for (int i = 0; i < 16; ++i) { s0[i] = 0.f; s1[i] = 0.f; }
            if (it == nloc && !isctx) {
                const bf16* p = QP + (size_t)qrow * AW + h * HD + 8 * hl;
#pragma unroll
                for (int s = 0; s < 8; ++s) qf[s] = *(const bf16x8*)(p + 16 * s);
#pragma unroll
                for (int s = 0; s < 8; ++s) asm volatile("" : "+v"(qf[s]));
            }
#pragma unroll
            for (int s = 0; s < 8; ++s) { const bf16x8 a0 = *(const LAS bf16x8*)(kimg + l31 * AT_KP + 32 * s + 16 * hl), a1 = *(const LAS bf16x8*)(kimg + (32 + l31) * AT_KP + 32 * s + 16 * hl);
                s0 = MFMA32(a0, qf[s], s0); s1 = MFMA32(a1, qf[s], s1); }
            float tmax = -INFINITY;
            if (local) {
                int cv = c; asm volatile("" : "+v"(cv));
                const int e0 = 4 * hl - clampi(cv - 8, 0, 48);
                const LAS float* bl = bias + ((kr - r + 7) * 31 + 4 * hl - cv + 15);
#pragma unroll
                for (int i = 0; i < 16; ++i) { const int ki = (i & 3) + 8 * (i >> 2);
                    const float x0 = s0[i] * SC + bl[ki], x1 = s1[i] * SC + bl[ki + 32];
                    s0[i] = ((unsigned)(ki + e0) < 16u) ? x0 : -INFINITY; s1[i] = ((unsigned)(ki + 32 + e0) < 16u) ? x1 : -INFINITY;
                    tmax = fmaxf(tmax, fmaxf(s0[i], s1[i])); }
            } else {
#pragma unroll
                for (int i = 0; i < 16; ++i) { s0[i] *= SC; s1[i] *= SC; tmax = fmaxf(tmax, fmaxf(s0[i], s1[i])); }
            }
            tmax = fmaxf(tmax, __shfl_xor(tmax, 32));
            const float mnew = fmaxf(mrun, tmax), alpha = __builtin_amdgcn_exp2f(mrun - mnew); mrun = mnew;
            float psum = 0.f;
#pragma unroll
            for (int i = 0; i < 16; ++i) { s0[i] = __builtin_amdgcn_exp2f(s0[i] - mnew); s1[i] = __builtin_amdgcn_exp2f(s1[i] - mnew); psum += s0[i] + s1[i]; }
            lrun = lrun * alpha + psum;
            if (!__all(alpha == 1.0f)) {
#pragma unroll
                for (int cc = 0; cc < 4; ++cc)
#pragma unroll
                    for (int i = 0; i < 16; ++i) O[cc][i] *= alpha;
            }
            const unsigned vtr = vtr0 + (unsigned)(cur * AT_BUF);
#define AT_PV(S16, SRC, ST) do { bf16x8 pf, vf[4]; PACK_STEP(pf, SRC, ST); tr_read_v4<16 * S16 * AT_VP>(vtr, vf); \
                O[0] = MFMA32(vf[0], pf, O[0]); O[1] = MFMA32(vf[1], pf, O[1]); O[2] = MFMA32(vf[2], pf, O[2]); O[3] = MFMA32(vf[3], pf, O[3]); } while (0)
            if (!(local && half == 1)) AT_PV(0, s0, 0);
            AT_PV(1, s0, 1); AT_PV(2, s1, 0);
            if (!(local && half == 0)) AT_PV(3, s1, 1);
#undef AT_PV
        }
        __syncthreads();
    }
#undef AT_GLOAD
#undef AT_LWRITE
    const float inv = 1.0f / (lrun + __shfl_xor(lrun, 32));
    bf16* orow = ACAT + (size_t)qrow * D + GMW + h * HD + 4 * hl;
#pragma unroll
    for (int cc = 0; cc < 4; ++cc)
#pragma unroll
        for (int g = 0; g < 4; ++g) { u32x2 w; w.x = cvt_pk_bf16(O[cc][4 * g] * inv, O[cc][4 * g + 1] * inv); w.y = cvt_pk_bf16(O[cc][4 * g + 2] * inv, O[cc][4 * g + 3] * inv);
            *(u32x2*)(orow + 32 * cc + 8 * g) = w; }
}

constexpr int GM_IMG = 128 * 96;
__device__ __forceinline__ void gmlp_unit(LAS unsigned char* lds, const bf16* ZB, bf16* ACAT, const float* lng, const float* lnb, const bf16* WSb, const float* bs, int unit, int tid, int wid, int lane) {
    const int chunk = unit >> 1, gh = unit & 1;
    const int hl = lane >> 5, l31 = lane & 31, row0 = 128 * chunk;
    LAS f32x2* stats = (LAS f32x2*)(lds + 8 * GM_IMG);
    __syncthreads();
    {
        u32x4 raw[16][2];
#pragma unroll
        for (int k = 0; k < 16; ++k) { const bf16* p = ZB + (size_t)(row0 + 16 * wid + k) * 2048 + 1024 + 8 * lane; raw[k][0] = *(const u32x4*)p; raw[k][1] = *(const u32x4*)(p + 512); }
#pragma unroll
        for (int k = 0; k < 16; ++k) {
            f32x4 v[4]; unpack8(raw[k][0], v[0], v[1]); unpack8(raw[k][1], v[2], v[3]);
            float s = 0.f;
#pragma unroll
            for (int j = 0; j < 4; ++j) s += (v[j][0] + v[j][1]) + (v[j][2] + v[j][3]);
            const float mean = wave_sum(s) * (1.0f / 1024.0f); float q = 0.f;
#pragma unroll
            for (int j = 0; j < 4; ++j) { const f32x4 d = v[j] - mean; q += (d[0] * d[0] + d[1] * d[1]) + (d[2] * d[2] + d[3] * d[3]); }
            const float rstd = 1.0f / sqrtf(wave_sum(q) * (1.0f / 1024.0f) + LN_EPS);
            if (lane == 0) stats[16 * wid + k] = (f32x2){mean, rstd};
        }
    }
    __syncthreads();
    const int g = 4 * gh + (wid & 3);
    LAS unsigned char* img = lds + wid * GM_IMG;
    const int blk = (lane >> 4) & 1, q4 = (lane & 15) >> 2, p4 = lane & 3;
    const unsigned itr = lds_addr(img) + (unsigned)((8 * hl + q4) * 96 + 32 * blk + 8 * p4);
    const bf16* wbase = WSb + ((size_t)(g * 128 + l31) * 128 + 8 * hl);
    for (int cbi = 0; cbi < 2; ++cbi) {
        const int cbase = 128 * g + 32 * (2 * (wid >> 2) + cbi);
        u32x4 vraw[2][4];
#pragma unroll
        for (int j2 = 0; j2 < 2; ++j2)
#pragma unroll
            for (int k4 = 0; k4 < 4; ++k4) vraw[j2][k4] = *(const u32x4*)(ZB + (size_t)(row0 + lane + 64 * j2) * 2048 + 1024 + cbase + 8 * k4);
        bf16x8 wf[4][4];
#pragma unroll
        for (int s4 = 0; s4 < 4; ++s4)
#pragma unroll
            for (int qb = 0; qb < 4; ++qb) wf[s4][qb] = *(const bf16x8*)(wbase + (size_t)(32 * qb) * 128 + 16 * s4);
#pragma unroll
        for (int j2 = 0; j2 < 2; ++j2) {
            const int p = lane + 64 * j2; const f32x2 st = stats[p];
#pragma unroll
            for (int k4 = 0; k4 < 4; ++k4) {
                f32x4 a, bq; unpack8(vraw[j2][k4], a, bq);
                const f32x4 g0 = *(const f32x4*)(lng + cbase + 8 * k4), g1 = *(const f32x4*)(lng + cbase + 8 * k4 + 4), b0 = *(const f32x4*)(lnb + cbase + 8 * k4), b1 = *(const f32x4*)(lnb + cbase + 8 * k4 + 4);
                a = (a - st.x) * st.y * g0 + b0; bq = (bq - st.x) * st.y * g1 + b1;
                *(LAS u32x4*)(img + p * 96 + 16 * k4) = pg8::pack8(a, bq);
            }
        }
        u32x2 uw[4][4]; float bqv[4];
#pragma unroll
        for (int qb = 0; qb < 4; ++qb) { bqv[qb] = bs[g * 128 + 32 * qb + l31];
#pragma unroll
            for (int gq = 0; gq < 4; ++gq) uw[qb][gq] = *(const u32x2*)(ZB + (size_t)(row0 + 32 * qb + l31) * 2048 + cbase + 8 * gq + 4 * hl); }
        LDS_WAIT();
        f32x16 acc[4];
#pragma unroll
        for (int qb = 0; qb < 4; ++qb)
#pragma unroll
            for (int i = 0; i < 16; ++i) acc[qb][i] = 0.f;
#define GM_STEP(S, WF) do { const bf16x8 vf = tr_read2<16 * S * 96, 16 * S * 96 + 4 * 96>(itr); \
            _Pragma("unroll") for (int qb = 0; qb < 4; ++qb) acc[qb] = MFMA32(vf, WF[S & 3][qb], acc[qb]); } while (0)
        GM_STEP(0, wf); GM_STEP(1, wf); GM_STEP(2, wf); GM_STEP(3, wf);
#pragma unroll
        for (int s4 = 0; s4 < 4; ++s4)
#pragma unroll
            for (int qb = 0; qb < 4; ++qb) wf[s4][qb] = *(const bf16x8*)(wbase + (size_t)(32 * qb) * 128 + 16 * (4 + s4));
        GM_STEP(4, wf); GM_STEP(5, wf); GM_STEP(6, wf); GM_STEP(7, wf);
#undef GM_STEP
#pragma unroll
        for (int qb = 0; qb < 4; ++qb) {
            const int q = 32 * qb + l31; const float bq = bqv[qb];
            const size_t row = (size_t)(row0 + q);
#pragma unroll
            for (int gq = 0; gq < 4; ++gq) { const int col = cbase + 8 * gq + 4 * hl;
                const u32x2 uwv = uw[qb][gq];
                u32x2 w; w.x = cvt_pk_bf16(bf_lo(uwv.x) * (acc[qb][4 * gq] + bq), bf_hi(uwv.x) * (acc[qb][4 * gq + 1] + bq)); w.y = cvt_pk_bf16(bf_lo(uwv.y) * (acc[qb][4 * gq + 2] + bq), bf_hi(uwv.y) * (acc[qb][4 * gq + 3] + bq));
                *(u32x2*)(ACAT + row * D + col) = w; }
        }
        LDS_WAIT();
    }
}

constexpr int S5_WAVE_LDS = 8192 + 16 * 272;
__device__ __forceinline__ void s5_chunk_ids(int ci, int& b, int& n, bool& isctx) { isctx = ci >= 128; if (isctx) { b = (ci - 128) >> 1; n = (ci - 128) & 1; } else { b = ci >> 6; n = ci & 63; } }
__device__ __forceinline__ int s5_scan_index(int d, int n, bool isctx) { return d == 0 ? (isctx ? n : 2 + n) : (isctx ? 1 - n : 2 + (63 - n)); }
__device__ __forceinline__ void s5_load_u(bf16x8 (&ufr)[4], const bf16* US, int row0, int g, int lane) {
#pragma unroll
    for (int tb = 0; tb < 4; ++tb) ufr[tb] = *(const bf16x8*)(US + (size_t)(row0 + 32 * tb + (lane & 31)) * SSW + SG * g + 8 * (lane >> 5));
}
__device__ __forceinline__ void s5_bu(f32x16 (&Dt)[4], const bf16x8 uf, const bf16x8 (&bfr)[4]) {
#pragma unroll
    for (int j = 0; j < 4; ++j) {
#pragma unroll
        for (int i = 0; i < 16; ++i) Dt[j][i] = 0.f;
        Dt[j] = MFMA32(uf, bfr[j], Dt[j]); }
}
template <int H2> __device__ __forceinline__ void s5_bu_to_lds(LAS float* bu, const f32x16 (&Dt)[4], int lane) {
    const int hl = lane >> 5, l31 = lane & 31;
#pragma unroll
    for (int j = 0; j < 4; ++j)
#pragma unroll
        for (int ii = 0; ii < 8; ++ii) { const int i = 8 * H2 + ii, tt = (ii & 3) + 8 * (ii >> 2) + 4 * hl; bu[tt * 128 + 32 * j + l31] = Dt[j][i]; }
    LDS_WAIT();
}
template <bool WRITE_H> __device__ __forceinline__ void s5_scan16(const LAS float* bu, LAS unsigned char* hs, int d, float ar, float ai, float& hr, float& hi, int lane) {
    for (int st = 0; st < 16; ++st) { const int tt = d ? 15 - st : st;
        const float br = bu[tt * 128 + lane], bi = bu[tt * 128 + 64 + lane];
        const float nr = ar * hr - ai * hi + br, ni = ar * hi + ai * hr + bi; hr = nr; hi = ni;
        if (WRITE_H) { const unsigned w = cvt_pk_bf16(hr, hi);
            *(LAS unsigned short*)(hs + tt * 272 + 2 * lane) = (unsigned short)(w & 0xffffu); *(LAS unsigned short*)(hs + tt * 272 + 128 + 2 * lane) = (unsigned short)(w >> 16); } }
    LDS_WAIT();
}
__device__ __forceinline__ void s5_pass1(LAS unsigned char* wl, const bf16* US, const f32x4* SA_l, const bf16* SBB_l, f32x2* HEND, int ci, int g, int lane) {
    LAS float* bu = (LAS float*)wl;
    int b, n; bool isctx; s5_chunk_ids(ci, b, n, isctx);
    const int row0 = 128 * ci;
    bf16x8 ufr[4]; s5_load_u(ufr, US, row0, g, lane);
#pragma unroll
    for (int d = 0; d < 2; ++d) {
        const int k = s5_scan_index(d, n, isctx);
        if (k == NK - 1) continue;
        const f32x4 A = SA_l[(d * NG + g) * NP + lane];
        bf16x8 bfr[4];
#pragma unroll
        for (int j = 0; j < 4; ++j) bfr[j] = *(const bf16x8*)(SBB_l + ((size_t)((d * NG + g) * 128 + 32 * j + (lane & 31)) * SG + 8 * (lane >> 5)));
        float hr = 0.f, hi = 0.f;
#pragma unroll
        for (int tbi = 0; tbi < 4; ++tbi) {
            const int tb = d ? 3 - tbi : tbi;
            f32x16 Dt[4]; s5_bu(Dt, ufr[tb], bfr);
            if (d == 0) { s5_bu_to_lds<0>(bu, Dt, lane); s5_scan16<false>(bu, nullptr, 0, A[0], A[1], hr, hi, lane); s5_bu_to_lds<1>(bu, Dt, lane); s5_scan16<false>(bu, nullptr, 0, A[0], A[1], hr, hi, lane); }
            else        { s5_bu_to_lds<1>(bu, Dt, lane); s5_scan16<false>(bu, nullptr, 1, A[0], A[1], hr, hi, lane); s5_bu_to_lds<0>(bu, Dt, lane); s5_scan16<false>(bu, nullptr, 1, A[0], A[1], hr, hi, lane); }
        }
        HEND[((size_t)((b * 2 + d) * NK + k) * NG + g) * NP + lane] = (f32x2){hr, hi};
    }
}
__device__ __forceinline__ void s5_pass2(LAS unsigned char* wl, const bf16* US, const f32x4* SA_l, const bf16* SBB_l, const bf16* SC_l, const f32x2* HEND, const float* dskip_l, bf16* YS, int ci, int g, int lane) {
    LAS float* bu = (LAS float*)wl; LAS unsigned char* hs = wl + 8192;
    int b, n; bool isctx; s5_chunk_ids(ci, b, n, isctx);
    const int row0 = 128 * ci;
    f32x4 yacc[8];
#pragma unroll
    for (int sb = 0; sb < 8; ++sb) yacc[sb] = (f32x4){0.f, 0.f, 0.f, 0.f};
    const int t16 = lane & 15, kq = lane >> 4;
    bf16x8 ufr[4]; s5_load_u(ufr, US, row0, g, lane);
#define S5_HALF(SB, H2, DIR) do { s5_bu_to_lds<H2>(bu, Dt, lane); s5_scan16<true>(bu, hs, DIR, A[0], A[1], hr, hi, lane); \
        _Pragma("unroll") for (int kb = 0; kb < 4; ++kb) { const bf16x8 hf = *(const LAS bf16x8*)(hs + t16 * 272 + 64 * kb + 16 * kq); yacc[SB] = MFMA16(cf[kb], hf, yacc[SB]); } \
        LDS_WAIT(); } while (0)
#pragma unroll
    for (int d = 0; d < 2; ++d) {
        const int k = s5_scan_index(d, n, isctx);
        const f32x4 A = SA_l[(d * NG + g) * NP + lane];
        bf16x8 bfr[4], cf[4];
#pragma unroll
        for (int j = 0; j < 4; ++j) bfr[j] = *(const bf16x8*)(SBB_l + ((size_t)((d * NG + g) * 128 + 32 * j + (lane & 31)) * SG + 8 * (lane >> 5)));
#pragma unroll
        for (int kb = 0; kb < 4; ++kb) cf[kb] = *(const bf16x8*)(SC_l + ((size_t)((d * NG + g) * SG + t16) * 128 + 32 * kb + 8 * kq));
        float hr = 0.f, hi = 0.f;
        const f32x2* he = HEND + ((size_t)((b * 2 + d) * NK) * NG + g) * NP + lane;
        for (int j0 = 0; j0 < k; j0 += 8) {
            f32x2 e[8];
#pragma unroll
            for (int q = 0; q < 8; ++q) { const int jj = (j0 + q < k) ? j0 + q : k - 1; e[q] = he[(size_t)jj * NG * NP]; }
#pragma unroll
            for (int q = 0; q < 8; ++q) if (j0 + q < k) { const float nr = A[2] * hr - A[3] * hi + e[q].x, ni = A[2] * hi + A[3] * hr + e[q].y; hr = nr; hi = ni; }
        }
        f32x16 Dt[4];
        if (d == 0) {
            s5_bu(Dt, ufr[0], bfr); S5_HALF(0, 0, 0); S5_HALF(1, 1, 0);
            s5_bu(Dt, ufr[1], bfr); S5_HALF(2, 0, 0); S5_HALF(3, 1, 0);
            s5_bu(Dt, ufr[2], bfr); S5_HALF(4, 0, 0); S5_HALF(5, 1, 0);
            s5_bu(Dt, ufr[3], bfr); S5_HALF(6, 0, 0); S5_HALF(7, 1, 0);
        } else {
            s5_bu(Dt, ufr[3], bfr); S5_HALF(7, 1, 1); S5_HALF(6, 0, 1);
            s5_bu(Dt, ufr[2], bfr); S5_HALF(5, 1, 1); S5_HALF(4, 0, 1);
            s5_bu(Dt, ufr[1], bfr); S5_HALF(3, 1, 1); S5_HALF(2, 0, 1);
            s5_bu(Dt, ufr[0], bfr); S5_HALF(1, 1, 1); S5_HALF(0, 0, 1);
        }
    }
#undef S5_HALF
    const f32x4 dsk = *(const f32x4*)(dskip_l + SG * g + 4 * kq);
#pragma unroll
    for (int sb = 0; sb < 8; ++sb) { const int t = 16 * sb + t16; const u32x2 uw = *(const u32x2*)(US + (size_t)(row0 + t) * SSW + SG * g + 4 * kq);
        const f32x4 us4 = {bf_lo(uw.x), bf_hi(uw.x), bf_lo(uw.y), bf_hi(uw.y)};
        f32x4 y = yacc[sb] + dsk * us4;
#pragma unroll
        for (int e = 0; e < 4; ++e) y[e] = gelu_tanh_f(y[e]);
        u32x2 w; w.x = cvt_pk_bf16(y[0], y[1]); w.y = cvt_pk_bf16(y[2], y[3]);
        *(u32x2*)(YS + (size_t)(row0 + t) * SSW + SG * g + 4 * kq) = w; }
}

constexpr int NPH = 2 + 13 * DEPTH;
__global__ void __launch_bounds__(512, 2) fwd_kernel(Args args) {
    extern __shared__ __attribute__((aligned(16))) unsigned char lds_raw[];
    LAS unsigned char* lds = (LAS unsigned char*)lds_raw;
    volatile LAS unsigned* MISC = (volatile LAS unsigned*)(lds + MISC_OFF);
    for (int u = threadIdx.x; u < (LDS_BYTES - LDSCTL_OFF) / 4; u += 512) ((LAS unsigned*)(lds + LDSCTL_OFF))[u] = 0u;
    __syncthreads();
    const int lo = args.ph_lo, hi = args.ph_hi;
    const bool use_bar = (hi - lo) > 1;
    XcdBarrier bar; bar.bar = (unsigned*)(args.ws + WS_CTL) + CW_BAR; bar.x = 0; bar.st = nullptr;
    if (use_bar) bar = xcd_barrier_post((unsigned*)(args.ws + WS_CTL) + CW_BAR, MISC + 8);
#ifndef PH_MASK
#define PH_MASK 0xFFFFFFFFu
#endif
#define IN(k) ((PH_MASK >> ((k) < 2 ? (k) : 2 + ((k) - 2) % 13) & 1u) && lo <= (k) && (k) < hi)
#define SEAM(k) do { if (IN(k) && IN((k) + 1)) xcd_barrier(bar); } while (0)
#define PHASE_IDS() int tid = threadIdx.x; asm volatile("" : "+v"(tid)); const int lane = tid & 63, wid = __builtin_amdgcn_readfirstlane(tid >> 6); \
    int bx = blockIdx.x, G = gridDim.x; asm volatile("" : "+s"(bx), "+s"(G)); GAS unsigned char* wsg_ = (GAS unsigned char*)args.ws; asm volatile("" : "+s"(wsg_)); unsigned char* ws = (unsigned char*)wsg_; const int gw = bx * 8 + wid, NGW = G * 8; (void)lane; (void)gw; (void)NGW
#define X ((float*)(ws + WS_X))
#define H ((bf16*)(ws + WS_H))
#define ACT ((bf16*)(ws + WS_ACT))
#define QP ((bf16*)(ws + WS_QP))
#define QR ((bf16*)(ws + WS_QR))
#define KB ((bf16*)(ws + WS_KB))
#define VB ((bf16*)(ws + WS_VB))
#define ZB ((bf16*)(ws + WS_ZB))
#define US ((bf16*)(ws + WS_US))
#define GB ((bf16*)(ws + WS_GB))
#define ACAT ((bf16*)(ws + WS_ACAT))
#define YS ((bf16*)(ws + WS_YS))
#define MG ((bf16*)(ws + WS_MG))
#define YB ((bf16*)(ws + WS_Y))
#define XSRC_IN (l == 0 ? as_global(args.in[0]) : nullptr)
#define modv ((const float*)(ws + WS_MOD))
#define WL(off) ((const bf16*)(ws + WS_W + (size_t)l * LW_BYTES + (off)))
#define MODL (modv + (size_t)l * 3 * NMODC)
#define LNG(i) (as_global(args.in[6]) + (size_t)(l * 3 + (i)) * D)
#define LNB(i) (as_global(args.in[7]) + (size_t)(l * 3 + (i)) * D)
#define MEFF (l == DEPTH - 1 ? ML : M)
constexpr int NCTXU = (MC / 256) * (D / 256);
#define OVL(mrows_) (use_bar && (mrows_) == M && G >= 4 * NCTXU)

    if (IN(0)) {
        PHASE_IDS();
        p0_tables(args, bx * 512 + tid, G * 512);
        p0_mod(args, lds, wid, lane, tid, G, bx);
        p0_weights(args, lds, wid, lane, G, bx);
        __syncthreads();
    }
    SEAM(0);
    if (IN(1)) { PHASE_IDS(); thin_phase(0, as_global(args.in[0]), as_global(args.in[2]), X, nullptr, nullptr, nullptr, modv, 0, 1, H, nullptr, M, gw, NGW, lane, (LAS float*)lds, tid); }
    SEAM(1);

    for (int l = 0; l < DEPTH; ++l) {
        const int pb = 2 + 13 * l;
        if (pb >= hi || pb + 13 <= lo) continue;
        if (IN(pb + 0)) { PHASE_IDS(); pg8::Gemm g{H, WL(LW_W1IN), M, 2 * DFF, D, D, D}; pg8::StaticOrder S; S.init(M, 2 * DFF, G, bx, D); pg8::EpiSwiGLU E{ACT, DFF};
            pg8::gemm_phase<pg8::EpiSwiGLU, pg8::StaticOrder>(lds, g, S, E, tid); }
        SEAM(pb + 0);
        if (IN(pb + 1)) { PHASE_IDS(); const int mr = OVL(M) ? ML : M; pg8::Gemm g{ACT, WL(LW_W1OUT), mr, D, DFF, DFF, DFF}; pg8::StaticOrder S; S.init(mr, D, G, bx, DFF); pg8::EpiY E{YB, MODL, 2, 0.5f};
            pg8::gemm_phase<pg8::EpiY, pg8::StaticOrder>(lds, g, S, E, tid); }
        SEAM(pb + 1);
        if (IN(pb + 2)) { PHASE_IDS();
            if (OVL(M)) {
                if (bx < NCTXU) { pg8::Gemm g{ACT, WL(LW_W1OUT), M, D, DFF, DFF, DFF}; pg8::CtxOrder S; S.init(D, bx, DFF); pg8::EpiY E{YB, MODL, 2, 0.5f}; pg8::gemm_phase<pg8::EpiY, pg8::CtxOrder>(lds, g, S, E, tid); }
                else thin_phase(1, XSRC_IN, as_global(args.in[2]), X, YB, LNG(0), LNB(0), MODL, 3, 4, H, nullptr, ML, (bx - NCTXU) * 8 + wid, (G - NCTXU) * 8, lane, (LAS float*)lds, tid, (unsigned char*)ACT);
                xcd_barrier(bar);
                thin_phase(1, XSRC_IN, as_global(args.in[2]), X, YB, LNG(0), LNB(0), MODL, 3, 4, H, nullptr, M, gw, NGW, lane, (LAS float*)lds, tid, (unsigned char*)ACT, ML);
            } else thin_phase(1, XSRC_IN, as_global(args.in[2]), X, YB, LNG(0), LNB(0), MODL, 3, 4, H, nullptr, M, gw, NGW, lane, (LAS float*)lds, tid, (unsigned char*)ACT); }
        SEAM(pb + 2);
        if (IN(pb + 3)) {
            { PHASE_IDS(); pg8::Gemm g{H, WL(LW_WIN), M, 36 * 256, D, D, D}; pg8::StaticOrder S; S.init(M, 36 * 256, G, bx, D);
              pg8::EpiIn<false> E{ws, (const float*)(ws + WS_ROPE), 0, 1.0f};
              pg8::gemm_phase<pg8::EpiIn<false>, pg8::StaticOrder>(lds, g, S, E, tid); }
            { PHASE_IDS(); pg8::Gemm g{ACT, WL(LW_W8), MEFF, 48 * 256, D / 2, D / 2, D / 2}; pg8::StaticOrder S; S.init(MEFF, 48 * 256, G, (bx + G / 2) % G, D / 2);
              pg8::EpiIn<true> E{ws, (const float*)(ws + WS_ROPE), 36, 1.0f / 16384.0f};
              pg8::gemm_phase<pg8::EpiIn<true>, pg8::StaticOrder>(lds, g, S, E, tid); }
        }
        SEAM(pb + 3);
#ifndef M1_MASK
#define M1_MASK 7
#endif
        if (IN(pb + 4)) {
            if (M1_MASK & 1) { PHASE_IDS();
                const float* rpb_l = as_global(args.in[13]) + (size_t)l * NH * 465;
                for (int u = bx; u < (l == DEPTH - 1 ? 1024 : 1056); u += G) {
                    if (u < 1024) { const int rb = u & 31, h = (u >> 5) & 15, b = u >> 9; attn_unit(lds, QP, QR, KB, VB, ACAT, rpb_l, b, h, 4 * rb, tid, wid, lane); }
                    else { const int v = u - 1024; attn_unit(lds, QP, QR, KB, VB, ACAT, rpb_l, v >> 4, v & 15, -1, tid, wid, lane); }
                }
                __syncthreads(); }
            if (M1_MASK & 2) { PHASE_IDS();
                for (int u = (G - 1 - bx); u < 2 * (MEFF / 128); u += G)
                    gmlp_unit(lds, ZB, ACAT, as_global(args.in[14]) + (size_t)l * GMW, as_global(args.in[15]) + (size_t)l * GMW, (const bf16*)(ws + WS_GWS) + (size_t)l * 8 * 128 * 128, as_global(args.in[17]) + (size_t)l * 8 * 128, u, tid, wid, lane);
                __syncthreads(); }
            if (M1_MASK & 4) { PHASE_IDS();
                for (int u = gw; u < NCH * NG; u += NGW)
                    s5_pass1(lds + wid * S5_WAVE_LDS, US, (const f32x4*)(ws + WS_SA) + (size_t)l * 2 * NG * NP, (const bf16*)(ws + WS_SBB) + (size_t)l * 2 * NG * 128 * SG, (f32x2*)(ws + WS_HEND), u >> 6, u & 63, lane);
                __syncthreads(); }
        }
        SEAM(pb + 4);
        if (IN(pb + 5)) { PHASE_IDS();
            for (int u = gw; u < (MEFF / 128) * NG; u += NGW)
                s5_pass2(lds + wid * S5_WAVE_LDS, US, (const f32x4*)(ws + WS_SA) + (size_t)l * 2 * NG * NP, (const bf16*)(ws + WS_SBB) + (size_t)l * 2 * NG * 128 * SG, (const bf16*)(ws + WS_SC) + (size_t)l * 2 * NG * SG * 128,
                         (const f32x2*)(ws + WS_HEND), as_global(args.in[25]) + (size_t)l * SSW, YS, u >> 6, u & 63, lane);
            __syncthreads();
        }
        SEAM(pb + 5);
        if (IN(pb + 6)) { PHASE_IDS(); pg8::Gemm g{YS, WL(LW_WGLU), MEFF, SSW, SSW, SSW, SSW}; pg8::StaticOrder S; S.init(MEFF, SSW, G, bx, SSW); pg8::EpiGLU E{YS, ACAT + GMW + AW, as_global(args.in[27]) + (size_t)l * SSW};
            pg8::gemm_phase<pg8::EpiGLU, pg8::StaticOrder>(lds, g, S, E, tid); }
        SEAM(pb + 6);
        if (IN(pb + 7)) { PHASE_IDS(); pg8::Gemm g{ACAT, WL(LW_WCAT), MEFF, D, D, D, D}; pg8::MergeOrder S; S.init(MEFF, D, G, bx); pg8::EpiMerge1 E{GB, MG};
            pg8::gemm_phase<pg8::EpiMerge1, pg8::MergeOrder>(lds, g, S, E, tid); }
        SEAM(pb + 7);
        if (IN(pb + 8)) { PHASE_IDS(); const int mr = OVL(MEFF) ? ML : MEFF; pg8::Gemm g{MG, WL(LW_WO), mr, D, D, D, D}; pg8::StaticOrder S; S.init(mr, D, G, bx, D); pg8::EpiY E{YB, MODL, 5, 1.0f};
            pg8::gemm_phase<pg8::EpiY, pg8::StaticOrder>(lds, g, S, E, tid); }
        SEAM(pb + 8);
        if (IN(pb + 9)) { PHASE_IDS();
            if (OVL(MEFF)) {
                if (bx < NCTXU) { pg8::Gemm g{MG, WL(LW_WO), M, D, D, D, D}; pg8::CtxOrder S; S.init(D, bx, D); pg8::EpiY E{YB, MODL, 5, 1.0f}; pg8::gemm_phase<pg8::EpiY, pg8::CtxOrder>(lds, g, S, E, tid); }
                else thin_phase(1, nullptr, nullptr, X, YB, LNG(1), LNB(1), MODL, 6, 7, H, nullptr, ML, (bx - NCTXU) * 8 + wid, (G - NCTXU) * 8, lane, (LAS float*)lds, tid);
                xcd_barrier(bar);
                thin_phase(1, nullptr, nullptr, X, YB, LNG(1), LNB(1), MODL, 6, 7, H, nullptr, M, gw, NGW, lane, (LAS float*)lds, tid, nullptr, ML);
            } else thin_phase(1, nullptr, nullptr, X, YB, LNG(1), LNB(1), MODL, 6, 7, H, nullptr, MEFF, gw, NGW, lane, (LAS float*)lds, tid); }
        SEAM(pb + 9);
        if (IN(pb + 10)) { PHASE_IDS(); pg8::Gemm g{H, WL(LW_W2IN), MEFF, 2 * DFF, D, D, D}; pg8::StaticOrder S; S.init(MEFF, 2 * DFF, G, bx, D); pg8::EpiSwiGLU E{ACT, DFF};
            pg8::gemm_phase<pg8::EpiSwiGLU, pg8::StaticOrder>(lds, g, S, E, tid); }
        SEAM(pb + 10);
        if (IN(pb + 11)) { PHASE_IDS(); const int mr = OVL(MEFF) ? ML : MEFF; pg8::Gemm g{ACT, WL(LW_W2OUT), mr, D, DFF, DFF, DFF}; pg8::StaticOrder S; S.init(mr, D, G, bx, DFF); pg8::EpiY E{YB, MODL, 8, 0.5f};
            pg8::gemm_phase<pg8::EpiY, pg8::StaticOrder>(lds, g, S, E, tid); }
        SEAM(pb + 11);
        if (IN(pb + 12)) { PHASE_IDS();
            if (l + 1 < DEPTH && OVL(M)) {
                if (bx < NCTXU) { pg8::Gemm g{ACT, WL(LW_W2OUT), M, D, DFF, DFF, DFF}; pg8::CtxOrder S; S.init(D, bx, DFF); pg8::EpiY E{YB, MODL, 8, 0.5f}; pg8::gemm_phase<pg8::EpiY, pg8::CtxOrder>(lds, g, S, E, tid); }
                else thin_phase(1, nullptr, nullptr, X, YB, LNG(2), LNB(2), MODL + 3 * NMODC, 0, 1, H, nullptr, ML, (bx - NCTXU) * 8 + wid, (G - NCTXU) * 8, lane, (LAS float*)lds, tid);
                xcd_barrier(bar);
                thin_phase(1, nullptr, nullptr, X, YB, LNG(2), LNB(2), MODL + 3 * NMODC, 0, 1, H, nullptr, M, gw, NGW, lane, (LAS float*)lds, tid, nullptr, ML);
            } else if (l + 1 < DEPTH) thin_phase(1, nullptr, nullptr, X, YB, LNG(2), LNB(2), MODL + 3 * NMODC, 0, 1, H, nullptr, M, gw, NGW, lane, (LAS float*)lds, tid);
            else thin_phase(2, nullptr, nullptr, X, YB, LNG(2), LNB(2), MODL, 0, 1, H, as_global(args.out), ML, gw, NGW, lane, (LAS float*)lds, tid);
        }
        SEAM(pb + 12);
    }
}

extern "C" void kernel_launch(void* const* d_in, const int* in_sizes, int n_in, void* d_out, int out_size, void* d_ws, size_t ws_size, hipStream_t stream) {
    static int grid = 0;
    if (grid == 0) {
        if (n_in != 32 || out_size != ML * D || ws_size < WS_END) { fprintf(stderr, "kernel_launch: unexpected sizes (n_in %d, out %d, ws %zu, need %zu)\n", n_in, out_size, ws_size, (size_t)WS_END); grid = -1; return; }
        int dev = 0, cus = 0, per_cu = 0;
        if (hipGetDevice(&dev) != hipSuccess || hipDeviceGetAttribute(&cus, hipDeviceAttributeMultiprocessorCount, dev) != hipSuccess) { grid = -1; return; }
        if (hipFuncSetAttribute((const void*)fwd_kernel, hipFuncAttributeMaxDynamicSharedMemorySize, LDS_BYTES) != hipSuccess) { fprintf(stderr, "kernel_launch: hipFuncSetAttribute failed\n"); grid = -1; return; }
        if (hipOccupancyMaxActiveBlocksPerMultiprocessor(&per_cu, (const void*)fwd_kernel, 512, LDS_BYTES) != hipSuccess || per_cu < 1) fprintf(stderr, "kernel_launch: occupancy query says %d\n", per_cu);
        (void)hipGetLastError();
        grid = cus;
    }
    if (grid < 0) return;
    (void)hipMemsetAsync((char*)d_ws + WS_CTL, 0, CTL_ZERO_BYTES, stream);
    Args a{};
    for (int i = 0; i < 32; ++i) a.in[i] = (const float*)d_in[i];
    a.out = (float*)d_out; a.ws = (unsigned char*)d_ws;
#if MK_N_LAUNCHES == 1
    a.ph_lo = 0; a.ph_hi = NPH;
    hipLaunchKernelGGL(fwd_kernel, dim3(grid), dim3(512), LDS_BYTES, stream, a);
#else
    for (int p = 0; p < NPH; ++p) { a.ph_lo = p; a.ph_hi = p + 1; hipLaunchKernelGGL(fwd_kernel, dim3(grid), dim3(512), LDS_BYTES, stream, a); }
#endif
}
```

```cpp
#include <hip/hip_runtime.h>
#include <cstdio>
#include <cstdint>

#ifndef MK_N_LAUNCHES
#define MK_N_LAUNCHES 1
#endif

#define GAS __attribute__((address_space(1)))
#define LAS __attribute__((address_space(3)))
typedef unsigned short bf16;
typedef short bf16x8 __attribute__((ext_vector_type(8)));
typedef short s16x4 __attribute__((ext_vector_type(4)));
typedef float f32x2 __attribute__((ext_vector_type(2)));
typedef float f32x4 __attribute__((ext_vector_type(4)));
typedef float f32x16 __attribute__((ext_vector_type(16)));
typedef unsigned u32x2 __attribute__((ext_vector_type(2)));
typedef unsigned u32x4 __attribute__((ext_vector_type(4)));

constexpr int D = 4096, NB = 2, SEQ = 8192, CTXL = 256, DEPTH = 2;
constexpr int ML = NB * SEQ, MC = NB * CTXL, M = ML + MC;
constexpr int DFF = 6144, NMOD = 9, NMODC = NMOD * D;
constexpr int AW = 2048, NH = 16, HD = 128, GMW = 1024, SSW = 1024, NG = 64, NP = 64, SG = 16;
constexpr int NIN = 21504;
constexpr int NCH = M / 128;
constexpr int NK = 66;
constexpr float ALPHA = 1.4142135623730951f, LN_EPS = 1e-6f, LOG2E = 1.4426950408889634f;

constexpr size_t MiB = 1u << 20;
constexpr size_t WS_CTL = 0, CTL_ZERO_BYTES = 1 * MiB;
constexpr size_t WS_MOD = 1 * MiB;
constexpr size_t WS_ROPE = 2 * MiB;
constexpr size_t WS_SA = 3 * MiB;
constexpr size_t WS_SBB = 4 * MiB;
constexpr size_t WS_SC = 6 * MiB;
constexpr size_t WS_GWS = 7 * MiB;
constexpr size_t WS_HEND = 8 * MiB;
constexpr size_t WS_W = 32 * MiB;
constexpr size_t LW_W1IN = 0, LW_W1OUT = 96 * MiB, LW_W2IN = 144 * MiB, LW_W2OUT = 240 * MiB, LW_WIN = 288 * MiB, LW_WGLU = 456 * MiB, LW_WCAT = 458 * MiB, LW_WO = 490 * MiB, LW_W8 = 522 * MiB  , LW_BYTES = 570 * MiB;
constexpr size_t WS_X = WS_W + 2 * LW_BYTES;
constexpr size_t WS_H = WS_X + 264 * MiB;
constexpr size_t WS_ACT = WS_H + 132 * MiB;
constexpr size_t WS_QP = WS_ACT + 198 * MiB;
constexpr size_t WS_QR = WS_QP + 66 * MiB;
constexpr size_t WS_KB = WS_QR + 66 * MiB;
constexpr size_t WS_VB = WS_KB + 66 * MiB;
constexpr size_t WS_ZB = WS_VB + 66 * MiB;
constexpr size_t WS_US = WS_ZB + 66 * MiB;
constexpr size_t WS_GB = WS_US + 33 * MiB;
constexpr size_t WS_ACAT = WS_GB + 396 * MiB;
constexpr size_t WS_YS = WS_ACAT + 132 * MiB;
constexpr size_t WS_MG = WS_YS + 33 * MiB;
constexpr size_t WS_Y = WS_MG + 132 * MiB;
constexpr size_t WS_END = WS_Y + 132 * MiB;
constexpr int CW_BAR = 4096;

constexpr int RING_BYTES = 131072, LDSCTL_OFF = RING_BYTES, MISC_OFF = LDSCTL_OFF + 320, LDS_BYTES = 147456;

__device__ __forceinline__ unsigned cvt_pk_bf16(float lo, float hi) { unsigned r; asm volatile("v_cvt_pk_bf16_f32 %0, %1, %2" : "=v"(r) : "v"(lo), "v"(hi)); return r; }
__device__ __forceinline__ float bf_lo(unsigned w) { return __uint_as_float(w << 16); }
__device__ __forceinline__ float bf_hi(unsigned w) { return __uint_as_float(w & 0xffff0000u); }
__device__ __forceinline__ float fast_sigmoid(float x) { return __builtin_amdgcn_rcpf(1.0f + __builtin_amdgcn_exp2f(-LOG2E * x)); }
__device__ __forceinline__ float silu_f(float x) { return x * fast_sigmoid(x); }
__device__ __forceinline__ float gelu_tanh_f(float x) { const float u = 1.5957691216057308f * (x + 0.044715f * x * x * x); return x * fast_sigmoid(u); }
template <class T> __device__ __forceinline__ T* as_global(T* p) { return (T*)(GAS T*)p; }
#define LDS_WAIT() asm volatile("s_waitcnt lgkmcnt(0)" ::: "memory")
#define VM_WAIT() asm volatile("s_waitcnt vmcnt(0)" ::: "memory")

namespace pg8 {
constexpr int BM = 256, BK = 64, HALF = 128, HTB = HALF * BK * 2, STAGE_BYTES = 8 * HTB, NXCD = 8, WGM = 4;
__host__ __device__ __forceinline__ int lds_byte(int r, int c) { const int st = (r >> 4) * 2 + (c >> 5), rr = r & 15, cc = c & 31, ob = rr * 64 + cc * 2; return st * 1024 + (ob ^ (((ob >> 9) & 1) << 5)); }
__host__ __device__ __forceinline__ void stage_rc(int b, int& R, int& C) { const int st = b / 1024, sb = b % 1024, swz = sb ^ (((sb >> 9) & 1) << 5); R = (st >> 1) * 16 + swz / 64; C = (st & 1) * 32 + (swz % 64) / 2; }
__host__ __device__ __forceinline__ int perm32(int rho) { const int n = rho >> 4, i = rho & 15; return 8 * (i >> 2) + 4 * n + (i & 3); }
typedef int v8i __attribute__((ext_vector_type(8)));
typedef int v4i __attribute__((ext_vector_type(4)));
struct Unit { int pm, pn, k0, nt, seg; };
struct Gemm { const bf16* A; const bf16* Bt; int M, N, K, lda, ldb; };
struct StaticOrder {
    int nM, nN, nwg, G, c, ntk;
    __host__ __device__ void init(int M_, int N_, int G_, int c_, int K_) { nM = M_ / BM; nN = N_ / BM; nwg = nM * nN; G = G_; c = c_; ntk = K_ / BK; }
    __host__ __device__ __forceinline__ bool next(int i, Unit& u) const {
        u.pm = 0; u.pn = 0; u.k0 = 0; u.nt = ntk; u.seg = 0;
        const long L = (long)i * G + c; if (L >= nwg) return false;
        int wgid = (int)L; { const int q = nwg / NXCD, r = nwg % NXCD, xcd = wgid % NXCD, off = wgid / NXCD; wgid = (xcd < r ? xcd * (q + 1) : r * (q + 1) + (xcd - r) * q) + off; }
        const int nig = WGM * nN, gid = wgid / nig, fm = gid * WGM, gsz = (nM - fm) < WGM ? (nM - fm) : WGM;
        u.pm = fm + ((wgid % nig) % gsz); u.pn = (wgid % nig) / gsz; return true;
    }
    __device__ __forceinline__ void a_ready(const Unit&) const {}
    __device__ __forceinline__ void done(const Unit&) const {}
};

struct CtxOrder {
    int nN, c, ntk;
    __host__ __device__ void init(int N_, int c_, int K_) { nN = N_ / BM; c = c_; ntk = K_ / BK; }
    __host__ __device__ __forceinline__ bool next(int i, Unit& u) const { u.pm = ML / BM + c / nN; u.pn = c % nN; u.k0 = 0; u.nt = ntk; u.seg = 0; return i == 0 && c < (MC / BM) * nN; }
    __device__ __forceinline__ void a_ready(const Unit&) const {}
    __device__ __forceinline__ void done(const Unit&) const {}
};
struct MergeOrder {
    StaticOrder tiles;
    __host__ __device__ void init(int M_, int N_, int G_, int c_) { tiles.init(M_, N_, G_, c_, GMW + AW + SSW); }
    __host__ __device__ __forceinline__ bool next(int i, Unit& u) const {
        const int it = i / 3, sg = i - 3 * it; Unit t; const bool ok = tiles.next(it, t);
        u.pm = t.pm; u.pn = t.pn; u.seg = sg; u.k0 = sg == 0 ? 0 : (sg == 1 ? GMW : GMW + AW); u.nt = (sg == 1 ? AW : GMW) / BK; return ok;
    }
    __device__ __forceinline__ void a_ready(const Unit&) const {}
    __device__ __forceinline__ void done(const Unit&) const {}
};

template <class Epi, class Sched, bool ALIGN_EPI = true, bool SP2 = true>
__device__ __forceinline__ void gemm_phase(LAS unsigned char* lds, const Gemm g, const Sched& S, const Epi& E, const int tid) {
    const int wid = __builtin_amdgcn_readfirstlane(tid >> 6), lane = tid & 63, wr = wid >> 2, wc = wid & 3, fr = lane & 15, fq = lane >> 4;
    unsigned voffA[2], voffB[2];
#pragma unroll
    for (int i = 0; i < 2; ++i) { int R, C; stage_rc(tid * 16 + i * 8192, R, C); const int Rb = Epi::PERM ? ((R & ~31) + perm32(R & 31)) : R;
        voffA[i] = (unsigned)(R * g.lda + C) * 2u; voffB[i] = (unsigned)(Rb * g.ldb + C) * 2u; }
    const unsigned kstep = (unsigned)(BK * 2);
    const unsigned hA = (unsigned)HALF * (unsigned)g.lda * 2u, hB = (unsigned)HALF * (unsigned)g.ldb * 2u;
    const unsigned tA = 2 * hA, tB = 2 * hB;
    const __amdgpu_buffer_rsrc_t srd_voffA = __builtin_amdgcn_make_buffer_rsrc((void*)g.A, 0, 0x7ffffff0, 0x00020000);
    const __amdgpu_buffer_rsrc_t srd_voffB = __builtin_amdgcn_make_buffer_rsrc((void*)g.Bt, 0, 0x7ffffff0, 0x00020000);
    const unsigned ldsw = (unsigned)wid * 1024u;
    constexpr bool FP8 = Epi::FP8;
    const int aoff = FP8 ? lds_byte(wr * 64 + fr, fq * 16) : lds_byte(wr * 64 + fr, fq * 8), boff = FP8 ? lds_byte(wc * 32 + fr, fq * 16) : lds_byte(wc * 32 + fr, fq * 8);
    const int aoff1 = FP8 ? lds_byte(wr * 64 + fr, fq * 16 + 8) : aoff + 1024, boff1 = FP8 ? lds_byte(wc * 32 + fr, fq * 16 + 8) : boff + 1024;
#define PG8_SA(b, h) (((b) * 2 + (h)) * HTB)
#define PG8_SB(b, h) ((4 + (b) * 2 + (h)) * HTB)
#define PG8_STAGE(bufoff, gbase, voff) do { _Pragma("unroll") for (int _i = 0; _i < 2; ++_i) \
        __builtin_amdgcn_raw_ptr_buffer_load_lds(srd_##voff, (LAS void*)(lds + (bufoff) + ldsw + _i * 8192), 16, (int)(voff)[_i], (int)(gbase), 0, 0); } while (0)
#define PG8_LDA(dst, b, h) do { if constexpr (FP8) { _Pragma("unroll") for (int m = 0; m < 4; ++m) { dst##8[m].lo = *(const LAS v4i*)(lds + PG8_SA(b, h) + aoff + m * 2048); dst##8[m].hi = *(const LAS v4i*)(lds + PG8_SA(b, h) + aoff1 + m * 2048); } } \
        else { _Pragma("unroll") for (int m = 0; m < 4; ++m) _Pragma("unroll") for (int k = 0; k < 2; ++k) dst[m][k] = *(const LAS bf16x8*)(lds + PG8_SA(b, h) + (k ? aoff1 : aoff) + m * 2048); } } while (0)
#define PG8_LDB(dst, b, h) do { if constexpr (FP8) { _Pragma("unroll") for (int n = 0; n < 2; ++n) { dst##8[n].lo = *(const LAS v4i*)(lds + PG8_SB(b, h) + boff + n * 2048); dst##8[n].hi = *(const LAS v4i*)(lds + PG8_SB(b, h) + boff1 + n * 2048); } } \
        else { _Pragma("unroll") for (int n = 0; n < 2; ++n) _Pragma("unroll") for (int k = 0; k < 2; ++k) dst[n][k] = *(const LAS bf16x8*)(lds + PG8_SB(b, h) + (k ? boff1 : boff) + n * 2048); } } while (0)
#define PG8_MMA(ai, bj, At, Bt) do { __builtin_amdgcn_s_setprio(1); _Pragma("unroll") for (int m = 0; m < 4; ++m) _Pragma("unroll") for (int n = 0; n < 2; ++n) { \
        if constexpr (FP8) asm volatile("v_mfma_scale_f32_16x16x128_f8f6f4 %0, %1, %2, %0, %3, %3 op_sel_hi:[0,0,0]" : "+v"(acc[ai][bj][m][n]) : "v"(Bt##8[n]), "v"(At##8[m]), "v"(scale1));   \
        else { _Pragma("unroll") for (int k = 0; k < 2; ++k) acc[ai][bj][m][n] = __builtin_amdgcn_mfma_f32_16x16x32_bf16(Bt[n][k], At[m][k], acc[ai][bj][m][n], 0, 0, 0); } } __builtin_amdgcn_s_setprio(0); } while (0)
#define PG8_WAIT_V(n) asm volatile("s_waitcnt vmcnt(" #n ")" ::: "memory")
#define PG8_WAIT_L(n) asm volatile("s_waitcnt lgkmcnt(" #n ")" ::: "memory")
#define PG8_BAR __builtin_amdgcn_s_barrier()
#define PG8_SCHED __builtin_amdgcn_sched_barrier(0)
    Unit cur, nxt; int ui = 0;
    if (!S.next(0, cur)) return;
    f32x4 acc[2][2][4][2];
#pragma unroll
    for (int a = 0; a < 2; ++a)
#pragma unroll
        for (int b = 0; b < 2; ++b)
#pragma unroll
            for (int m = 0; m < 4; ++m)
#pragma unroll
                for (int n = 0; n < 2; ++n) acc[a][b][m][n] = (f32x4){0.f, 0.f, 0.f, 0.f};
    const int scale1 = 0x7f7f7f7f;
    bf16x8 At[4][2], B0[2][2], B1[2][2]; v8i At8[4], B08[2], B18[2];
    unsigned cA = (unsigned)cur.pm * tA + (unsigned)cur.k0 * 2u, cB = (unsigned)cur.pn * tB + (unsigned)cur.k0 * 2u;
    S.a_ready(cur);
    if constexpr (SP2) {
        PG8_STAGE(PG8_SB(0, 0), cB, voffB); PG8_STAGE(PG8_SB(0, 1), cB + hB, voffB); PG8_STAGE(PG8_SA(0, 0), cA, voffA); PG8_STAGE(PG8_SA(0, 1), cA + hA, voffA);
        if (wr == 1) PG8_BAR;
        PG8_WAIT_V(2); PG8_BAR;
        PG8_STAGE(PG8_SB(1, 0), cB + kstep, voffB); PG8_STAGE(PG8_SA(1, 0), cA + kstep, voffA); PG8_STAGE(PG8_SB(1, 1), cB + hB + kstep, voffB);
        PG8_WAIT_V(6); PG8_BAR;
    } else {
        PG8_STAGE(PG8_SB(0, 0), cB, voffB); PG8_STAGE(PG8_SA(0, 0), cA, voffA); PG8_STAGE(PG8_SB(0, 1), cB + hB, voffB); PG8_STAGE(PG8_SA(0, 1), cA + hA, voffA);
        if (wr == 1) PG8_BAR;
        PG8_WAIT_V(4); PG8_BAR;
        PG8_STAGE(PG8_SB(1, 0), cB + kstep, voffB); PG8_STAGE(PG8_SA(1, 0), cA + kstep, voffA); PG8_STAGE(PG8_SB(1, 1), cB + hB + kstep, voffB);
        PG8_WAIT_V(6); PG8_BAR;
    }
    for (;;) {
        const bool has_next = S.next(ui + 1, nxt);
        const unsigned nA = has_next ? (unsigned)nxt.pm * tA + (unsigned)nxt.k0 * 2u : cA, nB = has_next ? (unsigned)nxt.pn * tB + (unsigned)nxt.k0 * 2u : cB;
        const int nt = cur.nt;
        for (int t = 0; t < nt; t += 2) {
            const bool last = (t == nt - 2);
            const unsigned a1 = cA + (unsigned)(t + 1) * kstep;
            const unsigned a2 = last ? nA : cA + (unsigned)(t + 2) * kstep, b2 = last ? nB : cB + (unsigned)(t + 2) * kstep;
            const unsigned a3 = a2 + kstep, b3 = b2 + kstep;
            if (last && has_next) S.a_ready(nxt);
            if constexpr (SP2) {
            PG8_LDB(B0, 0, 0); PG8_LDB(B1, 0, 1); PG8_SCHED; PG8_LDA(At, 0, 0); PG8_STAGE(PG8_SA(1, 1), a1 + hA, voffA);
            PG8_WAIT_V(8); PG8_WAIT_L(0); PG8_BAR; PG8_MMA(0, 0, At, B0); PG8_MMA(0, 1, At, B1); PG8_BAR; PG8_SCHED;
            PG8_LDA(At, 0, 1); PG8_STAGE(PG8_SB(0, 0), b2, voffB); PG8_STAGE(PG8_SB(0, 1), b2 + hB, voffB); PG8_STAGE(PG8_SA(0, 0), a2, voffA);
            PG8_WAIT_V(8); PG8_WAIT_L(0); PG8_BAR; PG8_MMA(1, 0, At, B0); PG8_MMA(1, 1, At, B1); PG8_BAR; PG8_SCHED;
            PG8_LDB(B0, 1, 0); PG8_LDB(B1, 1, 1); PG8_SCHED; PG8_LDA(At, 1, 0); PG8_STAGE(PG8_SA(0, 1), a2 + hA, voffA);
            PG8_WAIT_V(8); PG8_WAIT_L(0); PG8_BAR; PG8_MMA(0, 0, At, B0); PG8_MMA(0, 1, At, B1); PG8_BAR; PG8_SCHED;
            PG8_LDA(At, 1, 1); PG8_STAGE(PG8_SB(1, 0), b3, voffB); PG8_STAGE(PG8_SB(1, 1), b3 + hB, voffB); PG8_STAGE(PG8_SA(1, 0), a3, voffA);
            PG8_WAIT_V(8); PG8_WAIT_L(0); PG8_BAR; PG8_MMA(1, 0, At, B0); PG8_MMA(1, 1, At, B1); PG8_BAR; PG8_SCHED;
            } else {
            PG8_LDB(B0, 0, 0); PG8_SCHED; PG8_LDA(At, 0, 0); PG8_STAGE(PG8_SA(1, 1), a1 + hA, voffA);
            PG8_WAIT_L(8); PG8_BAR; PG8_WAIT_L(0); PG8_MMA(0, 0, At, B0); PG8_BAR; PG8_SCHED;
            PG8_LDB(B1, 0, 1); PG8_STAGE(PG8_SB(0, 0), b2, voffB);
            PG8_BAR; PG8_WAIT_L(0); PG8_MMA(0, 1, At, B1); PG8_BAR;
            PG8_LDA(At, 0, 1); PG8_STAGE(PG8_SA(0, 0), a2, voffA);
            PG8_BAR; PG8_WAIT_L(0); PG8_MMA(1, 0, At, B0); PG8_BAR; PG8_SCHED;
            PG8_STAGE(PG8_SB(0, 1), b2 + hB, voffB);
            PG8_WAIT_V(6); PG8_BAR; PG8_MMA(1, 1, At, B1); PG8_BAR;
            PG8_LDB(B0, 1, 0); PG8_SCHED; PG8_LDA(At, 1, 0); PG8_STAGE(PG8_SA(0, 1), a2 + hA, voffA);
            PG8_WAIT_L(8); PG8_BAR; PG8_WAIT_L(0); PG8_MMA(0, 0, At, B0); PG8_BAR; PG8_SCHED;
            PG8_LDB(B1, 1, 1); PG8_STAGE(PG8_SB(1, 0), b3, voffB);
            PG8_BAR; PG8_WAIT_L(0); PG8_MMA(0, 1, At, B1); PG8_BAR;
            PG8_LDA(At, 1, 1); PG8_STAGE(PG8_SA(1, 0), a3, voffA);
            PG8_BAR; PG8_WAIT_L(0); PG8_MMA(1, 0, At, B0); PG8_BAR; PG8_SCHED;
            PG8_STAGE(PG8_SB(1, 1), b3 + hB, voffB);
            PG8_WAIT_V(6); PG8_BAR; PG8_MMA(1, 1, At, B1); PG8_BAR;
            }
        }
        if constexpr (ALIGN_EPI) { if (wr == 0) PG8_BAR; }
        if constexpr (FP8) asm volatile("s_nop 15\n\ts_nop 15" ::: "memory");
        E(acc, cur, wr, wc, fr, fq); S.done(cur);
        if (!has_next) break;
        if constexpr (!Epi::CARRY) {
#pragma unroll
        for (int a = 0; a < 2; ++a)
#pragma unroll
            for (int b = 0; b < 2; ++b)
#pragma unroll
                for (int m = 0; m < 4; ++m)
#pragma unroll
                    for (int n = 0; n < 2; ++n) acc[a][b][m][n] = (f32x4){0.f, 0.f, 0.f, 0.f};
        }
        cur = nxt; cA = nA; cB = nB; ++ui;
        if constexpr (ALIGN_EPI) { if (wr == 1) PG8_BAR; }
    }
    PG8_WAIT_V(0);
    if constexpr (!ALIGN_EPI) { if (wr == 0) PG8_BAR; }
    PG8_BAR;
#undef PG8_SA
#undef PG8_SB
#undef PG8_STAGE
#undef PG8_LDA
#undef PG8_LDB
#undef PG8_MMA
#undef PG8_WAIT_V
#undef PG8_WAIT_L
#undef PG8_BAR
#undef PG8_SCHED
}

__device__ __forceinline__ u32x4 pack8(const f32x4 a, const f32x4 b) { u32x4 w; w.x = cvt_pk_bf16(a[0], a[1]); w.y = cvt_pk_bf16(a[2], a[3]); w.z = cvt_pk_bf16(b[0], b[1]); w.w = cvt_pk_bf16(b[2], b[3]); return w; }

struct EpiSwiGLU {
    static constexpr bool PERM = true, CARRY = false, FP8 = false;
    bf16* O; int ldo;
    __device__ __forceinline__ void operator()(const f32x4 (&acc)[2][2][4][2], const Unit& u, int wr, int wc, int fr, int fq) const {
        const int row0 = u.pm * BM + wr * 64 + fr, col0 = u.pn * 128 + wc * 32 + 8 * fq;
#pragma unroll
        for (int ai = 0; ai < 2; ++ai)
#pragma unroll
            for (int m = 0; m < 4; ++m) {
                f32x4 v0, v1;
#pragma unroll
                for (int e = 0; e < 4; ++e) { v0[e] = silu_f(acc[ai][0][m][0][e]) * acc[ai][1][m][0][e]; v1[e] = silu_f(acc[ai][0][m][1][e]) * acc[ai][1][m][1][e]; }
                *(u32x4*)(O + (size_t)(row0 + ai * HALF + m * 16) * ldo + col0) = pack8(v0, v1);
            }
    }
};
struct EpiY {
    static constexpr bool PERM = true, CARRY = false, FP8 = false;
    bf16* Y; const float* modl; int gi; float cg;
    __device__ __forceinline__ void operator()(const f32x4 (&acc)[2][2][4][2], const Unit& u, int wr, int wc, int fr, int fq) const {
        const int row0 = u.pm * BM + wr * 64 + fr, col0 = u.pn * BM + wc * 32 + 8 * fq;
        const int s = u.pm < 32 ? 0 : (u.pm < 64 ? 1 : 2);
        const float* gate = modl + (size_t)(s * NMOD + gi) * D;
        f32x4 gv[2][2];
#pragma unroll
        for (int bj = 0; bj < 2; ++bj)
#pragma unroll
            for (int n = 0; n < 2; ++n) gv[bj][n] = *(const f32x4*)(gate + col0 + bj * HALF + 4 * n) * cg;
#pragma unroll
        for (int ai = 0; ai < 2; ++ai)
#pragma unroll
            for (int m = 0; m < 4; ++m) { bf16* rowp = Y + (size_t)(row0 + ai * HALF + m * 16) * D + col0;
#pragma unroll
                for (int bj = 0; bj < 2; ++bj) *(u32x4*)(rowp + bj * HALF) = pack8(gv[bj][0] * acc[ai][bj][m][0], gv[bj][1] * acc[ai][bj][m][1]); }
    }
};
template <bool FP8_> struct EpiIn {
    static constexpr bool PERM = true, CARRY = false, FP8 = FP8_;
    unsigned char* ws; const float* rope; int pn0; float ascale;
    __device__ __forceinline__ void operator()(const f32x4 (&acc)[2][2][4][2], const Unit& u0, int wr, int wc, int fr, int fq) const {
        Unit u; u.pm = u0.pm; u.pn = u0.pn + pn0;
        const int row0 = u.pm * BM + wr * 64 + fr;
        if (u.pn < 16) {
            const bool isq = u.pn < 8; const int head = 2 * (u.pn & 7) + (wc >> 1), rr = wc & 1, i0 = 8 * fq;
            const int colb = head * HD + rr * 64 + i0;
            const bool lat = u.pm < 64;
#pragma unroll
            for (int ai = 0; ai < 2; ++ai)
#pragma unroll
                for (int m = 0; m < 4; ++m) {
                    const int row = row0 + ai * HALF + m * 16;
                    const f32x4 a0 = acc[ai][0][m][0], a1 = acc[ai][0][m][1], b0 = acc[ai][1][m][0], b1 = acc[ai][1][m][1];
                    if (isq || !lat) { bf16* dst = (bf16*)(ws + (isq ? WS_QP : WS_KB)) + (size_t)row * AW + colb; *(u32x4*)dst = pack8(a0, a1); *(u32x4*)(dst + 32) = pack8(b0, b1); }
                    if (lat) {
                        const int t = row & (SEQ - 1), pos = rr ? (t & 63) : (t >> 6);
                        const float* cp = rope + pos * 32 + i0; const float* sp = cp + 128 * 32;
                        const f32x4 c0 = *(const f32x4*)cp, c1 = *(const f32x4*)(cp + 4), s0 = *(const f32x4*)sp, s1 = *(const f32x4*)(sp + 4);
                        const f32x4 o0 = a0 * c0 - b0 * s0, o1 = a1 * c1 - b1 * s1, p0 = a0 * s0 + b0 * c0, p1 = a1 * s1 + b1 * c1;
                        bf16* dst = (bf16*)(ws + (isq ? WS_QR : WS_KB)) + (size_t)row * AW + colb; *(u32x4*)dst = pack8(o0, o1); *(u32x4*)(dst + 32) = pack8(p0, p1);
                    }
                }
            return;
        }
        size_t boff; int ld, colt, act;
        if (u.pn < 24) { boff = WS_VB; ld = AW; colt = (u.pn - 16) * BM; act = 0; }
        else if (u.pn < 32) { boff = WS_ZB; ld = 2048; colt = (u.pn - 24) * BM; act = 1; }
        else if (u.pn < 36) { boff = WS_US; ld = SSW; colt = (u.pn - 32) * BM; act = 0; }
        else { boff = WS_GB; ld = 3 * D; colt = (u.pn - 36) * BM; act = 2; }
        bf16* base = (bf16*)(ws + boff);
        const int col0 = colt + wc * 32 + 8 * fq;
#pragma unroll
        for (int ai = 0; ai < 2; ++ai)
#pragma unroll
            for (int m = 0; m < 4; ++m) { bf16* rowp = base + (size_t)(row0 + ai * HALF + m * 16) * ld + col0;
#pragma unroll
                for (int bj = 0; bj < 2; ++bj) { f32x4 v0 = acc[ai][bj][m][0], v1 = acc[ai][bj][m][1];
                    if (act == 1) {
#pragma unroll
                        for (int e = 0; e < 4; ++e) { v0[e] = gelu_tanh_f(v0[e]); v1[e] = gelu_tanh_f(v1[e]); } }
                    else if (act == 2) {
#pragma unroll
                        for (int e = 0; e < 4; ++e) { v0[e] = fast_sigmoid(v0[e] * ascale); v1[e] = fast_sigmoid(v1[e] * ascale); } }
                    *(u32x4*)(rowp + bj * HALF) = pack8(v0, v1); } }
    }
};
__device__ __forceinline__ void unpack8(const u32x4 w, f32x4& a, f32x4& b) { a = (f32x4){bf_lo(w.x), bf_hi(w.x), bf_lo(w.y), bf_hi(w.y)}; b = (f32x4){bf_lo(w.z), bf_hi(w.z), bf_lo(w.w), bf_hi(w.w)}; }
struct EpiGLU {
    static constexpr bool PERM = true, CARRY = false, FP8 = false;
    const bf16* YS; bf16* O; const float* bias;
    __device__ __forceinline__ void operator()(const f32x4 (&acc)[2][2][4][2], const Unit& u, int wr, int wc, int fr, int fq) const {
        const int row0 = u.pm * BM + wr * 64 + fr, col0 = u.pn * BM + wc * 32 + 8 * fq;
        const f32x4 bv[2][2] = {{*(const f32x4*)(bias + col0), *(const f32x4*)(bias + col0 + 4)}, {*(const f32x4*)(bias + col0 + HALF), *(const f32x4*)(bias + col0 + HALF + 4)}};
        constexpr int PD = 7;
        u32x4 yr[PD + 1];
#define EG_ROW(s_) ((size_t)(row0 + ((s_) >> 3) * HALF + (((s_) >> 1) & 3) * 16))
#define EG_LOAD(s_) yr[(s_) % (PD + 1)] = *(const u32x4*)(YS + EG_ROW(s_) * SSW + col0 + ((s_) & 1) * HALF)
#pragma unroll
        for (int s = 0; s < PD; ++s) EG_LOAD(s);
#pragma unroll
        for (int s = 0; s < 16; ++s) {
            if (s + PD < 16) EG_LOAD(s + PD);
            const int ai = s >> 3, m = (s >> 1) & 3, bj = s & 1;
            f32x4 y0, y1; unpack8(yr[s % (PD + 1)], y0, y1);
            f32x4 v0 = acc[ai][bj][m][0] + bv[bj][0], v1 = acc[ai][bj][m][1] + bv[bj][1];
#pragma unroll
            for (int e = 0; e < 4; ++e) { v0[e] = y0[e] * fast_sigmoid(v0[e]); v1[e] = y1[e] * fast_sigmoid(v1[e]); }
            *(u32x4*)(O + EG_ROW(s) * D + col0 + bj * HALF) = pack8(v0, v1);
            asm volatile("" ::: "memory");
        }
#undef EG_LOAD
#undef EG_ROW
    }
};
#ifndef MERGE_PD
#define MERGE_PD 3
#endif
struct EpiMerge1 {
    static constexpr bool PERM = true, CARRY = true, FP8 = false;
    const bf16* GB; bf16* MG;
    __device__ __forceinline__ void operator()(f32x4 (&acc)[2][2][4][2], const Unit& u, int wr, int wc, int fr, int fq) const {
        const int row0 = u.pm * BM + wr * 64 + fr, col0 = u.pn * BM + wc * 32 + 8 * fq;
        const bool fin = u.seg == 2;
        const int noff = u.seg * D;
        const float keep = fin ? 0.f : 1.f;
        constexpr int PD = MERGE_PD;
        u32x4 nwr[PD + 1], dwr[PD + 1];
#define EM_ROW(s_) ((size_t)(row0 + ((s_) >> 3) * HALF + (((s_) >> 1) & 3) * 16))
#define EM_LOAD(s_) do { const bf16* gp_ = GB + EM_ROW(s_) * (3 * D) + noff + col0 + ((s_) & 1) * HALF; nwr[(s_) % (PD + 1)] = *(const u32x4*)gp_; dwr[(s_) % (PD + 1)] = *(const u32x4*)(gp_ + (fin ? 0 : D)); } while (0)
#pragma unroll
        for (int s = 0; s < PD; ++s) EM_LOAD(s);
#pragma unroll
        for (int s = 0; s < 16; ++s) {
            if (s + PD < 16) EM_LOAD(s + PD);
            const int ai = s >> 3, m = (s >> 1) & 3, bj = s & 1;
            f32x4 n0, n1, d0, d1; unpack8(nwr[s % (PD + 1)], n0, n1); unpack8(dwr[s % (PD + 1)], d0, d1);
            f32x4 r0, r1;
#pragma unroll
            for (int e = 0; e < 4; ++e) { const float q0 = __builtin_amdgcn_rcpf(fmaxf(d0[e], 1e-30f)), q1 = __builtin_amdgcn_rcpf(fmaxf(d1[e], 1e-30f));
                r0[e] = fmaxf(n0[e], 1e-30f) * (fin ? 1.0f : q0); r1[e] = fmaxf(n1[e], 1e-30f) * (fin ? 1.0f : q1); }
            const f32x4 v0 = acc[ai][bj][m][0] * r0, v1 = acc[ai][bj][m][1] * r1;
            if (fin) *(u32x4*)(MG + EM_ROW(s) * D + col0 + bj * HALF) = pack8(v0, v1);
            acc[ai][bj][m][0] = v0 * keep; acc[ai][bj][m][1] = v1 * keep;
            asm volatile("" : "+v"(acc[ai][bj][m][0]), "+v"(acc[ai][bj][m][1]) :: "memory");
        }
#undef EM_LOAD
#undef EM_ROW
    }
};
}
using pg8::unpack8; using pg8::pack8;

#define XB_TMO      128
#define XB_XCNT(j)  (256  + 64 * (j))
#define XB_XSUB(j)  (1280 + 64 * (j))
#define XB_XGEN(j)  (2304 + 64 * (j))
#define XB_TOP      3328
#define XB_TOPGEN   3392
#define XCD_BAR_WORDS 3456
#define XB_SPIN_CAP (1u << 18)
__device__ __forceinline__ unsigned xb_ld(unsigned* p)              { return __hip_atomic_load(p, __ATOMIC_RELAXED, __HIP_MEMORY_SCOPE_AGENT); }
__device__ __forceinline__ unsigned xb_add(unsigned* p, unsigned v) { return __hip_atomic_fetch_add(p, v, __ATOMIC_RELAXED, __HIP_MEMORY_SCOPE_AGENT); }
__device__ __forceinline__ unsigned xb_xcc_id() { return (unsigned)__builtin_amdgcn_s_getreg((3 << 11) | 20) & 0xFu; }
#define XB_SPIN(cond, bar) do { unsigned _sp = 0; while (cond) { __builtin_amdgcn_s_sleep(1); \
    if ((++_sp & 255u) == 0u) { if (xb_ld(&(bar)[XB_TMO])) break; if (_sp > XB_SPIN_CAP) { atomicAdd(&(bar)[XB_TMO], 1u); break; } } } } while (0)
struct XcdBarrier { unsigned* bar; unsigned x; volatile LAS unsigned* st; };
__device__ __forceinline__ XcdBarrier xcd_barrier_post(unsigned* bar, volatile LAS unsigned* st) {
    XcdBarrier b; b.bar = bar; b.x = xb_xcc_id(); b.st = st;
    if (threadIdx.x == 0) (void)xb_add(&bar[XB_XCNT(b.x)], 1u);
    return b;
}
__device__ __forceinline__ void xcd_barrier_complete(unsigned* bar, unsigned x, unsigned& nloc, unsigned& nx) {
    const unsigned G = gridDim.x * gridDim.y * gridDim.z;
    unsigned sum, cnt, mine, sp = 0u;
    for (;;) {
        sum = 0u; cnt = 0u; mine = 0u;
#pragma unroll
        for (unsigned j = 0; j < 16; ++j) { const unsigned c = xb_ld(&bar[XB_XCNT(j)]); sum += c; cnt += (c > 0u) ? 1u : 0u; mine = (j == x) ? c : mine; }
        if (sum == G) break;
        __builtin_amdgcn_s_sleep(1);
        if ((++sp & 255u) == 0u) { if (xb_ld(&bar[XB_TMO])) break; if (sp > XB_SPIN_CAP) { atomicAdd(&bar[XB_TMO], 1u); break; } }
    }
    nloc = mine > 0u ? mine : 1u; nx = cnt > 0u ? cnt : 1u;
}
__device__ __forceinline__ void xcd_barrier(const XcdBarrier& b) {
    asm volatile("s_waitcnt vmcnt(0)" ::: "memory");
    __syncthreads();
    if (threadIdx.x == 0) {
        unsigned* bar = b.bar;
        __builtin_amdgcn_s_waitcnt(0);
        unsigned nloc = b.st[0], nx = b.st[1];
        if (nloc == 0u) { xcd_barrier_complete(bar, b.x, nloc, nx); b.st[0] = nloc; b.st[1] = nx; }
        const unsigned old = xb_add(&bar[XB_XSUB(b.x)], 1u);
        const unsigned gen = old / nloc;
        if (old + 1u == (gen + 1u) * nloc) {
            __builtin_amdgcn_fence(__ATOMIC_RELEASE, "agent");
            asm volatile("s_waitcnt vmcnt(0)" ::: "memory");
            const unsigned og = xb_add(&bar[XB_TOP], 1u);
            const unsigned tg = og / nx;
            if (og + 1u == (tg + 1u) * nx) xb_add(&bar[XB_TOPGEN], 1u);
            else XB_SPIN(xb_ld(&bar[XB_TOPGEN]) == tg, bar);
            __builtin_amdgcn_fence(__ATOMIC_ACQUIRE, "agent");
            xb_add(&bar[XB_XGEN(b.x)], 1u);
            asm volatile("s_waitcnt vmcnt(0)" ::: "memory");
        } else {
            XB_SPIN(xb_ld(&bar[XB_XGEN(b.x)]) == gen, bar);
            __builtin_amdgcn_fence(__ATOMIC_ACQUIRE, "agent");
            asm volatile("s_waitcnt vmcnt(0)" ::: "memory");
        }
    }
    __syncthreads();
}

__device__ __forceinline__ float wave_sum(float v) {
#pragma unroll
    for (int o = 1; o < 64; o <<= 1) v += __shfl_xor(v, o);
    return v;
}
#define MFMA32(a, b, c) __builtin_amdgcn_mfma_f32_32x32x16_bf16((a), (b), (c), 0, 0, 0)
#define MFMA16(a, b, c) __builtin_amdgcn_mfma_f32_16x16x32_bf16((a), (b), (c), 0, 0, 0)
#define PACK_STEP(dst, x, s) do { u32x4 _p; asm volatile("v_cvt_pk_bf16_f32 %0, %4, %5\n\tv_cvt_pk_bf16_f32 %1, %6, %7\n\tv_cvt_pk_bf16_f32 %2, %8, %9\n\tv_cvt_pk_bf16_f32 %3, %10, %11\n\ts_nop 1" \
        : "=&v"(_p[0]), "=&v"(_p[1]), "=&v"(_p[2]), "=&v"(_p[3]) \
        : "v"(x[8 * (s)]), "v"(x[8 * (s) + 1]), "v"(x[8 * (s) + 2]), "v"(x[8 * (s) + 3]), "v"(x[8 * (s) + 4]), "v"(x[8 * (s) + 5]), "v"(x[8 * (s) + 6]), "v"(x[8 * (s) + 7])); \
        dst = __builtin_bit_cast(bf16x8, _p); } while (0)
template <int OFF_LO, int OFF_HI> __device__ __forceinline__ bf16x8 tr_read2(unsigned base) {
    s16x4 lo, hi;
    asm volatile("ds_read_b64_tr_b16 %0, %2 offset:%3\n\tds_read_b64_tr_b16 %1, %2 offset:%4\n\ts_waitcnt lgkmcnt(0)" : "=&v"(lo), "=&v"(hi) : "v"(base), "i"(OFF_LO), "i"(OFF_HI) : "memory");
    return __builtin_shufflevector(lo, hi, 0, 1, 2, 3, 4, 5, 6, 7);
}
__device__ __forceinline__ unsigned lds_addr(LAS unsigned char* p) { return (unsigned)(__UINTPTR_TYPE__)p; }

__device__ __forceinline__ void transpose_item(const float* W, int N, bf16* WT, int ldt, int k0, int src_n0, int dst_n0, LAS float* scr, int lane) {
#pragma unroll
    for (int i = 0; i < 32; ++i) { const int kk = 2 * i + (lane >> 5); scr[kk * 33 + (lane & 31)] = __builtin_nontemporal_load(W + (size_t)(k0 + kk) * N + src_n0 + (lane & 31)); }
    LDS_WAIT();
    const int c = lane & 7;
#pragma unroll
    for (int j = 0; j < 4; ++j) { const int n = (lane >> 3) + 8 * j; const LAS float* s = scr + (8 * c) * 33 + n;
        u32x4 o; o.x = cvt_pk_bf16(s[0 * 33], s[1 * 33]); o.y = cvt_pk_bf16(s[2 * 33], s[3 * 33]); o.z = cvt_pk_bf16(s[4 * 33], s[5 * 33]); o.w = cvt_pk_bf16(s[6 * 33], s[7 * 33]);
        *(u32x4*)(WT + (size_t)(dst_n0 + n) * ldt + k0 + 8 * c) = o; }
    LDS_WAIT();
}
__device__ __forceinline__ void transpose_item_fp8(const float* W, int N, unsigned char* WT8, int ldt, int k0, int src_n0, int dst_n0, LAS float* scr, int lane) {
#pragma unroll
    for (int i = 0; i < 32; ++i) { const int kk = 2 * i + (lane >> 5); scr[kk * 33 + (lane & 31)] = __builtin_nontemporal_load(W + (size_t)(k0 + kk) * N + src_n0 + (lane & 31)); }
    LDS_WAIT();
    const int c = lane & 7;
#pragma unroll
    for (int j = 0; j < 4; ++j) { const int n = (lane >> 3) + 8 * j; const LAS float* s = scr + (8 * c) * 33 + n;
        float e[8];
#pragma unroll
        for (int q = 0; q < 8; ++q) e[q] = fminf(fmaxf(s[q * 33] * 2048.f, -448.f), 448.f);
        int w0 = __builtin_amdgcn_cvt_pk_fp8_f32(e[0], e[1], 0, false); w0 = __builtin_amdgcn_cvt_pk_fp8_f32(e[2], e[3], w0, true);
        int w1 = __builtin_amdgcn_cvt_pk_fp8_f32(e[4], e[5], 0, false); w1 = __builtin_amdgcn_cvt_pk_fp8_f32(e[6], e[7], w1, true);
        *(u32x2*)(WT8 + (size_t)(dst_n0 + n) * ldt + k0 + 8 * c) = (u32x2){(unsigned)w0, (unsigned)w1}; }
    LDS_WAIT();
}
__device__ __forceinline__ int src_block(int mode, int nb) {
    if (mode == 1) { const int pn = nb >> 3, wb = nb & 7, bj = wb >> 2, jb = wb & 3; return bj * 192 + 4 * pn + jb; }
    if (mode == 2 && nb < 128) { const int tile = nb >> 3, wb = nb & 7, bj = wb >> 2, hh = (wb & 3) >> 1, rr = wb & 1; const int base = tile < 8 ? 0 : AW, head = 2 * (tile & 7) + hh; return (base + head * HD + rr * 64 + 32 * bj) >> 5; }
    return nb;
}
__device__ __forceinline__ void transpose_matrix_items(const float* W, int K, int N, bf16* WT, int ldt, int mode, int it, LAS float* scr, int lane, unsigned char* WT8 = nullptr) {
    const int nblk = N / 32, kb = it / nblk, nb = it % nblk;
    if (mode == 2 && nb >= 288) { transpose_item_fp8(W, N, WT8, K, 64 * kb, 32 * nb, 32 * (nb - 288), scr, lane); return; }
    transpose_item(W, N, WT, ldt, 64 * kb, 32 * src_block(mode, nb), 32 * nb, scr, lane);
}

struct Args { const float* in[32]; float* out; unsigned char* ws; int ph_lo, ph_hi; };

__device__ __forceinline__ void p0_tables(const Args& args, int gtid, int gthreads) {
    unsigned char* ws = args.ws;
    float* rope = (float*)(ws + WS_ROPE);
    for (int i = gtid; i < 128 * 32; i += gthreads) { const int pos = i >> 5, j = i & 31; const float inv = exp2f(-(float)j * (13.287712379549449f / 32.0f)); const float ang = (float)pos * inv; rope[i] = cosf(ang); rope[128 * 32 + i] = sinf(ang); }
    const float *lam_re = as_global(args.in[18]), *lam_im = as_global(args.in[19]), *log_dt = as_global(args.in[20]), *b_re = as_global(args.in[21]), *b_im = as_global(args.in[22]), *c_re = as_global(args.in[23]), *c_im = as_global(args.in[24]);
    f32x4* SA = (f32x4*)(ws + WS_SA); bf16* SBB = (bf16*)(ws + WS_SBB); bf16* SC = (bf16*)(ws + WS_SC);
    for (int i = gtid; i < DEPTH * 2 * NG * NP; i += gthreads) {
        const int p = i & 63, ldg = i >> 6;
        const float dt = expf(log_dt[ldg]), lr = lam_re[i], li = lam_im[i];
        const float x = lr * dt, y = li * dt, mag = expf(x), cs = cosf(y), sn = sinf(y), sh = sinf(0.5f * y);
        const float ar = mag * cs, ai = mag * sn, re1 = expm1f(x) * cs - 2.0f * sh * sh, den = lr * lr + li * li;
        const float fr = (re1 * lr + ai * li) / den, fi = (ai * lr - re1 * li) / den;
        float tr = ar, ti = ai;
#pragma unroll
        for (int q = 0; q < 7; ++q) { const float nr = tr * tr - ti * ti, ni = 2.0f * tr * ti; tr = nr; ti = ni; }
        SA[i] = (f32x4){ar, ai, tr, ti};
        { bf16* o_re = SBB + ((size_t)ldg * 128 + p) * SG; bf16* o_im = o_re + 64 * SG;
#pragma unroll
          for (int ch = 0; ch < SG; ch += 2) { const float br0 = b_re[(size_t)i * SG + ch], bi0 = b_im[(size_t)i * SG + ch], br1 = b_re[(size_t)i * SG + ch + 1], bi1 = b_im[(size_t)i * SG + ch + 1];
              *(unsigned*)(o_re + ch) = cvt_pk_bf16(fr * br0 - fi * bi0, fr * br1 - fi * bi1); *(unsigned*)(o_im + ch) = cvt_pk_bf16(fr * bi0 + fi * br0, fr * bi1 + fi * br1); } }
#pragma unroll
        for (int ch = 0; ch < SG; ++ch) { const size_t ci = ((size_t)ldg * SG + ch) * NP + p; const size_t o = ((size_t)ldg * SG + ch) * 128;
            SC[o + p] = (bf16)(cvt_pk_bf16(c_re[ci], 0.f) & 0xffffu); SC[o + 64 + p] = (bf16)(cvt_pk_bf16(-c_im[ci], 0.f) & 0xffffu); }
    }
    const float* gws = as_global(args.in[16]); bf16* GWS = (bf16*)(ws + WS_GWS);
    for (int i = gtid; i < DEPTH * 8 * 128 * 128 / 2; i += gthreads) ((unsigned*)GWS)[i] = cvt_pk_bf16(gws[2 * i], gws[2 * i + 1]);
}

__device__ __forceinline__ void p0_mod(const Args& args, LAS unsigned char* lds, int wid, int lane, int tid, int G, int bx) {
    LAS float* sv = (LAS float*)lds;
    LAS float* red = (LAS float*)(lds + 49152);
    const float *c = as_global(args.in[1]), *cctx = as_global(args.in[3]);
    for (int i = tid; i < 3 * D; i += 512) { const float v = i < 2 * D ? c[i] : cctx[i - 2 * D]; sv[i] = silu_f(v); }
    __syncthreads();
    float* modv = (float*)(args.ws + WS_MOD);
    constexpr int NCB = NMODC / 256;
    for (int u = bx; u < DEPTH * NCB; u += G) {
        const int l = u / NCB, cb = u % NCB;
        const float* W = as_global(args.in[4]) + (size_t)l * D * NMODC + (size_t)cb * 256 + 4 * lane;
        f32x4 a0 = {0.f, 0.f, 0.f, 0.f}, a1 = a0, a2 = a0;
        const int kbeg = wid * 512;
        for (int k = kbeg; k < kbeg + 512; k += 8) {
            f32x4 w[8];
#pragma unroll
            for (int i = 0; i < 8; ++i) w[i] = __builtin_nontemporal_load((const f32x4*)(W + (size_t)(k + i) * NMODC));
#pragma unroll
            for (int i = 0; i < 8; ++i) { a0 += w[i] * sv[k + i]; a1 += w[i] * sv[D + k + i]; a2 += w[i] * sv[2 * D + k + i]; }
        }
        *(LAS f32x4*)(red + (wid * 3 + 0) * 256 + 4 * lane) = a0; *(LAS f32x4*)(red + (wid * 3 + 1) * 256 + 4 * lane) = a1; *(LAS f32x4*)(red + (wid * 3 + 2) * 256 + 4 * lane) = a2;
        __syncthreads();
        for (int o = tid; o < 768; o += 512) { const int s = o >> 8, cc = o & 255; float sum = 0.f;
#pragma unroll
            for (int w8 = 0; w8 < 8; ++w8) sum += red[(w8 * 3 + s) * 256 + cc];
            modv[(size_t)(l * 3 + s) * NMODC + cb * 256 + cc] = sum + as_global(args.in[5])[(size_t)l * NMODC + cb * 256 + cc]; }
        __syncthreads();
    }
}

__device__ __forceinline__ void p0_item_finish(const f32x4 (&rg)[16], unsigned char* dst, int ldt, bool f8, LAS float* scr, int lane) {
#pragma unroll
    for (int i = 0; i < 16; ++i) { const int kk = 8 * i + (lane >> 3), ch = lane & 7; *(LAS f32x4*)(scr + kk * 32 + ((ch ^ (i & 7)) << 2)) = rg[i]; }
    LDS_WAIT();
    const int c = lane & 15;
#pragma unroll
    for (int j = 0; j < 8; ++j) { const int n = (lane >> 4) + 4 * j; const LAS float* s = scr + (8 * c) * 32 + ((((n >> 2) ^ (c & 7))) << 2) + (n & 3);
        float e[8];
#pragma unroll
        for (int q = 0; q < 8; ++q) e[q] = s[q * 32];
        if (f8) {
#pragma unroll
            for (int q = 0; q < 8; ++q) e[q] = fminf(fmaxf(e[q] * 2048.f, -448.f), 448.f);
            int w0 = __builtin_amdgcn_cvt_pk_fp8_f32(e[0], e[1], 0, false); w0 = __builtin_amdgcn_cvt_pk_fp8_f32(e[2], e[3], w0, true);
            int w1 = __builtin_amdgcn_cvt_pk_fp8_f32(e[4], e[5], 0, false); w1 = __builtin_amdgcn_cvt_pk_fp8_f32(e[6], e[7], w1, true);
            __builtin_nontemporal_store((u32x2){(unsigned)w0, (unsigned)w1}, (u32x2*)(dst + (size_t)n * ldt + 8 * c));
        } else {
            u32x4 o; o.x = cvt_pk_bf16(e[0], e[1]); o.y = cvt_pk_bf16(e[2], e[3]); o.z = cvt_pk_bf16(e[4], e[5]); o.w = cvt_pk_bf16(e[6], e[7]);
            __builtin_nontemporal_store(o, (u32x4*)(dst + ((size_t)n * ldt + 8 * c) * 2)); } }
    LDS_WAIT();
}
__device__ __forceinline__ void p0_weights(const Args& args, LAS unsigned char* lds, int wid, int lane, int G, int bx) {
    LAS float* scr = (LAS float*)(lds + wid * 16384);
    const int gw = bx * 8 + wid, NGW = G * 8;
    constexpr int I_FI = (D / 128) * (2 * DFF / 32), I_FO = (DFF / 128) * (D / 32), I_IN = (D / 128) * (NIN / 32), I_GL = (SSW / 128) * (SSW / 32), I_PA = (GMW / 128) * (D / 32), I_PB = (AW / 128) * (D / 32), I_PC = (SSW / 128) * (D / 32), I_O = (D / 128) * (D / 32);
    constexpr int PER_L = 2 * I_FI + 2 * I_FO + I_IN + I_GL + I_PA + I_PB + I_PC + I_O;
    constexpr int TOTAL = DEPTH * PER_L, MODU = (D * 256 * 4) / (24 * 1024) / 8;
    const int nheavy = (DEPTH * (NMODC / 256) > G && DEPTH * (NMODC / 256) < 2 * G) ? DEPTH * (NMODC / 256) - G : 0;
    const int X = nheavy > 0 && TOTAL > MODU * 8 * (G - nheavy) ? TOTAL - MODU * 8 * (G - nheavy) : TOTAL;
    const int c0 = gw < X ? (X - gw + NGW - 1) / NGW : 0;
    const int st1 = (G - nheavy) * 8, i1 = X + (bx - nheavy) * 8 + wid;
    const int c1 = (bx >= nheavy && i1 < TOTAL) ? (TOTAL - i1 + st1 - 1) / st1 : 0;
    const int cnt = c0 + c1;
    if (cnt == 0) return;
#define P0_ITEM(k_) ((k_) < c0 ? gw + (k_) * NGW : i1 + ((k_) - c0) * st1)
#define P0_DECODE(it_, SRC, NN, DST, LDT, F8) do { const int l_ = (it_) / PER_L; int r_ = (it_) % PER_L; unsigned char* wl_ = args.ws + WS_W + (size_t)l_ * LW_BYTES; \
        const float* W_; int K_, N_, md_; unsigned char* T_; int lt_; \
        if (r_ < I_FI) { W_ = as_global(args.in[8]) + (size_t)l_ * D * 2 * DFF; K_ = D; N_ = 2 * DFF; T_ = wl_ + LW_W1IN; lt_ = D; md_ = 1; } \
        else if ((r_ -= I_FI) < I_FO) { W_ = as_global(args.in[9]) + (size_t)l_ * DFF * D; K_ = DFF; N_ = D; T_ = wl_ + LW_W1OUT; lt_ = DFF; md_ = 0; } \
        else if ((r_ -= I_FO) < I_FI) { W_ = as_global(args.in[10]) + (size_t)l_ * D * 2 * DFF; K_ = D; N_ = 2 * DFF; T_ = wl_ + LW_W2IN; lt_ = D; md_ = 1; } \
        else if ((r_ -= I_FI) < I_FO) { W_ = as_global(args.in[11]) + (size_t)l_ * DFF * D; K_ = DFF; N_ = D; T_ = wl_ + LW_W2OUT; lt_ = DFF; md_ = 0; } \
        else if ((r_ -= I_FO) < I_IN) { W_ = as_global(args.in[12]) + (size_t)l_ * D * NIN; K_ = D; N_ = NIN; T_ = wl_ + LW_WIN; lt_ = D; md_ = 2; } \
        else if ((r_ -= I_IN) < I_GL) { W_ = as_global(args.in[26]) + (size_t)l_ * SSW * SSW; K_ = SSW; N_ = SSW; T_ = wl_ + LW_WGLU; lt_ = SSW; md_ = 0; } \
        else if ((r_ -= I_GL) < I_PA) { W_ = as_global(args.in[28]) + (size_t)l_ * GMW * D; K_ = GMW; N_ = D; T_ = wl_ + LW_WCAT; lt_ = D; md_ = 0; } \
        else if ((r_ -= I_PA) < I_PB) { W_ = as_global(args.in[29]) + (size_t)l_ * AW * D; K_ = AW; N_ = D; T_ = wl_ + LW_WCAT + 2 * GMW; lt_ = D; md_ = 0; } \
        else if ((r_ -= I_PB) < I_PC) { W_ = as_global(args.in[30]) + (size_t)l_ * SSW * D; K_ = SSW; N_ = D; T_ = wl_ + LW_WCAT + 2 * (GMW + AW); lt_ = D; md_ = 0; } \
        else { r_ -= I_PC; W_ = as_global(args.in[31]) + (size_t)l_ * D * D; K_ = D; N_ = D; T_ = wl_ + LW_WO; lt_ = D; md_ = 0; } \
        const int nblk_ = N_ / 32, kb_ = r_ / nblk_, nb_ = r_ % nblk_; NN = N_; \
        if (md_ == 2 && nb_ >= 288) { F8 = true; SRC = W_ + (size_t)(128 * kb_) * N_ + 32 * nb_; DST = wl_ + LW_W8 + (size_t)(32 * (nb_ - 288)) * K_ + 128 * kb_; LDT = K_; }     \
        else { F8 = false; SRC = W_ + (size_t)(128 * kb_) * N_ + 32 * src_block(md_, nb_); DST = T_ + ((size_t)(32 * nb_) * lt_ + 128 * kb_) * 2; LDT = lt_; } } while (0)
#define P0_LOAD(RG, SRC, NN) do { _Pragma("unroll") for (int i = 0; i < 16; ++i) RG[i] = __builtin_nontemporal_load((const f32x4*)((SRC) + (size_t)(8 * i + (lane >> 3)) * (NN) + 4 * (lane & 7))); } while (0)
    f32x4 ra[16], rb[16];
    const float* srcA; const float* srcB; int nnA, nnB, ldA, ldB; unsigned char* dstA; unsigned char* dstB; bool f8A, f8B;
    P0_DECODE(P0_ITEM(0), srcA, nnA, dstA, ldA, f8A);
    P0_LOAD(ra, srcA, nnA);
#pragma unroll
    for (int i = 0; i < 16; ++i) asm volatile("" : "+v"(ra[i]));
    for (int k = 0; k < cnt; k += 2) {
        { const int kn = k + 1 < cnt ? k + 1 : k; P0_DECODE(P0_ITEM(kn), srcB, nnB, dstB, ldB, f8B); P0_LOAD(rb, srcB, nnB); }
        p0_item_finish(ra, dstA, ldA, f8A, scr, lane);
        if (k + 1 >= cnt) break;
        { const int kn = k + 2 < cnt ? k + 2 : k + 1; P0_DECODE(P0_ITEM(kn), srcA, nnA, dstA, ldA, f8A); P0_LOAD(ra, srcA, nnA); }
        p0_item_finish(rb, dstB, ldB, f8B, scr, lane);
    }
#undef P0_LOAD
#undef P0_DECODE
#undef P0_ITEM
}

__device__ __forceinline__ void thin_phase(int mode, const float* xin, const float* cin, float* X, const bf16* Y, const float* lng, const float* lnb, const float* modl, int sh_i, int sc_i, bf16* H, float* outp, int mrows, int gw, int NGW, int lane, LAS float* vl, int tid, unsigned char* H8 = nullptr, int row_lo = 0) {
    for (int i = tid; i < D / 4; i += 512) { const int c4 = 4 * i;
        if (mode != 0) { *(LAS f32x4*)(vl + c4) = *(const f32x4*)(lng + c4); *(LAS f32x4*)(vl + D + c4) = *(const f32x4*)(lnb + c4); }
        if (mode != 2) {
#pragma unroll
            for (int sx = 0; sx < 3; ++sx) { *(LAS f32x4*)(vl + (2 + sx) * D + c4) = *(const f32x4*)(modl + (size_t)(sx * NMOD + sh_i) * D + c4); *(LAS f32x4*)(vl + (5 + sx) * D + c4) = *(const f32x4*)(modl + (size_t)(sx * NMOD + sc_i) * D + c4) + 1.0f; } } }
    __syncthreads();
    if (row_lo + gw >= mrows) return;
    f32x4 v[16]; u32x2 y[16];
#define THIN_LOAD(dst, dsty, r) do { if (xin) { const float* src_ = (r) < ML ? xin + (size_t)(r) * D : cin + (size_t)((r) - ML) * D; \
        _Pragma("unroll") for (int j = 0; j < 16; ++j) dst[j] = __builtin_nontemporal_load((const f32x4*)(src_ + 256 * j + 4 * lane)); } \
        else { const unsigned* src_ = (const unsigned*)X + (size_t)(r) * (5 * D / 8); \
        _Pragma("unroll") for (int s_ = 0; s_ < 2; ++s_) { unsigned w_[20]; \
            _Pragma("unroll") for (int g = 0; g < 5; ++g) { const u32x4 t_ = __builtin_nontemporal_load((const u32x4*)(src_ + 256 * (5 * s_ + g) + 4 * lane)); w_[4 * g] = t_.x; w_[4 * g + 1] = t_.y; w_[4 * g + 2] = t_.z; w_[4 * g + 3] = t_.w; } \
            _Pragma("unroll") for (int p_ = 0; p_ < 4; ++p_) { const unsigned d0 = w_[5 * p_], d1 = w_[5 * p_ + 1], d2 = w_[5 * p_ + 2], d3 = w_[5 * p_ + 3], d4 = w_[5 * p_ + 4]; const int j0 = 8 * s_ + 2 * p_; \
                dst[j0][0] = __uint_as_float(d0 << 12); dst[j0][1] = __uint_as_float(__builtin_amdgcn_alignbit(d1, d0, 20) << 12); dst[j0][2] = __uint_as_float((d1 >> 8) << 12); dst[j0][3] = __uint_as_float(__builtin_amdgcn_alignbit(d2, d1, 28) << 12); \
                dst[j0 + 1][0] = __uint_as_float(__builtin_amdgcn_alignbit(d3, d2, 16) << 12); dst[j0 + 1][1] = __uint_as_float((d3 >> 4) << 12); dst[j0 + 1][2] = __uint_as_float(__builtin_amdgcn_alignbit(d4, d3, 24) << 12); dst[j0 + 1][3] = __uint_as_float(d4 & 0xfffff000u); } } } \
        if (mode != 0) { _Pragma("unroll") for (int j = 0; j < 16; ++j) dsty[j] = __builtin_nontemporal_load((const u32x2*)(Y + (size_t)(r) * D + 256 * j + 4 * lane)); } } while (0)
    for (int row = row_lo + gw; row < mrows; row += NGW) {
        THIN_LOAD(v, y, row);
        if (mode != 0) {
            float s = 0.f;
#pragma unroll
            for (int j = 0; j < 16; ++j) { v[j] = v[j] * ALPHA + (f32x4){bf_lo(y[j].x), bf_hi(y[j].x), bf_lo(y[j].y), bf_hi(y[j].y)}; s += (v[j][0] + v[j][1]) + (v[j][2] + v[j][3]); }
            const float mean = wave_sum(s) * (1.0f / D); float q = 0.f;
#pragma unroll
            for (int j = 0; j < 16; ++j) { v[j] = v[j] - mean; q += (v[j][0] * v[j][0] + v[j][1] * v[j][1]) + (v[j][2] * v[j][2] + v[j][3] * v[j][3]); }
            const float rstd = 1.0f / sqrtf(wave_sum(q) * (1.0f / D) + LN_EPS);
#pragma unroll
            for (int j = 0; j < 16; ++j) { const f32x4 g = *(const LAS f32x4*)(vl + 256 * j + 4 * lane), b = *(const LAS f32x4*)(vl + D + 256 * j + 4 * lane); v[j] = v[j] * rstd * g + b; }
            if (mode == 2) { float* dst = outp + (size_t)row * D;
#pragma unroll
                for (int j = 0; j < 16; ++j) __builtin_nontemporal_store(v[j], (f32x4*)(dst + 256 * j + 4 * lane)); }
            else { unsigned* dst = (unsigned*)X + (size_t)row * (5 * D / 8);
#pragma unroll
                for (int s_ = 0; s_ < 2; ++s_) { unsigned w_[20];
#pragma unroll
                    for (int p_ = 0; p_ < 4; ++p_) { const int j0 = 8 * s_ + 2 * p_; unsigned f[8];
#pragma unroll
                        for (int e = 0; e < 8; ++e) f[e] = (__float_as_uint(v[j0 + (e >> 2)][e & 3]) + 0x800u) >> 12;
                        w_[5 * p_] = f[0] | (f[1] << 20); w_[5 * p_ + 1] = (f[1] >> 12) | (f[2] << 8) | (f[3] << 28); w_[5 * p_ + 2] = (f[3] >> 4) | (f[4] << 16);
                        w_[5 * p_ + 3] = (f[4] >> 16) | (f[5] << 4) | (f[6] << 24); w_[5 * p_ + 4] = (f[6] >> 8) | (f[7] << 12); }
#pragma unroll
                    for (int g = 0; g < 5; ++g) { u32x4 t_; t_.x = w_[4 * g]; t_.y = w_[4 * g + 1]; t_.z = w_[4 * g + 2]; t_.w = w_[4 * g + 3]; __builtin_nontemporal_store(t_, (u32x4*)(dst + 256 * (5 * s_ + g) + 4 * lane)); } } }
        }
        if (mode != 2) {
            float s = 0.f;
#pragma unroll
            for (int j = 0; j < 16; ++j) s += (v[j][0] + v[j][1]) + (v[j][2] + v[j][3]);
            const float mean = wave_sum(s) * (1.0f / D); float q = 0.f;
#pragma unroll
            for (int j = 0; j < 16; ++j) { v[j] = v[j] - mean; q += (v[j][0] * v[j][0] + v[j][1] * v[j][1]) + (v[j][2] * v[j][2] + v[j][3] * v[j][3]); }
            const float rstd = 1.0f / sqrtf(wave_sum(q) * (1.0f / D) + LN_EPS);
            const int sidx = row < SEQ ? 0 : (row < ML ? 1 : 2);
            const LAS float* shp = vl + (2 + sidx) * D; const LAS float* scp = vl + (5 + sidx) * D;
#pragma unroll
            for (int j = 0; j < 16; ++j) { const f32x4 sh = *(const LAS f32x4*)(shp + 256 * j + 4 * lane), sc = *(const LAS f32x4*)(scp + 256 * j + 4 * lane);
                const f32x4 h = v[j] * rstd * sc + sh; u32x2 w; w.x = cvt_pk_bf16(h[0], h[1]); w.y = cvt_pk_bf16(h[2], h[3]);
                *(u32x2*)(H + (size_t)row * D + 256 * j + 4 * lane) = w;
                if (H8) { const f32x4 q = __builtin_elementwise_min(__builtin_elementwise_max(h * 8.f, (f32x4){-448.f, -448.f, -448.f, -448.f}), (f32x4){448.f, 448.f, 448.f, 448.f});
                    int w8 = __builtin_amdgcn_cvt_pk_fp8_f32(q[0], q[1], 0, false); w8 = __builtin_amdgcn_cvt_pk_fp8_f32(q[2], q[3], w8, true); *(unsigned*)(H8 + (size_t)row * D + 256 * j + 4 * lane) = (unsigned)w8; } }
        }
    }
#undef THIN_LOAD
}

constexpr int AT_KP = 272, AT_VP = 320, AT_VOFF = 64 * AT_KP, AT_BUF = AT_VOFF + 64 * AT_VP, AT_BOFF = 2 * AT_BUF + 256;
__device__ __forceinline__ int clampi(int v, int lo, int hi) { return v < lo ? lo : (v > hi ? hi : v); }
template <int OFF> __device__ __forceinline__ void tr_read_v4(unsigned base, bf16x8 (&f)[4]) {
    s16x4 l0, h0, l1, h1, l2, h2, l3, h3;
    asm volatile("ds_read_b64_tr_b16 %0, %8 offset:%9\n\tds_read_b64_tr_b16 %1, %8 offset:%10\n\tds_read_b64_tr_b16 %2, %8 offset:%11\n\tds_read_b64_tr_b16 %3, %8 offset:%12\n\t"
                 "ds_read_b64_tr_b16 %4, %8 offset:%13\n\tds_read_b64_tr_b16 %5, %8 offset:%14\n\tds_read_b64_tr_b16 %6, %8 offset:%15\n\tds_read_b64_tr_b16 %7, %8 offset:%16\n\ts_waitcnt lgkmcnt(0)"
                 : "=&v"(l0), "=&v"(h0), "=&v"(l1), "=&v"(h1), "=&v"(l2), "=&v"(h2), "=&v"(l3), "=&v"(h3)
                 : "v"(base), "i"(OFF), "i"(OFF + 8 * AT_VP), "i"(OFF + 64), "i"(OFF + 8 * AT_VP + 64), "i"(OFF + 128), "i"(OFF + 8 * AT_VP + 128), "i"(OFF + 192), "i"(OFF + 8 * AT_VP + 192) : "memory");
    f[0] = __builtin_shufflevector(l0, h0, 0, 1, 2, 3, 4, 5, 6, 7); f[1] = __builtin_shufflevector(l1, h1, 0, 1, 2, 3, 4, 5, 6, 7);
    f[2] = __builtin_shufflevector(l2, h2, 0, 1, 2, 3, 4, 5, 6, 7); f[3] = __builtin_shufflevector(l3, h3, 0, 1, 2, 3, 4, 5, 6, 7);
}
__device__ __forceinline__ void attn_unit(LAS unsigned char* lds, const bf16* QP, const bf16* QR, const bf16* KB, const bf16* VB, bf16* ACAT, const float* rpb_l, int b, int h, int r0, int tid, int wid, int lane) {
    const int hl = lane >> 5, l31 = lane & 31;
    const bool isctx = r0 < 0;
    const int r = isctx ? 0 : r0 + (wid >> 1), half = wid & 1;
    const int qrow = isctx ? ML + b * CTXL + 32 * wid + l31 : b * SEQ + r * 64 + 32 * half + l31;
    const int c = 32 * half + l31;
    int lo = 0, nloc = 0;
    if (!isctx) { lo = clampi(r0 - 4, 0, 120); nloc = clampi(r0 - 1, 0, 120) + 7 - lo + 1; }
    const int nt = nloc + 4, rs = clampi(r - 4, 0, 120);
    LAS float* bias = (LAS float*)(lds + AT_BOFF);
    const int skey = tid >> 3, spart = tid & 7;
    u32x4 kreg0, kreg1, vreg0, vreg1;
#define AT_GLOAD(it_) do { const int t_ = (it_); const size_t off = (size_t)((t_ < nloc ? b * SEQ + (lo + t_) * 64 : ML + b * CTXL + 64 * (t_ - nloc)) + skey) * AW + h * HD + 16 * spart; \
        kreg0 = *(const u32x4*)(KB + off); kreg1 = *(const u32x4*)(KB + off + 8); vreg0 = *(const u32x4*)(VB + off); vreg1 = *(const u32x4*)(VB + off + 8); } while (0)
#define AT_LWRITE(buf_) do { LAS unsigned char* kb_ = lds + (buf_) * AT_BUF; *(LAS u32x4*)(kb_ + skey * AT_KP + 32 * spart) = kreg0; *(LAS u32x4*)(kb_ + skey * AT_KP + 32 * spart + 16) = kreg1; \
        *(LAS u32x4*)(kb_ + AT_VOFF + skey * AT_VP + 32 * spart) = vreg0; *(LAS u32x4*)(kb_ + AT_VOFF + skey * AT_VP + 32 * spart + 16) = vreg1; } while (0)
    AT_GLOAD(0);
    bf16x8 qf[8];
    { const bf16* p2 = (isctx ? QP : QR) + (size_t)qrow * AW + h * HD + 8 * hl;
#pragma unroll
      for (int s = 0; s < 8; ++s) qf[s] = *(const bf16x8*)(p2 + 16 * s); }
    const float bias_w = tid < 15 * 31 ? rpb_l[h * 465 + tid] * LOG2E : 0.f;
    __syncthreads();
    if (tid < 15 * 31) bias[tid] = bias_w;
    AT_LWRITE(0);
    AT_GLOAD(1);
    {
#pragma unroll
      for (int s = 0; s < 8; ++s) asm volatile("" : "+v"(qf[s])); }
    f32x16 O[4];
#pragma unroll
    for (int cc = 0; cc < 4; ++cc)
#pragma unroll
        for (int i = 0; i < 16; ++i) O[cc][i] = 0.f;
    float mrun = -1e30f, lrun = 0.f;
    const float SC = 0.08838834764831845f * LOG2E;
    const int blk = (lane >> 4) & 1, q4 = (lane & 15) >> 2, p4 = lane & 3;
    const unsigned vtr0 = lds_addr(lds + AT_VOFF) + (unsigned)((4 * hl + q4) * AT_VP + 32 * blk + 8 * p4);
    __syncthreads();
    for (int it = 0; it < nt; ++it) {
        const int cur = it & 1;
        if (it + 1 < nt) { AT_LWRITE(cur ^ 1); if (it + 2 < nt) AT_GLOAD(it + 2); }
        const bool local = it < nloc; const int kr = lo + it;
        if (!(local && (kr < rs || kr > rs + 7))) {
            LAS unsigned char* kimg = lds + cur * AT_BUF;
            f32x16 s0, s1;
#pragma unroll
            for (int i = 0; i < 16; ++i) { s0[i] = 0.f; s1[i] = 0.f; }
            if (it == nloc && !isctx) {
                const bf16* p = QP + (size_t)qrow * AW + h * HD + 8 * hl;
#pragma unroll
                for (int s = 0; s < 8; ++s) qf[s] = *(const bf16x8*)(p + 16 * s);
#pragma unroll
                for (int s = 0; s < 8; ++s) asm volatile("" : "+v"(qf[s]));
            }
#pragma unroll
            for (int s = 0; s < 8; ++s) { const bf16x8 a0 = *(const LAS bf16x8*)(kimg + l31 * AT_KP + 32 * s + 16 * hl), a1 = *(const LAS bf16x8*)(kimg + (32 + l31) * AT_KP + 32 * s + 16 * hl);
                s0 = MFMA32(a0, qf[s], s0); s1 = MFMA32(a1, qf[s], s1); }
            float tmax = -INFINITY;
            if (local) {
                int cv = c; asm volatile("" : "+v"(cv));
                const int e0 = 4 * hl - clampi(cv - 8, 0, 48);
                const LAS float* bl = bias + ((kr - r + 7) * 31 + 4 * hl - cv + 15);
#pragma unroll
                for (int i = 0; i < 16; ++i) { const int ki = (i & 3) + 8 * (i >> 2);
                    const float x0 = s0[i] * SC + bl[ki], x1 = s1[i] * SC + bl[ki + 32];
                    s0[i] = ((unsigned)(ki + e0) < 16u) ? x0 : -INFINITY; s1[i] = ((unsigned)(ki + 32 + e0) < 16u) ? x1 : -INFINITY;
                    tmax = fmaxf(tmax, fmaxf(s0[i], s1[i])); }
            } else {
#pragma unroll
                for (int i = 0; i < 16; ++i) { s0[i] *= SC; s1[i] *= SC; tmax = fmaxf(tmax, fmaxf(s0[i], s1[i])); }
            }
            tmax = fmaxf(tmax, __shfl_xor(tmax, 32));
            const float mnew = fmaxf(mrun, tmax), alpha = __builtin_amdgcn_exp2f(mrun - mnew); mrun = mnew;
            float psum = 0.f;
#pragma unroll
            for (int i = 0; i < 16; ++i) { s0[i] = __builtin_amdgcn_exp2f(s0[i] - mnew); s1[i] = __builtin_amdgcn_exp2f(s1[i] - mnew); psum += s0[i] + s1[i]; }
            lrun = lrun * alpha + psum;
            if (!__all(alpha == 1.0f)) {
#pragma unroll
                for (int cc = 0; cc < 4; ++cc)
#pragma unroll
                    for (int i = 0; i < 16; ++i) O[cc][i] *= alpha;
            }
            const unsigned vtr = vtr0 + (unsigned)(cur * AT_BUF);
#define AT_PV(S16, SRC, ST) do { bf16x8 pf, vf[4]; PACK_STEP(pf, SRC, ST); tr_read_v4<16 * S16 * AT_VP>(vtr, vf); \
                O[0] = MFMA32(vf[0], pf, O[0]); O[1] = MFMA32(vf[1], pf, O[1]); O[2] = MFMA32(vf[2], pf, O[2]); O[3] = MFMA32(vf[3], pf, O[3]); } while (0)
            if (!(local && half == 1)) AT_PV(0, s0, 0);
            AT_PV(1, s0, 1); AT_PV(2, s1, 0);
            if (!(local && half == 0)) AT_PV(3, s1, 1);
#undef AT_PV
        }
        __syncthreads();
    }
#undef AT_GLOAD
#undef AT_LWRITE
    const float inv = 1.0f / (lrun + __shfl_xor(lrun, 32));
    bf16* orow = ACAT + (size_t)qrow * D + GMW + h * HD + 4 * hl;
#pragma unroll
    for (int cc = 0; cc < 4; ++cc)
#pragma unroll
        for (int g = 0; g < 4; ++g) { u32x2 w; w.x = cvt_pk_bf16(O[cc][4 * g] * inv, O[cc][4 * g + 1] * inv); w.y = cvt_pk_bf16(O[cc][4 * g + 2] * inv, O[cc][4 * g + 3] * inv);
            *(u32x2*)(orow + 32 * cc + 8 * g) = w; }
}

constexpr int GM_IMG = 128 * 96;
__device__ __forceinline__ void gmlp_unit(LAS unsigned char* lds, const bf16* ZB, bf16* ACAT, const float* lng, const float* lnb, const bf16* WSb, const float* bs, int unit, int tid, int wid, int lane) {
    const int chunk = unit >> 1, gh = unit & 1;
    const int hl = lane >> 5, l31 = lane & 31, row0 = 128 * chunk;
    LAS f32x2* stats = (LAS f32x2*)(lds + 8 * GM_IMG);
    __syncthreads();
    {
        u32x4 raw[16][2];
#pragma unroll
        for (int k = 0; k < 16; ++k) { const bf16* p = ZB + (size_t)(row0 + 16 * wid + k) * 2048 + 1024 + 8 * lane; raw[k][0] = *(const u32x4*)p; raw[k][1] = *(const u32x4*)(p + 512); }
#pragma unroll
        for (int k = 0; k < 16; ++k) {
            f32x4 v[4]; unpack8(raw[k][0], v[0], v[1]); unpack8(raw[k][1], v[2], v[3]);
            float s = 0.f;
#pragma unroll
            for (int j = 0; j < 4; ++j) s += (v[j][0] + v[j][1]) + (v[j][2] + v[j][3]);
            const float mean = wave_sum(s) * (1.0f / 1024.0f); float q = 0.f;
#pragma unroll
            for (int j = 0; j < 4; ++j) { const f32x4 d = v[j] - mean; q += (d[0] * d[0] + d[1] * d[1]) + (d[2] * d[2] + d[3] * d[3]); }
            const float rstd = 1.0f / sqrtf(wave_sum(q) * (1.0f / 1024.0f) + LN_EPS);
            if (lane == 0) stats[16 * wid + k] = (f32x2){mean, rstd};
        }
    }
    __syncthreads();
    const int g = 4 * gh + (wid & 3);
    LAS unsigned char* img = lds + wid * GM_IMG;
    const int blk = (lane >> 4) & 1, q4 = (lane & 15) >> 2, p4 = lane & 3;
    const unsigned itr = lds_addr(img) + (unsigned)((8 * hl + q4) * 96 + 32 * blk + 8 * p4);
    const bf16* wbase = WSb + ((size_t)(g * 128 + l31) * 128 + 8 * hl);
    for (int cbi = 0; cbi < 2; ++cbi) {
        const int cbase = 128 * g + 32 * (2 * (wid >> 2) + cbi);
        u32x4 vraw[2][4];
#pragma unroll
        for (int j2 = 0; j2 < 2; ++j2)
#pragma unroll
            for (int k4 = 0; k4 < 4; ++k4) vraw[j2][k4] = *(const u32x4*)(ZB + (size_t)(row0 + lane + 64 * j2) * 2048 + 1024 + cbase + 8 * k4);
        bf16x8 wf[4][4];
#pragma unroll
        for (int s4 = 0; s4 < 4; ++s4)
#pragma unroll
            for (int qb = 0; qb < 4; ++qb) wf[s4][qb] = *(const bf16x8*)(wbase + (size_t)(32 * qb) * 128 + 16 * s4);
#pragma unroll
        for (int j2 = 0; j2 < 2; ++j2) {
            const int p = lane + 64 * j2; const f32x2 st = stats[p];
#pragma unroll
            for (int k4 = 0; k4 < 4; ++k4) {
                f32x4 a, bq; unpack8(vraw[j2][k4], a, bq);
                const f32x4 g0 = *(const f32x4*)(lng + cbase + 8 * k4), g1 = *(const f32x4*)(lng + cbase + 8 * k4 + 4), b0 = *(const f32x4*)(lnb + cbase + 8 * k4), b1 = *(const f32x4*)(lnb + cbase + 8 * k4 + 4);
                a = (a - st.x) * st.y * g0 + b0; bq = (bq - st.x) * st.y * g1 + b1;
                *(LAS u32x4*)(img + p * 96 + 16 * k4) = pg8::pack8(a, bq);
            }
        }
        u32x2 uw[4][4]; float bqv[4];
#pragma unroll
        for (int qb = 0; qb < 4; ++qb) { bqv[qb] = bs[g * 128 + 32 * qb + l31];
#pragma unroll
            for (int gq = 0; gq < 4; ++gq) uw[qb][gq] = *(const u32x2*)(ZB + (size_t)(row0 + 32 * qb + l31) * 2048 + cbase + 8 * gq + 4 * hl); }
        LDS_WAIT();
        f32x16 acc[4];
#pragma unroll
        for (int qb = 0; qb < 4; ++qb)
#pragma unroll
            for (int i = 0; i < 16; ++i) acc[qb][i] = 0.f;
#define GM_STEP(S, WF) do { const bf16x8 vf = tr_read2<16 * S * 96, 16 * S * 96 + 4 * 96>(itr); \
            _Pragma("unroll") for (int qb = 0; qb < 4; ++qb) acc[qb] = MFMA32(vf, WF[S & 3][qb], acc[qb]); } while (0)
        GM_STEP(0, wf); GM_STEP(1, wf); GM_STEP(2, wf); GM_STEP(3, wf);
#pragma unroll
        for (int s4 = 0; s4 < 4; ++s4)
#pragma unroll
            for (int qb = 0; qb < 4; ++qb) wf[s4][qb] = *(const bf16x8*)(wbase + (size_t)(32 * qb) * 128 + 16 * (4 + s4));
        GM_STEP(4, wf); GM_STEP(5, wf); GM_STEP(6, wf); GM_STEP(7, wf);
#undef GM_STEP
#pragma unroll
        for (int qb = 0; qb < 4; ++qb) {
            const int q = 32 * qb + l31; const float bq = bqv[qb];
            const size_t row = (size_t)(row0 + q);
#pragma unroll
            for (int gq = 0; gq < 4; ++gq) { const int col = cbase + 8 * gq + 4 * hl;
                const u32x2 uwv = uw[qb][gq];
                u32x2 w; w.x = cvt_pk_bf16(bf_lo(uwv.x) * (acc[qb][4 * gq] + bq), bf_hi(uwv.x) * (acc[qb][4 * gq + 1] + bq)); w.y = cvt_pk_bf16(bf_lo(uwv.y) * (acc[qb][4 * gq + 2] + bq), bf_hi(uwv.y) * (acc[qb][4 * gq + 3] + bq));
                *(u32x2*)(ACAT + row * D + col) = w; }
        }
        LDS_WAIT();
    }
}

constexpr int S5_WAVE_LDS = 8192 + 16 * 272;
__device__ __forceinline__ void s5_chunk_ids(int ci, int& b, int& n, bool& isctx) { isctx = ci >= 128; if (isctx) { b = (ci - 128) >> 1; n = (ci - 128) & 1; } else { b = ci >> 6; n = ci & 63; } }
__device__ __forceinline__ int s5_scan_index(int d, int n, bool isctx) { return d == 0 ? (isctx ? n : 2 + n) : (isctx ? 1 - n : 2 + (63 - n)); }
__device__ __forceinline__ void s5_load_u(bf16x8 (&ufr)[4], const bf16* US, int row0, int g, int lane) {
#pragma unroll
    for (int tb = 0; tb < 4; ++tb) ufr[tb] = *(const bf16x8*)(US + (size_t)(row0 + 32 * tb + (lane & 31)) * SSW + SG * g + 8 * (lane >> 5));
}
__device__ __forceinline__ void s5_bu(f32x16 (&Dt)[4], const bf16x8 uf, const bf16x8 (&bfr)[4]) {
#pragma unroll
    for (int j = 0; j < 4; ++j) {
#pragma unroll
        for (int i = 0; i < 16; ++i) Dt[j][i] = 0.f;
        Dt[j] = MFMA32(uf, bfr[j], Dt[j]); }
}
template <int H2> __device__ __forceinline__ void s5_bu_to_lds(LAS float* bu, const f32x16 (&Dt)[4], int lane) {
    const int hl = lane >> 5, l31 = lane & 31;
#pragma unroll
    for (int j = 0; j < 4; ++j)
#pragma unroll
        for (int ii = 0; ii < 8; ++ii) { const int i = 8 * H2 + ii, tt = (ii & 3) + 8 * (ii >> 2) + 4 * hl; bu[tt * 128 + 32 * j + l31] = Dt[j][i]; }
    LDS_WAIT();
}
template <bool WRITE_H> __device__ __forceinline__ void s5_scan16(const LAS float* bu, LAS unsigned char* hs, int d, float ar, float ai, float& hr, float& hi, int lane) {
    for (int st = 0; st < 16; ++st) { const int tt = d ? 15 - st : st;
        const float br = bu[tt * 128 + lane], bi = bu[tt * 128 + 64 + lane];
        const float nr = ar * hr - ai * hi + br, ni = ar * hi + ai * hr + bi; hr = nr; hi = ni;
        if (WRITE_H) { const unsigned w = cvt_pk_bf16(hr, hi);
            *(LAS unsigned short*)(hs + tt * 272 + 2 * lane) = (unsigned short)(w & 0xffffu); *(LAS unsigned short*)(hs + tt * 272 + 128 + 2 * lane) = (unsigned short)(w >> 16); } }
    LDS_WAIT();
}
__device__ __forceinline__ void s5_pass1(LAS unsigned char* wl, const bf16* US, const f32x4* SA_l, const bf16* SBB_l, f32x2* HEND, int ci, int g, int lane) {
    LAS float* bu = (LAS float*)wl;
    int b, n; bool isctx; s5_chunk_ids(ci, b, n, isctx);
    const int row0 = 128 * ci;
    bf16x8 ufr[4]; s5_load_u(ufr, US, row0, g, lane);
#pragma unroll
    for (int d = 0; d < 2; ++d) {
        const int k = s5_scan_index(d, n, isctx);
        if (k == NK - 1) continue;
        const f32x4 A = SA_l[(d * NG + g) * NP + lane];
        bf16x8 bfr[4];
#pragma unroll
        for (int j = 0; j < 4; ++j) bfr[j] = *(const bf16x8*)(SBB_l + ((size_t)((d * NG + g) * 128 + 32 * j + (lane & 31)) * SG + 8 * (lane >> 5)));
        float hr = 0.f, hi = 0.f;
#pragma unroll
        for (int tbi = 0; tbi < 4; ++tbi) {
            const int tb = d ? 3 - tbi : tbi;
            f32x16 Dt[4]; s5_bu(Dt, ufr[tb], bfr);
            if (d == 0) { s5_bu_to_lds<0>(bu, Dt, lane); s5_scan16<false>(bu, nullptr, 0, A[0], A[1], hr, hi, lane); s5_bu_to_lds<1>(bu, Dt, lane); s5_scan16<false>(bu, nullptr, 0, A[0], A[1], hr, hi, lane); }
            else        { s5_bu_to_lds<1>(bu, Dt, lane); s5_scan16<false>(bu, nullptr, 1, A[0], A[1], hr, hi, lane); s5_bu_to_lds<0>(bu, Dt, lane); s5_scan16<false>(bu, nullptr, 1, A[0], A[1], hr, hi, lane); }
        }
        HEND[((size_t)((b * 2 + d) * NK + k) * NG + g) * NP + lane] = (f32x2){hr, hi};
    }
}
__device__ __forceinline__ void s5_pass2(LAS unsigned char* wl, const bf16* US, const f32x4* SA_l, const bf16* SBB_l, const bf16* SC_l, const f32x2* HEND, const float* dskip_l, bf16* YS, int ci, int g, int lane) {
    LAS float* bu = (LAS float*)wl; LAS unsigned char* hs = wl + 8192;
    int b, n; bool isctx; s5_chunk_ids(ci, b, n, isctx);
    const int row0 = 128 * ci;
    f32x4 yacc[8];
#pragma unroll
    for (int sb = 0; sb < 8; ++sb) yacc[sb] = (f32x4){0.f, 0.f, 0.f, 0.f};
    const int t16 = lane & 15, kq = lane >> 4;
    bf16x8 ufr[4]; s5_load_u(ufr, US, row0, g, lane);
#define S5_HALF(SB, H2, DIR) do { s5_bu_to_lds<H2>(bu, Dt, lane); s5_scan16<true>(bu, hs, DIR, A[0], A[1], hr, hi, lane); \
        _Pragma("unroll") for (int kb = 0; kb < 4; ++kb) { const bf16x8 hf = *(const LAS bf16x8*)(hs + t16 * 272 + 64 * kb + 16 * kq); yacc[SB] = MFMA16(cf[kb], hf, yacc[SB]); } \
        LDS_WAIT(); } while (0)
#pragma unroll
    for (int d = 0; d < 2; ++d) {
        const int k = s5_scan_index(d, n, isctx);
        const f32x4 A = SA_l[(d * NG + g) * NP + lane];
        bf16x8 bfr[4], cf[4];
#pragma unroll
        for (int j = 0; j < 4; ++j) bfr[j] = *(const bf16x8*)(SBB_l + ((size_t)((d * NG + g) * 128 + 32 * j + (lane & 31)) * SG + 8 * (lane >> 5)));
#pragma unroll
        for (int kb = 0; kb < 4; ++kb) cf[kb] = *(const bf16x8*)(SC_l + ((size_t)((d * NG + g) * SG + t16) * 128 + 32 * kb + 8 * kq));
        float hr = 0.f, hi = 0.f;
        const f32x2* he = HEND + ((size_t)((b * 2 + d) * NK) * NG + g) * NP + lane;
        for (int j0 = 0; j0 < k; j0 += 8) {
            f32x2 e[8];
#pragma unroll
            for (int q = 0; q < 8; ++q) { const int jj = (j0 + q < k) ? j0 + q : k - 1; e[q] = he[(size_t)jj * NG * NP]; }
#pragma unroll
            for (int q = 0; q < 8; ++q) if (j0 + q < k) { const float nr = A[2] * hr - A[3] * hi + e[q].x, ni = A[2] * hi + A[3] * hr + e[q].y; hr = nr; hi = ni; }
        }
        f32x16 Dt[4];
        if (d == 0) {
            s5_bu(Dt, ufr[0], bfr); S5_HALF(0, 0, 0); S5_HALF(1, 1, 0);
            s5_bu(Dt, ufr[1], bfr); S5_HALF(2, 0, 0); S5_HALF(3, 1, 0);
            s5_bu(Dt, ufr[2], bfr); S5_HALF(4, 0, 0); S5_HALF(5, 1, 0);
            s5_bu(Dt, ufr[3], bfr); S5_HALF(6, 0, 0); S5_HALF(7, 1, 0);
        } else {
            s5_bu(Dt, ufr[3], bfr); S5_HALF(7, 1, 1); S5_HALF(6, 0, 1);
            s5_bu(Dt, ufr[2], bfr); S5_HALF(5, 1, 1); S5_HALF(4, 0, 1);
            s5_bu(Dt, ufr[1], bfr); S5_HALF(3, 1, 1); S5_HALF(2, 0, 1);
            s5_bu(Dt, ufr[0], bfr); S5_HALF(1, 1, 1); S5_HALF(0, 0, 1);
        }
    }
#undef S5_HALF
    const f32x4 dsk = *(const f32x4*)(dskip_l + SG * g + 4 * kq);
#pragma unroll
    for (int sb = 0; sb < 8; ++sb) { const int t = 16 * sb + t16; const u32x2 uw = *(const u32x2*)(US + (size_t)(row0 + t) * SSW + SG * g + 4 * kq);
        const f32x4 us4 = {bf_lo(uw.x), bf_hi(uw.x), bf_lo(uw.y), bf_hi(uw.y)};
        f32x4 y = yacc[sb] + dsk * us4;
#pragma unroll
        for (int e = 0; e < 4; ++e) y[e] = gelu_tanh_f(y[e]);
        u32x2 w; w.x = cvt_pk_bf16(y[0], y[1]); w.y = cvt_pk_bf16(y[2], y[3]);
        *(u32x2*)(YS + (size_t)(row0 + t) * SSW + SG * g + 4 * kq) = w; }
}

constexpr int NPH = 2 + 13 * DEPTH;
__global__ void __launch_bounds__(512, 2) fwd_kernel(Args args) {
    extern __shared__ __attribute__((aligned(16))) unsigned char lds_raw[];
    LAS unsigned char* lds = (LAS unsigned char*)lds_raw;
    volatile LAS unsigned* MISC = (volatile LAS unsigned*)(lds + MISC_OFF);
    for (int u = threadIdx.x; u < (LDS_BYTES - LDSCTL_OFF) / 4; u += 512) ((LAS unsigned*)(lds + LDSCTL_OFF))[u] = 0u;
    __syncthreads();
    const int lo = args.ph_lo, hi = args.ph_hi;
    const bool use_bar = (hi - lo) > 1;
    XcdBarrier bar; bar.bar = (unsigned*)(args.ws + WS_CTL) + CW_BAR; bar.x = 0; bar.st = nullptr;
    if (use_bar) bar = xcd_barrier_post((unsigned*)(args.ws + WS_CTL) + CW_BAR, MISC + 8);
#ifndef PH_MASK
#define PH_MASK 0xFFFFFFFFu
#endif
#define IN(k) ((PH_MASK >> ((k) < 2 ? (k) : 2 + ((k) - 2) % 13) & 1u) && lo <= (k) && (k) < hi)
#define SEAM(k) do { if (IN(k) && IN((k) + 1)) xcd_barrier(bar); } while (0)
#define PHASE_IDS() int tid = threadIdx.x; asm volatile("" : "+v"(tid)); const int lane = tid & 63, wid = __builtin_amdgcn_readfirstlane(tid >> 6); \
    int bx = blockIdx.x, G = gridDim.x; asm volatile("" : "+s"(bx), "+s"(G)); GAS unsigned char* wsg_ = (GAS unsigned char*)args.ws; asm volatile("" : "+s"(wsg_)); unsigned char* ws = (unsigned char*)wsg_; const int gw = bx * 8 + wid, NGW = G * 8; (void)lane; (void)gw; (void)NGW
#define X ((float*)(ws + WS_X))
#define H ((bf16*)(ws + WS_H))
#define ACT ((bf16*)(ws + WS_ACT))
#define QP ((bf16*)(ws + WS_QP))
#define QR ((bf16*)(ws + WS_QR))
#define KB ((bf16*)(ws + WS_KB))
#define VB ((bf16*)(ws + WS_VB))
#define ZB ((bf16*)(ws + WS_ZB))
#define US ((bf16*)(ws + WS_US))
#define GB ((bf16*)(ws + WS_GB))
#define ACAT ((bf16*)(ws + WS_ACAT))
#define YS ((bf16*)(ws + WS_YS))
#define MG ((bf16*)(ws + WS_MG))
#define YB ((bf16*)(ws + WS_Y))
#define XSRC_IN (l == 0 ? as_global(args.in[0]) : nullptr)
#define modv ((const float*)(ws + WS_MOD))
#define WL(off) ((const bf16*)(ws + WS_W + (size_t)l * LW_BYTES + (off)))
#define MODL (modv + (size_t)l * 3 * NMODC)
#define LNG(i) (as_global(args.in[6]) + (size_t)(l * 3 + (i)) * D)
#define LNB(i) (as_global(args.in[7]) + (size_t)(l * 3 + (i)) * D)
#define MEFF (l == DEPTH - 1 ? ML : M)
constexpr int NCTXU = (MC / 256) * (D / 256);
#define OVL(mrows_) (use_bar && (mrows_) == M && G >= 4 * NCTXU)

    if (IN(0)) {
        PHASE_IDS();
        p0_tables(args, bx * 512 + tid, G * 512);
        p0_mod(args, lds, wid, lane, tid, G, bx);
        p0_weights(args, lds, wid, lane, G, bx);
        __syncthreads();
    }
    SEAM(0);
    if (IN(1)) { PHASE_IDS(); thin_phase(0, as_global(args.in[0]), as_global(args.in[2]), X, nullptr, nullptr, nullptr, modv, 0, 1, H, nullptr, M, gw, NGW, lane, (LAS float*)lds, tid); }
    SEAM(1);

    for (int l = 0; l < DEPTH; ++l) {
        const int pb = 2 + 13 * l;
        if (pb >= hi || pb + 13 <= lo) continue;
        if (IN(pb + 0)) { PHASE_IDS(); pg8::Gemm g{H, WL(LW_W1IN), M, 2 * DFF, D, D, D}; pg8::StaticOrder S; S.init(M, 2 * DFF, G, bx, D); pg8::EpiSwiGLU E{ACT, DFF};
            pg8::gemm_phase<pg8::EpiSwiGLU, pg8::StaticOrder>(lds, g, S, E, tid); }
        SEAM(pb + 0);
        if (IN(pb + 1)) { PHASE_IDS(); const int mr = OVL(M) ? ML : M; pg8::Gemm g{ACT, WL(LW_W1OUT), mr, D, DFF, DFF, DFF}; pg8::StaticOrder S; S.init(mr, D, G, bx, DFF); pg8::EpiY E{YB, MODL, 2, 0.5f};
            pg8::gemm_phase<pg8::EpiY, pg8::StaticOrder>(lds, g, S, E, tid); }
        SEAM(pb + 1);
        if (IN(pb + 2)) { PHASE_IDS();
            if (OVL(M)) {
                if (bx < NCTXU) { pg8::Gemm g{ACT, WL(LW_W1OUT), M, D, DFF, DFF, DFF}; pg8::CtxOrder S; S.init(D, bx, DFF); pg8::EpiY E{YB, MODL, 2, 0.5f}; pg8::gemm_phase<pg8::EpiY, pg8::CtxOrder>(lds, g, S, E, tid); }
                else thin_phase(1, XSRC_IN, as_global(args.in[2]), X, YB, LNG(0), LNB(0), MODL, 3, 4, H, nullptr, ML, (bx - NCTXU) * 8 + wid, (G - NCTXU) * 8, lane, (LAS float*)lds, tid, (unsigned char*)ACT);
                xcd_barrier(bar);
                thin_phase(1, XSRC_IN, as_global(args.in[2]), X, YB, LNG(0), LNB(0), MODL, 3, 4, H, nullptr, M, gw, NGW, lane, (LAS float*)lds, tid, (unsigned char*)ACT, ML);
            } else thin_phase(1, XSRC_IN, as_global(args.in[2]), X, YB, LNG(0), LNB(0), MODL, 3, 4, H, nullptr, M, gw, NGW, lane, (LAS float*)lds, tid, (unsigned char*)ACT); }
        SEAM(pb + 2);
        if (IN(pb + 3)) {
            { PHASE_IDS(); pg8::Gemm g{H, WL(LW_WIN), M, 36 * 256, D, D, D}; pg8::StaticOrder S; S.init(M, 36 * 256, G, bx, D);
              pg8::EpiIn<false> E{ws, (const float*)(ws + WS_ROPE), 0, 1.0f};
              pg8::gemm_phase<pg8::EpiIn<false>, pg8::StaticOrder>(lds, g, S, E, tid); }
            { PHASE_IDS(); pg8::Gemm g{ACT, WL(LW_W8), MEFF, 48 * 256, D / 2, D / 2, D / 2}; pg8::StaticOrder S; S.init(MEFF, 48 * 256, G, (bx + G / 2) % G, D / 2);
              pg8::EpiIn<true> E{ws, (const float*)(ws + WS_ROPE), 36, 1.0f / 16384.0f};
              pg8::gemm_phase<pg8::EpiIn<true>, pg8::StaticOrder>(lds, g, S, E, tid); }
        }
        SEAM(pb + 3);
#ifndef M1_MASK
#define M1_MASK 7
#endif
        if (IN(pb + 4)) {
            if (M1_MASK & 1) { PHASE_IDS();
                const float* rpb_l = as_global(args.in[13]) + (size_t)l * NH * 465;
                for (int u = bx; u < (l == DEPTH - 1 ? 1024 : 1056); u += G) {
                    if (u < 1024) { const int rb = u & 31, h = (u >> 5) & 15, b = u >> 9; attn_unit(lds, QP, QR, KB, VB, ACAT, rpb_l, b, h, 4 * rb, tid, wid, lane); }
                    else { const int v = u - 1024; attn_unit(lds, QP, QR, KB, VB, ACAT, rpb_l, v >> 4, v & 15, -1, tid, wid, lane); }
                }
                __syncthreads(); }
            if (M1_MASK & 2) { PHASE_IDS();
                for (int u = (G - 1 - bx); u < 2 * (MEFF / 128); u += G)
                    gmlp_unit(lds, ZB, ACAT, as_global(args.in[14]) + (size_t)l * GMW, as_global(args.in[15]) + (size_t)l * GMW, (const bf16*)(ws + WS_GWS) + (size_t)l * 8 * 128 * 128, as_global(args.in[17]) + (size_t)l * 8 * 128, u, tid, wid, lane);
                __syncthreads(); }
            if (M1_MASK & 4) { PHASE_IDS();
                for (int u = gw; u < NCH * NG; u += NGW)
                    s5_pass1(lds + wid * S5_WAVE_LDS, US, (const f32x4*)(ws + WS_SA) + (size_t)l * 2 * NG * NP, (const bf16*)(ws + WS_SBB) + (size_t)l * 2 * NG * 128 * SG, (f32x2*)(ws + WS_HEND), u >> 6, u & 63, lane);
                __syncthreads(); }
        }
        SEAM(pb + 4);
        if (IN(pb + 5)) { PHASE_IDS();
            for (int u = gw; u < (MEFF / 128) * NG; u += NGW)
                s5_pass2(lds + wid * S5_WAVE_LDS, US, (const f32x4*)(ws + WS_SA) + (size_t)l * 2 * NG * NP, (const bf16*)(ws + WS_SBB) + (size_t)l * 2 * NG * 128 * SG, (const bf16*)(ws + WS_SC) + (size_t)l * 2 * NG * SG * 128,
                         (const f32x2*)(ws + WS_HEND), as_global(args.in[25]) + (size_t)l * SSW, YS, u >> 6, u & 63, lane);
            __syncthreads();
        }
        SEAM(pb + 5);
        if (IN(pb + 6)) { PHASE_IDS(); pg8::Gemm g{YS, WL(LW_WGLU), MEFF, SSW, SSW, SSW, SSW}; pg8::StaticOrder S; S.init(MEFF, SSW, G, bx, SSW); pg8::EpiGLU E{YS, ACAT + GMW + AW, as_global(args.in[27]) + (size_t)l * SSW};
            pg8::gemm_phase<pg8::EpiGLU, pg8::StaticOrder>(lds, g, S, E, tid); }
        SEAM(pb + 6);
        if (IN(pb + 7)) { PHASE_IDS(); pg8::Gemm g{ACAT, WL(LW_WCAT), MEFF, D, D, D, D}; pg8::MergeOrder S; S.init(MEFF, D, G, bx); pg8::EpiMerge1 E{GB, MG};
            pg8::gemm_phase<pg8::EpiMerge1, pg8::MergeOrder>(lds, g, S, E, tid); }
        SEAM(pb + 7);
        if (IN(pb + 8)) { PHASE_IDS(); const int mr = OVL(MEFF) ? ML : MEFF; pg8::Gemm g{MG, WL(LW_WO), mr, D, D, D, D}; pg8::StaticOrder S; S.init(mr, D, G, bx, D); pg8::EpiY E{YB, MODL, 5, 1.0f};
            pg8::gemm_phase<pg8::EpiY, pg8::StaticOrder>(lds, g, S, E, tid); }
        SEAM(pb + 8);
        if (IN(pb + 9)) { PHASE_IDS();
            if (OVL(MEFF)) {
                if (bx < NCTXU) { pg8::Gemm g{MG, WL(LW_WO), M, D, D, D, D}; pg8::CtxOrder S; S.init(D, bx, D); pg8::EpiY E{YB, MODL, 5, 1.0f}; pg8::gemm_phase<pg8::EpiY, pg8::CtxOrder>(lds, g, S, E, tid); }
                else thin_phase(1, nullptr, nullptr, X, YB, LNG(1), LNB(1), MODL, 6, 7, H, nullptr, ML, (bx - NCTXU) * 8 + wid, (G - NCTXU) * 8, lane, (LAS float*)lds, tid);
                xcd_barrier(bar);
                thin_phase(1, nullptr, nullptr, X, YB, LNG(1), LNB(1), MODL, 6, 7, H, nullptr, M, gw, NGW, lane, (LAS float*)lds, tid, nullptr, ML);
            } else thin_phase(1, nullptr, nullptr, X, YB, LNG(1), LNB(1), MODL, 6, 7, H, nullptr, MEFF, gw, NGW, lane, (LAS float*)lds, tid); }
        SEAM(pb + 9);
        if (IN(pb + 10)) { PHASE_IDS(); pg8::Gemm g{H, WL(LW_W2IN), MEFF, 2 * DFF, D, D, D}; pg8::StaticOrder S; S.init(MEFF, 2 * DFF, G, bx, D); pg8::EpiSwiGLU E{ACT, DFF};
            pg8::gemm_phase<pg8::EpiSwiGLU, pg8::StaticOrder>(lds, g, S, E, tid); }
        SEAM(pb + 10);
        if (IN(pb + 11)) { PHASE_IDS(); const int mr = OVL(MEFF) ? ML : MEFF; pg8::Gemm g{ACT, WL(LW_W2OUT), mr, D, DFF, DFF, DFF}; pg8::StaticOrder S; S.init(mr, D, G, bx, DFF); pg8::EpiY E{YB, MODL, 8, 0.5f};
            pg8::gemm_phase<pg8::EpiY, pg8::StaticOrder>(lds, g, S, E, tid); }
        SEAM(pb + 11);
        if (IN(pb + 12)) { PHASE_IDS();
            if (l + 1 < DEPTH && OVL(M)) {
                if (bx < NCTXU) { pg8::Gemm g{ACT, WL(LW_W2OUT), M, D, DFF, DFF, DFF}; pg8::CtxOrder S; S.init(D, bx, DFF); pg8::EpiY E{YB, MODL, 8, 0.5f}; pg8::gemm_phase<pg8::EpiY, pg8::CtxOrder>(lds, g, S, E, tid); }
                else thin_phase(1, nullptr, nullptr, X, YB, LNG(2), LNB(2), MODL + 3 * NMODC, 0, 1, H, nullptr, ML, (bx - NCTXU) * 8 + wid, (G - NCTXU) * 8, lane, (LAS float*)lds, tid);
                xcd_barrier(bar);
                thin_phase(1, nullptr, nullptr, X, YB, LNG(2), LNB(2), MODL + 3 * NMODC, 0, 1, H, nullptr, M, gw, NGW, lane, (LAS float*)lds, tid, nullptr, ML);
            } else if (l + 1 < DEPTH) thin_phase(1, nullptr, nullptr, X, YB, LNG(2), LNB(2), MODL + 3 * NMODC, 0, 1, H, nullptr, M, gw, NGW, lane, (LAS float*)lds, tid);
            else thin_phase(2, nullptr, nullptr, X, YB, LNG(2), LNB(2), MODL, 0, 1, H, as_global(args.out), ML, gw, NGW, lane, (LAS float*)lds, tid);
        }
        SEAM(pb + 12);
    }
}

extern "C" void kernel_launch(void* const* d_in, const int* in_sizes, int n_in, void* d_out, int out_size, void* d_ws, size_t ws_size, hipStream_t stream) {
    static int grid = 0;
    if (grid == 0) {
        if (n_in != 32 || out_size != ML * D || ws_size < WS_END) { fprintf(stderr, "kernel_launch: unexpected sizes (n_in %d, out %d, ws %zu, need %zu)\n", n_in, out_size, ws_size, (size_t)WS_END); grid = -1; return; }
        int dev = 0, cus = 0, per_cu = 0;
        if (hipGetDevice(&dev) != hipSuccess || hipDeviceGetAttribute(&cus, hipDeviceAttributeMultiprocessorCount, dev) != hipSuccess) { grid = -1; return; }
        if (hipFuncSetAttribute((const void*)fwd_kernel, hipFuncAttributeMaxDynamicSharedMemorySize, LDS_BYTES) != hipSuccess) { fprintf(stderr, "kernel_launch: hipFuncSetAttribute failed\n"); grid = -1; return; }
        if (hipOccupancyMaxActiveBlocksPerMultiprocessor(&per_cu, (const void*)fwd_kernel, 512, LDS_BYTES) != hipSuccess || per_cu < 1) fprintf(stderr, "kernel_launch: occupancy query says %d\n", per_cu);
        (void)hipGetLastError();
        grid = cus;
    }
    if (grid < 0) return;
    (void)hipMemsetAsync((char*)d_ws + WS_CTL, 0, CTL_ZERO_BYTES, stream);
    Args a{};
    for (int i = 0; i < 32; ++i) a.in[i] = (const float*)d_in[i];
    a.out = (float*)d_out; a.ws = (unsigned char*)d_ws;
#if MK_N_LAUNCHES == 1
    a.ph_lo = 0; a.ph_hi = NPH;
    hipLaunchKernelGGL(fwd_kernel, dim3(grid), dim3(512), LDS_BYTES, stream, a);
#else
    for (int p = 0; p < NPH; ++p) { a.ph_lo = p; a.ph_hi = p + 1; hipLaunchKernelGGL(fwd_kernel, dim3(grid), dim3(512), LDS_BYTES, stream, a); }
#endif
}
```

```cpp
#include <hip/hip_runtime.h>
#include <cstdio>
#include <cstdint>

#ifndef MK_N_LAUNCHES
#define MK_N_LAUNCHES 1
#endif

#define GAS __attribute__((address_space(1)))
#define LAS __attribute__((address_space(3)))
typedef unsigned short bf16;
typedef short bf16x8 __attribute__((ext_vector_type(8)));
typedef short s16x4 __attribute__((ext_vector_type(4)));
typedef float f32x2 __attribute__((ext_vector_type(2)));
typedef float f32x4 __attribute__((ext_vector_type(4)));
typedef float f32x16 __attribute__((ext_vector_type(16)));
typedef unsigned u32x2 __attribute__((ext_vector_type(2)));
typedef unsigned u32x4 __attribute__((ext_vector_type(4)));

constexpr int D = 4096, NB = 2, SEQ = 8192, CTXL = 256, DEPTH = 2;
constexpr int ML = NB * SEQ, MC = NB * CTXL, M = ML + MC;
constexpr int DFF = 6144, NMOD = 9, NMODC = NMOD * D;
constexpr int AW = 2048, NH = 16, HD = 128, GMW = 1024, SSW = 1024, NG = 64, NP = 64, SG = 16;
constexpr int NIN = 21504;
constexpr int NCH = M / 128;
constexpr int NK = 66;
constexpr float ALPHA = 1.4142135623730951f, LN_EPS = 1e-6f, LOG2E = 1.4426950408889634f;

constexpr size_t MiB = 1u << 20;
constexpr size_t WS_CTL = 0, CTL_ZERO_BYTES = 1 * MiB;
constexpr size_t WS_MOD = 1 * MiB;
constexpr size_t WS_ROPE = 2 * MiB;
constexpr size_t WS_SA = 3 * MiB;
constexpr size_t WS_SBB = 4 * MiB;
constexpr size_t WS_SC = 6 * MiB;
constexpr size_t WS_GWS = 7 * MiB;
constexpr size_t WS_HEND = 8 * MiB;
constexpr size_t WS_W = 32 * MiB;
constexpr size_t LW_W1IN = 0, LW_W1OUT = 96 * MiB, LW_W2IN = 144 * MiB, LW_W2OUT = 240 * MiB, LW_WIN = 288 * MiB, LW_WGLU = 456 * MiB, LW_WCAT = 458 * MiB, LW_WO = 490 * MiB, LW_W8 = 522 * MiB  , LW_BYTES = 570 * MiB;
constexpr size_t WS_X = WS_W + 2 * LW_BYTES;
constexpr size_t WS_H = WS_X + 264 * MiB;
constexpr size_t WS_ACT = WS_H + 132 * MiB;
constexpr size_t WS_QP = WS_ACT + 198 * MiB;
constexpr size_t WS_QR = WS_QP + 66 * MiB;
constexpr size_t WS_KB = WS_QR + 66 * MiB;
constexpr size_t WS_VB = WS_KB + 66 * MiB;
constexpr size_t WS_ZB = WS_VB + 66 * MiB;
constexpr size_t WS_US = WS_ZB + 66 * MiB;
constexpr size_t WS_GB = WS_US + 33 * MiB;
constexpr size_t WS_ACAT = WS_GB + 396 * MiB;
constexpr size_t WS_YS = WS_ACAT + 132 * MiB;
constexpr size_t WS_MG = WS_YS + 33 * MiB;
constexpr size_t WS_Y = WS_MG + 132 * MiB;
constexpr size_t WS_END = WS_Y + 132 * MiB;
constexpr int CW_BAR = 4096;

constexpr int RING_BYTES = 131072, LDSCTL_OFF = RING_BYTES, MISC_OFF = LDSCTL_OFF + 320, LDS_BYTES = 147456;

__device__ __forceinline__ unsigned cvt_pk_bf16(float lo, float hi) { unsigned r; asm volatile("v_cvt_pk_bf16_f32 %0, %1, %2" : "=v"(r) : "v"(lo), "v"(hi)); return r; }
__device__ __forceinline__ float bf_lo(unsigned w) { return __uint_as_float(w << 16); }
__device__ __forceinline__ float bf_hi(unsigned w) { return __uint_as_float(w & 0xffff0000u); }
__device__ __forceinline__ float fast_sigmoid(float x) { return __builtin_amdgcn_rcpf(1.0f + __builtin_amdgcn_exp2f(-LOG2E * x)); }
__device__ __forceinline__ float silu_f(float x) { return x * fast_sigmoid(x); }
__device__ __forceinline__ float gelu_tanh_f(float x) { const float u = 1.5957691216057308f * (x + 0.044715f * x * x * x); return x * fast_sigmoid(u); }
template <class T> __device__ __forceinline__ T* as_global(T* p) { return (T*)(GAS T*)p; }
#define LDS_WAIT() asm volatile("s_waitcnt lgkmcnt(0)" ::: "memory")
#define VM_WAIT() asm volatile("s_waitcnt vmcnt(0)" ::: "memory")

namespace pg8 {
constexpr int BM = 256, BK = 64, HALF = 128, HTB = HALF * BK * 2, STAGE_BYTES = 8 * HTB, NXCD = 8, WGM = 4;
__host__ __device__ __forceinline__ int lds_byte(int r, int c) { const int st = (r >> 4) * 2 + (c >> 5), rr = r & 15, cc = c & 31, ob = rr * 64 + cc * 2; return st * 1024 + (ob ^ (((ob >> 9) & 1) << 5)); }
__host__ __device__ __forceinline__ void stage_rc(int b, int& R, int& C) { const int st = b / 1024, sb = b % 1024, swz = sb ^ (((sb >> 9) & 1) << 5); R = (st >> 1) * 16 + swz / 64; C = (st & 1) * 32 + (swz % 64) / 2; }
__host__ __device__ __forceinline__ int perm32(int rho) { const int n = rho >> 4, i = rho & 15; return 8 * (i >> 2) + 4 * n + (i & 3); }
typedef int v8i __attribute__((ext_vector_type(8)));
typedef int v4i __attribute__((ext_vector_type(4)));
struct Unit { int pm, pn, k0, nt, seg; };
struct Gemm { const bf16* A; const bf16* Bt; int M, N, K, lda, ldb; };
struct StaticOrder {
    int nM, nN, nwg, G, c, ntk;
    __host__ __device__ void init(int M_, int N_, int G_, int c_, int K_) { nM = M_ / BM; nN = N_ / BM; nwg = nM * nN; G = G_; c = c_; ntk = K_ / BK; }
    __host__ __device__ __forceinline__ bool next(int i, Unit& u) const {
        u.pm = 0; u.pn = 0; u.k0 = 0; u.nt = ntk; u.seg = 0;
        const long L = (long)i * G + c; if (L >= nwg) return false;
        int wgid = (int)L; { const int q = nwg / NXCD, r = nwg % NXCD, xcd = wgid % NXCD, off = wgid / NXCD; wgid = (xcd < r ? xcd * (q + 1) : r * (q + 1) + (xcd - r) * q) + off; }
        const int nig = WGM * nN, gid = wgid / nig, fm = gid * WGM, gsz = (nM - fm) < WGM ? (nM - fm) : WGM;
        u.pm = fm + ((wgid % nig) % gsz); u.pn = (wgid % nig) / gsz; return true;
    }
    __device__ __forceinline__ void a_ready(const Unit&) const {}
    __device__ __forceinline__ void done(const Unit&) const {}
};

struct CtxOrder {
    int nN, c, ntk;
    __host__ __device__ void init(int N_, int c_, int K_) { nN = N_ / BM; c = c_; ntk = K_ / BK; }
    __host__ __device__ __forceinline__ bool next(int i, Unit& u) const { u.pm = ML / BM + c / nN; u.pn = c % nN; u.k0 = 0; u.nt = ntk; u.seg = 0; return i == 0 && c < (MC / BM) * nN; }
    __device__ __forceinline__ void a_ready(const Unit&) const {}
    __device__ __forceinline__ void done(const Unit&) const {}
};
struct MergeOrder {
    StaticOrder tiles;
    __host__ __device__ void init(int M_, int N_, int G_, int c_) { tiles.init(M_, N_, G_, c_, GMW + AW + SSW); }
    __host__ __device__ __forceinline__ bool next(int i, Unit& u) const {
        const int it = i / 3, sg = i - 3 * it; Unit t; const bool ok = tiles.next(it, t);
        u.pm = t.pm; u.pn = t.pn; u.seg = sg; u.k0 = sg == 0 ? 0 : (sg == 1 ? GMW : GMW + AW); u.nt = (sg == 1 ? AW : GMW) / BK; return ok;
    }
    __device__ __forceinline__ void a_ready(const Unit&) const {}
    __device__ __forceinline__ void done(const Unit&) const {}
};

template <class Epi, class Sched, bool ALIGN_EPI = true, bool SP2 = true>
__device__ __forceinline__ void gemm_phase(LAS unsigned char* lds, const Gemm g, const Sched& S, const Epi& E, const int tid) {
    const int wid = __builtin_amdgcn_readfirstlane(tid >> 6), lane = tid & 63, wr = wid >> 2, wc = wid & 3, fr = lane & 15, fq = lane >> 4;
    unsigned voffA[2], voffB[2];
#pragma unroll
    for (int i = 0; i < 2; ++i) { int R, C; stage_rc(tid * 16 + i * 8192, R, C); const int Rb = Epi::PERM ? ((R & ~31) + perm32(R & 31)) : R;
        voffA[i] = (unsigned)(R * g.lda + C) * 2u; voffB[i] = (unsigned)(Rb * g.ldb + C) * 2u; }
    const unsigned kstep = (unsigned)(BK * 2);
    const unsigned hA = (unsigned)HALF * (unsigned)g.lda * 2u, hB = (unsigned)HALF * (unsigned)g.ldb * 2u;
    const unsigned tA = 2 * hA, tB = 2 * hB;
    const __amdgpu_buffer_rsrc_t srd_voffA = __builtin_amdgcn_make_buffer_rsrc((void*)g.A, 0, 0x7ffffff0, 0x00020000);
    const __amdgpu_buffer_rsrc_t srd_voffB = __builtin_amdgcn_make_buffer_rsrc((void*)g.Bt, 0, 0x7ffffff0, 0x00020000);
    const unsigned ldsw = (unsigned)wid * 1024u;
    constexpr bool FP8 = Epi::FP8;
    const int aoff = FP8 ? lds_byte(wr * 64 + fr, fq * 16) : lds_byte(wr * 64 + fr, fq * 8), boff = FP8 ? lds_byte(wc * 32 + fr, fq * 16) : lds_byte(wc * 32 + fr, fq * 8);
    const int aoff1 = FP8 ? lds_byte(wr * 64 + fr, fq * 16 + 8) : aoff + 1024, boff1 = FP8 ? lds_byte(wc * 32 + fr, fq * 16 + 8) : boff + 1024;
#define PG8_SA(b, h) (((b) * 2 + (h)) * HTB)
#define PG8_SB(b, h) ((4 + (b) * 2 + (h)) * HTB)
#define PG8_STAGE(bufoff, gbase, voff) do { _Pragma("unroll") for (int _i = 0; _i < 2; ++_i) \
        __builtin_amdgcn_raw_ptr_buffer_load_lds(srd_##voff, (LAS void*)(lds + (bufoff) + ldsw + _i * 8192), 16, (int)(voff)[_i], (int)(gbase), 0, 0); } while (0)
#define PG8_LDA(dst, b, h) do { if constexpr (FP8) { _Pragma("unroll") for (int m = 0; m < 4; ++m) { dst##8[m].lo = *(const LAS v4i*)(lds + PG8_SA(b, h) + aoff + m * 2048); dst##8[m].hi = *(const LAS v4i*)(lds + PG8_SA(b, h) + aoff1 + m * 2048); } } \
        else { _Pragma("unroll") for (int m = 0; m < 4; ++m) _Pragma("unroll") for (int k = 0; k < 2; ++k) dst[m][k] = *(const LAS bf16x8*)(lds + PG8_SA(b, h) + (k ? aoff1 : aoff) + m * 2048); } } while (0)
#define PG8_LDB(dst, b, h) do { if constexpr (FP8) { _Pragma("unroll") for (int n = 0; n < 2; ++n) { dst##8[n].lo = *(const LAS v4i*)(lds + PG8_SB(b, h) + boff + n * 2048); dst##8[n].hi = *(const LAS v4i*)(lds + PG8_SB(b, h) + boff1 + n * 2048); } } \
        else { _Pragma("unroll") for (int n = 0; n < 2; ++n) _Pragma("unroll") for (int k = 0; k < 2; ++k) dst[n][k] = *(const LAS bf16x8*)(lds + PG8_SB(b, h) + (k ? boff1 : boff) + n * 2048); } } while (0)
#define PG8_MMA(ai, bj, At, Bt) do { __builtin_amdgcn_s_setprio(1); _Pragma("unroll") for (int m = 0; m < 4; ++m) _Pragma("unroll") for (int n = 0; n < 2; ++n) { \
        if constexpr (FP8) asm volatile("v_mfma_scale_f32_16x16x128_f8f6f4 %0, %1, %2, %0, %3, %3 op_sel_hi:[0,0,0]" : "+v"(acc[ai][bj][m][n]) : "v"(Bt##8[n]), "v"(At##8[m]), "v"(scale1));   \
        else { _Pragma("unroll") for (int k = 0; k < 2; ++k) acc[ai][bj][m][n] = __builtin_amdgcn_mfma_f32_16x16x32_bf16(Bt[n][k], At[m][k], acc[ai][bj][m][n], 0, 0, 0); } } __builtin_amdgcn_s_setprio(0); } while (0)
#define PG8_WAIT_V(n) asm volatile("s_waitcnt vmcnt(" #n ")" ::: "memory")
#define PG8_WAIT_L(n) asm volatile("s_waitcnt lgkmcnt(" #n ")" ::: "memory")
#define PG8_BAR __builtin_amdgcn_s_barrier()
#define PG8_SCHED __builtin_amdgcn_sched_barrier(0)
    Unit cur, nxt; int ui = 0;
    if (!S.next(0, cur)) return;
    f32x4 acc[2][2][4][2];
#pragma unroll
    for (int a = 0; a < 2; ++a)
#pragma unroll
        for (int b = 0; b < 2; ++b)
#pragma unroll
            for (int m = 0; m < 4; ++m)
#pragma unroll
                for (int n = 0; n < 2; ++n) acc[a][b][m][n] = (f32x4){0.f, 0.f, 0.f, 0.f};
    const int scale1 = 0x7f7f7f7f;
    bf16x8 At[4][2], B0[2][2], B1[2][2]; v8i At8[4], B08[2], B18[2];
    unsigned cA = (unsigned)cur.pm * tA + (unsigned)cur.k0 * 2u, cB = (unsigned)cur.pn * tB + (unsigned)cur.k0 * 2u;
    S.a_ready(cur);
    if constexpr (SP2) {
        PG8_STAGE(PG8_SB(0, 0), cB, voffB); PG8_STAGE(PG8_SB(0, 1), cB + hB, voffB); PG8_STAGE(PG8_SA(0, 0), cA, voffA); PG8_STAGE(PG8_SA(0, 1), cA + hA, voffA);
        if (wr == 1) PG8_BAR;
        PG8_WAIT_V(2); PG8_BAR;
        PG8_STAGE(PG8_SB(1, 0), cB + kstep, voffB); PG8_STAGE(PG8_SA(1, 0), cA + kstep, voffA); PG8_STAGE(PG8_SB(1, 1), cB + hB + kstep, voffB);
        PG8_WAIT_V(6); PG8_BAR;
    } else {
        PG8_STAGE(PG8_SB(0, 0), cB, voffB); PG8_STAGE(PG8_SA(0, 0), cA, voffA); PG8_STAGE(PG8_SB(0, 1), cB + hB, voffB); PG8_STAGE(PG8_SA(0, 1), cA + hA, voffA);
        if (wr == 1) PG8_BAR;
        PG8_WAIT_V(4); PG8_BAR;
        PG8_STAGE(PG8_SB(1, 0), cB + kstep, voffB); PG8_STAGE(PG8_SA(1, 0), cA + kstep, voffA); PG8_STAGE(PG8_SB(1, 1), cB + hB + kstep, voffB);
        PG8_WAIT_V(6); PG8_BAR;
    }
    for (;;) {
        const bool has_next = S.next(ui + 1, nxt);
        const unsigned nA = has_next ? (unsigned)nxt.pm * tA + (unsigned)nxt.k0 * 2u : cA, nB = has_next ? (unsigned)nxt.pn * tB + (unsigned)nxt.k0 * 2u : cB;
        const int nt = cur.nt;
        for (int t = 0; t < nt; t += 2) {
            const bool last = (t == nt - 2);
            const unsigned a1 = cA + (unsigned)(t + 1) * kstep;
            const unsigned a2 = last ? nA : cA + (unsigned)(t + 2) * kstep, b2 = last ? nB : cB + (unsigned)(t + 2) * kstep;
            const unsigned a3 = a2 + kstep, b3 = b2 + kstep;
            if (last && has_next) S.a_ready(nxt);
            if constexpr (SP2) {
            PG8_LDB(B0, 0, 0); PG8_LDB(B1, 0, 1); PG8_SCHED; PG8_LDA(At, 0, 0); PG8_STAGE(PG8_SA(1, 1), a1 + hA, voffA);
            PG8_WAIT_V(8); PG8_WAIT_L(0); PG8_BAR; PG8_MMA(0, 0, At, B0); PG8_MMA(0, 1, At, B1); PG8_BAR; PG8_SCHED;
            PG8_LDA(At, 0, 1); PG8_STAGE(PG8_SB(0, 0), b2, voffB); PG8_STAGE(PG8_SB(0, 1), b2 + hB, voffB); PG8_STAGE(PG8_SA(0, 0), a2, voffA);
            PG8_WAIT_V(8); PG8_WAIT_L(0); PG8_BAR; PG8_MMA(1, 0, At, B0); PG8_MMA(1, 1, At, B1); PG8_BAR; PG8_SCHED;
            PG8_LDB(B0, 1, 0); PG8_LDB(B1, 1, 1); PG8_SCHED; PG8_LDA(At, 1, 0); PG8_STAGE(PG8_SA(0, 1), a2 + hA, voffA);
            PG8_WAIT_V(8); PG8_WAIT_L(0); PG8_BAR; PG8_MMA(0, 0, At, B0); PG8_MMA(0, 1, At, B1); PG8_BAR; PG8_SCHED;
            PG8_LDA(At, 1, 1); PG8_STAGE(PG8_SB(1, 0), b3, voffB); PG8_STAGE(PG8_SB(1, 1), b3 + hB, voffB); PG8_STAGE(PG8_SA(1, 0), a3, voffA);
            PG8_WAIT_V(8); PG8_WAIT_L(0); PG8_BAR; PG8_MMA(1, 0, At, B0); PG8_MMA(1, 1, At, B1); PG8_BAR; PG8_SCHED;
            } else {
            PG8_LDB(B0, 0, 0); PG8_SCHED; PG8_LDA(At, 0, 0); PG8_STAGE(PG8_SA(1, 1), a1 + hA, voffA);
            PG8_WAIT_L(8); PG8_BAR; PG8_WAIT_L(0); PG8_MMA(0, 0, At, B0); PG8_BAR; PG8_SCHED;
            PG8_LDB(B1, 0, 1); PG8_STAGE(PG8_SB(0, 0), b2, voffB);
            PG8_BAR; PG8_WAIT_L(0); PG8_MMA(0, 1, At, B1); PG8_BAR;
            PG8_LDA(At, 0, 1); PG8_STAGE(PG8_SA(0, 0), a2, voffA);
            PG8_BAR; PG8_WAIT_L(0); PG8_MMA(1, 0, At, B0); PG8_BAR; PG8_SCHED;
            PG8_STAGE(PG8_SB(0, 1), b2 + hB, voffB);
            PG8_WAIT_V(6); PG8_BAR; PG8_MMA(1, 1, At, B1); PG8_BAR;
            PG8_LDB(B0, 1, 0); PG8_SCHED; PG8_LDA(At, 1, 0); PG8_STAGE(PG8_SA(0, 1), a2 + hA, voffA);
            PG8_WAIT_L(8); PG8_BAR; PG8_WAIT_L(0); PG8_MMA(0, 0, At, B0); PG8_BAR; PG8_SCHED;
            PG8_LDB(B1, 1, 1); PG8_STAGE(PG8_SB(1, 0), b3, voffB);
            PG8_BAR; PG8_WAIT_L(0); PG8_MMA(0, 1, At, B1); PG8_BAR;
            PG8_LDA(At, 1, 1); PG8_STAGE(PG8_SA(1, 0), a3, voffA);
            PG8_BAR; PG8_WAIT_L(0); PG8_MMA(1, 0, At, B0); PG8_BAR; PG8_SCHED;
            PG8_STAGE(PG8_SB(1, 1), b3 + hB, voffB);
            PG8_WAIT_V(6); PG8_BAR; PG8_MMA(1, 1, At, B1); PG8_BAR;
            }
        }
        if constexpr (ALIGN_EPI) { if (wr == 0) PG8_BAR; }
        if constexpr (FP8) asm volatile("s_nop 15\n\ts_nop 15" ::: "memory");
        E(acc, cur, wr, wc, fr, fq); S.done(cur);
        if (!has_next) break;
        if constexpr (!Epi::CARRY) {
#pragma unroll
        for (int a = 0; a < 2; ++a)
#pragma unroll
            for (int b = 0; b < 2; ++b)
#pragma unroll
                for (int m = 0; m < 4; ++m)
#pragma unroll
                    for (int n = 0; n < 2; ++n) acc[a][b][m][n] = (f32x4){0.f, 0.f, 0.f, 0.f};
        }
        cur = nxt; cA = nA; cB = nB; ++ui;
        if constexpr (ALIGN_EPI) { if (wr == 1) PG8_BAR; }
    }
    PG8_WAIT_V(0);
    if constexpr (!ALIGN_EPI) { if (wr == 0) PG8_BAR; }
    PG8_BAR;
#undef PG8_SA
#undef PG8_SB
#undef PG8_STAGE
#undef PG8_LDA
#undef PG8_LDB
#undef PG8_MMA
#undef PG8_WAIT_V
#undef PG8_WAIT_L
#undef PG8_BAR
#undef PG8_SCHED
}

__device__ __forceinline__ u32x4 pack8(const f32x4 a, const f32x4 b) { u32x4 w; w.x = cvt_pk_bf16(a[0], a[1]); w.y = cvt_pk_bf16(a[2], a[3]); w.z = cvt_pk_bf16(b[0], b[1]); w.w = cvt_pk_bf16(b[2], b[3]); return w; }

struct EpiSwiGLU {
    static constexpr bool PERM = true, CARRY = false, FP8 = false;
    bf16* O; int ldo;
    __device__ __forceinline__ void operator()(const f32x4 (&acc)[2][2][4][2], const Unit& u, int wr, int wc, int fr, int fq) const {
        const int row0 = u.pm * BM + wr * 64 + fr, col0 = u.pn * 128 + wc * 32 + 8 * fq;
#pragma unroll
        for (int ai = 0; ai < 2; ++ai)
#pragma unroll
            for (int m = 0; m < 4; ++m) {
                f32x4 v0, v1;
#pragma unroll
                for (int e = 0; e < 4; ++e) { v0[e] = silu_f(acc[ai][0][m][0][e]) * acc[ai][1][m][0][e]; v1[e] = silu_f(acc[ai][0][m][1][e]) * acc[ai][1][m][1][e]; }
                *(u32x4*)(O + (size_t)(row0 + ai * HALF + m * 16) * ldo + col0) = pack8(v0, v1);
            }
    }
};
struct EpiY {
    static constexpr bool PERM = true, CARRY = false, FP8 = false;
    bf16* Y; const float* modl; int gi; float cg;
    __device__ __forceinline__ void operator()(const f32x4 (&acc)[2][2][4][2], const Unit& u, int wr, int wc, int fr, int fq) const {
        const int row0 = u.pm * BM + wr * 64 + fr, col0 = u.pn * BM + wc * 32 + 8 * fq;
        const int s = u.pm < 32 ? 0 : (u.pm < 64 ? 1 : 2);
        const float* gate = modl + (size_t)(s * NMOD + gi) * D;
        f32x4 gv[2][2];
#pragma unroll
        for (int bj = 0; bj < 2; ++bj)
#pragma unroll
            for (int n = 0; n < 2; ++n) gv[bj][n] = *(const f32x4*)(gate + col0 + bj * HALF + 4 * n) * cg;
#pragma unroll
        for (int ai = 0; ai < 2; ++ai)
#pragma unroll
            for (int m = 0; m < 4; ++m) { bf16* rowp = Y + (size_t)(row0 + ai * HALF + m * 16) * D + col0;
#pragma unroll
                for (int bj = 0; bj < 2; ++bj) *(u32x4*)(rowp + bj * HALF) = pack8(gv[bj][0] * acc[ai][bj][m][0], gv[bj][1] * acc[ai][bj][m][1]); }
    }
};
template <bool FP8_> struct EpiIn {
    static constexpr bool PERM = true, CARRY = false, FP8 = FP8_;
    unsigned char* ws; const float* rope; int pn0; float ascale;
    __device__ __forceinline__ void operator()(const f32x4 (&acc)[2][2][4][2], const Unit& u0, int wr, int wc, int fr, int fq) const {
        Unit u; u.pm = u0.pm; u.pn = u0.pn + pn0;
        const int row0 = u.pm * BM + wr * 64 + fr;
        if (u.pn < 16) {
            const bool isq = u.pn < 8; const int head = 2 * (u.pn & 7) + (wc >> 1), rr = wc & 1, i0 = 8 * fq;
            const int colb = head * HD + rr * 64 + i0;
            const bool lat = u.pm < 64;
#pragma unroll
            for (int ai = 0; ai < 2; ++ai)
#pragma unroll
                for (int m = 0; m < 4; ++m) {
                    const int row = row0 + ai * HALF + m * 16;
                    const f32x4 a0 = acc[ai][0][m][0], a1 = acc[ai][0][m][1], b0 = acc[ai][1][m][0], b1 = acc[ai][1][m][1];
                    if (isq || !lat) { bf16* dst = (bf16*)(ws + (isq ? WS_QP : WS_KB)) + (size_t)row * AW + colb; *(u32x4*)dst = pack8(a0, a1); *(u32x4*)(dst + 32) = pack8(b0, b1); }
                    if (lat) {
                        const int t = row & (SEQ - 1), pos = rr ? (t & 63) : (t >> 6);
                        const float* cp = rope + pos * 32 + i0; const float* sp = cp + 128 * 32;
                        const f32x4 c0 = *(const f32x4*)cp, c1 = *(const f32x4*)(cp + 4), s0 = *(const f32x4*)sp, s1 = *(const f32x4*)(sp + 4);
                        const f32x4 o0 = a0 * c0 - b0 * s0, o1 = a1 * c1 - b1 * s1, p0 = a0 * s0 + b0 * c0, p1 = a1 * s1 + b1 * c1;
                        bf16* dst = (bf16*)(ws + (isq ? WS_QR : WS_KB)) + (size_t)row * AW + colb; *(u32x4*)dst = pack8(o0, o1); *(u32x4*)(dst + 32) = pack8(p0, p1);
                    }
                }
            return;
        }
        size_t boff; int ld, colt, act;
        if (u.pn < 24) { boff = WS_VB; ld = AW; colt = (u.pn - 16) * BM; act = 0; }
        else if (u.pn < 32) { boff = WS_ZB; ld = 2048; colt = (u.pn - 24) * BM; act = 1; }
        else if (u.pn < 36) { boff = WS_US; ld = SSW; colt = (u.pn - 32) * BM; act = 0; }
        else { boff = WS_GB; ld = 3 * D; colt = (u.pn - 36) * BM; act = 2; }
        bf16* base = (bf16*)(ws + boff);
        const int col0 = colt + wc * 32 + 8 * fq;
#pragma unroll
        for (int ai = 0; ai < 2; ++ai)
#pragma unroll
            for (int m = 0; m < 4; ++m) { bf16* rowp = base + (size_t)(row0 + ai * HALF + m * 16) * ld + col0;
#pragma unroll
                for (int bj = 0; bj < 2; ++bj) { f32x4 v0 = acc[ai][bj][m][0], v1 = acc[ai][bj][m][1];
                    if (act == 1) {
#pragma unroll
                        for (int e = 0; e < 4; ++e) { v0[e] = gelu_tanh_f(v0[e]); v1[e] = gelu_tanh_f(v1[e]); } }
                    else if (act == 2) {
#pragma unroll
                        for (int e = 0; e < 4; ++e) { v0[e] = fast_sigmoid(v0[e] * ascale); v1[e] = fast_sigmoid(v1[e] * ascale); } }
                    *(u32x4*)(rowp + bj * HALF) = pack8(v0, v1); } }
    }
};
__device__ __forceinline__ void unpack8(const u32x4 w, f32x4& a, f32x4& b) { a = (f32x4){bf_lo(w.x), bf_hi(w.x), bf_lo(w.y), bf_hi(w.y)}; b = (f32x4){bf_lo(w.z), bf_hi(w.z), bf_lo(w.w), bf_hi(w.w)}; }
struct EpiGLU {
    static constexpr bool PERM = true, CARRY = false, FP8 = false;
    const bf16* YS; bf16* O; const float* bias;
    __device__ __forceinline__ void operator()(const f32x4 (&acc)[2][2][4][2], const Unit& u, int wr, int wc, int fr, int fq) const {
        const int row0 = u.pm * BM + wr * 64 + fr, col0 = u.pn * BM + wc * 32 + 8 * fq;
        const f32x4 bv[2][2] = {{*(const f32x4*)(bias + col0), *(const f32x4*)(bias + col0 + 4)}, {*(const f32x4*)(bias + col0 + HALF), *(const f32x4*)(bias + col0 + HALF + 4)}};
        constexpr int PD = 7;
        u32x4 yr[PD + 1];
#define EG_ROW(s_) ((size_t)(row0 + ((s_) >> 3) * HALF + (((s_) >> 1) & 3) * 16))
#define EG_LOAD(s_) yr[(s_) % (PD + 1)] = *(const u32x4*)(YS + EG_ROW(s_) * SSW + col0 + ((s_) & 1) * HALF)
#pragma unroll
        for (int s = 0; s < PD; ++s) EG_LOAD(s);
#pragma unroll
        for (int s = 0; s < 16; ++s) {
            if (s + PD < 16) EG_LOAD(s + PD);
            const int ai = s >> 3, m = (s >> 1) & 3, bj = s & 1;
            f32x4 y0, y1; unpack8(yr[s % (PD + 1)], y0, y1);
            f32x4 v0 = acc[ai][bj][m][0] + bv[bj][0], v1 = acc[ai][bj][m][1] + bv[bj][1];
#pragma unroll
            for (int e = 0; e < 4; ++e) { v0[e] = y0[e] * fast_sigmoid(v0[e]); v1[e] = y1[e] * fast_sigmoid(v1[e]); }
            *(u32x4*)(O + EG_ROW(s) * D + col0 + bj * HALF) = pack8(v0, v1);
            asm volatile("" ::: "memory");
        }
#undef EG_LOAD
#undef EG_ROW
    }
};
#ifndef MERGE_PD
#define MERGE_PD 3
#endif
struct EpiMerge1 {
    static constexpr bool PERM = true, CARRY = true, FP8 = false;
    const bf16* GB; bf16* MG;
    __device__ __forceinline__ void operator()(f32x4 (&acc)[2][2][4][2], const Unit& u, int wr, int wc, int fr, int fq) const {
        const int row0 = u.pm * BM + wr * 64 + fr, col0 = u.pn * BM + wc * 32 + 8 * fq;
        const bool fin = u.seg == 2;
        const int noff = u.seg * D;
        const float keep = fin ? 0.f : 1.f;
        constexpr int PD = MERGE_PD;
        u32x4 nwr[PD + 1], dwr[PD + 1];
#define EM_ROW(s_) ((size_t)(row0 + ((s_) >> 3) * HALF + (((s_) >> 1) & 3) * 16))
#define EM_LOAD(s_) do { const bf16* gp_ = GB + EM_ROW(s_) * (3 * D) + noff + col0 + ((s_) & 1) * HALF; nwr[(s_) % (PD + 1)] = *(const u32x4*)gp_; dwr[(s_) % (PD + 1)] = *(const u32x4*)(gp_ + (fin ? 0 : D)); } while (0)
#pragma unroll
        for (int s = 0; s < PD; ++s) EM_LOAD(s);
#pragma unroll
        for (int s = 0; s < 16; ++s) {
            if (s + PD < 16) EM_LOAD(s + PD);
            const int ai = s >> 3, m = (s >> 1) & 3, bj = s & 1;
            f32x4 n0, n1, d0, d1; unpack8(nwr[s % (PD + 1)], n0, n1); unpack8(dwr[s % (PD + 1)], d0, d1);
            f32x4 r0, r1;
#pragma unroll
            for (int e = 0; e < 4; ++e) { const float q0 = __builtin_amdgcn_rcpf(fmaxf(d0[e], 1e-30f)), q1 = __builtin_amdgcn_rcpf(fmaxf(d1[e], 1e-30f));
                r0[e] = fmaxf(n0[e], 1e-30f) * (fin ? 1.0f : q0); r1[e] = fmaxf(n1[e], 1e-30f) * (fin ? 1.0f : q1); }
            const f32x4 v0 = acc[ai][bj][m][0] * r0, v1 = acc[ai][bj][m][1] * r1;
            if (fin) *(u32x4*)(MG + EM_ROW(s) * D + col0 + bj * HALF) = pack8(v0, v1);
            acc[ai][bj][m][0] = v0 * keep; acc[ai][bj][m][1] = v1 * keep;
            asm volatile("" : "+v"(acc[ai][bj][m][0]), "+v"(acc[ai][bj][m][1]) :: "memory");
        }
#undef EM_LOAD
#undef EM_ROW
    }
};
}
using pg8::unpack8; using pg8::pack8;

#define XB_TMO      128
#define XB_XCNT(j)  (256  + 64 * (j))
#define XB_XSUB(j)  (1280 + 64 * (j))
#define XB_XGEN(j)  (2304 + 64 * (j))
#define XB_TOP      3328
#define XB_TOPGEN   3392
#define XCD_BAR_WORDS 3456
#define XB_SPIN_CAP (1u << 18)
__device__ __forceinline__ unsigned xb_ld(unsigned* p)              { return __hip_atomic_load(p, __ATOMIC_RELAXED, __HIP_MEMORY_SCOPE_AGENT); }
__device__ __forceinline__ unsigned xb_add(unsigned* p, unsigned v) { return __hip_atomic_fetch_add(p, v, __ATOMIC_RELAXED, __HIP_MEMORY_SCOPE_AGENT); }
__device__ __forceinline__ unsigned xb_xcc_id() { return (unsigned)__builtin_amdgcn_s_getreg((3 << 11) | 20) & 0xFu; }
#define XB_SPIN(cond, bar) do { unsigned _sp = 0; while (cond) { __builtin_amdgcn_s_sleep(1); \
    if ((++_sp & 255u) == 0u) { if (xb_ld(&(bar)[XB_TMO])) break; if (_sp > XB_SPIN_CAP) { atomicAdd(&(bar)[XB_TMO], 1u); break; } } } } while (0)
struct XcdBarrier { unsigned* bar; unsigned x; volatile LAS unsigned* st; };
__device__ __forceinline__ XcdBarrier xcd_barrier_post(unsigned* bar, volatile LAS unsigned* st) {
    XcdBarrier b; b.bar = bar; b.x = xb_xcc_id(); b.st = st;
    if (threadIdx.x == 0) (void)xb_add(&bar[XB_XCNT(b.x)], 1u);
    return b;
}
__device__ __forceinline__ void xcd_barrier_complete(unsigned* bar, unsigned x, unsigned& nloc, unsigned& nx) {
    const unsigned G = gridDim.x * gridDim.y * gridDim.z;
    unsigned sum, cnt, mine, sp = 0u;
    for (;;) {
        sum = 0u; cnt = 0u; mine = 0u;
#pragma unroll
        for (unsigned j = 0; j < 16; ++j) { const unsigned c = xb_ld(&bar[XB_XCNT(j)]); sum += c; cnt += (c > 0u) ? 1u : 0u; mine = (j == x) ? c : mine; }
        if (sum == G) break;
        __builtin_amdgcn_s_sleep(1);
        if ((++sp & 255u) == 0u) { if (xb_ld(&bar[XB_TMO])) break; if (sp > XB_SPIN_CAP) { atomicAdd(&bar[XB_TMO], 1u); break; } }
    }
    nloc = mine > 0u ? mine : 1u; nx = cnt > 0u ? cnt : 1u;
}
__device__ __forceinline__ void xcd_barrier(const XcdBarrier& b) {
    asm volatile("s_waitcnt vmcnt(0)" ::: "memory");
    __syncthreads();
    if (threadIdx.x == 0) {
        unsigned* bar = b.bar;
        __builtin_amdgcn_s_waitcnt(0);
        unsigned nloc = b.st[0], nx = b.st[1];
        if (nloc == 0u) { xcd_barrier_complete(bar, b.x, nloc, nx); b.st[0] = nloc; b.st[1] = nx; }
        const unsigned old = xb_add(&bar[XB_XSUB(b.x)], 1u);
        const unsigned gen = old / nloc;
        if (old + 1u == (gen + 1u) * nloc) {
            __builtin_amdgcn_fence(__ATOMIC_RELEASE, "agent");
            asm volatile("s_waitcnt vmcnt(0)" ::: "memory");
            const unsigned og = xb_add(&bar[XB_TOP], 1u);
            const unsigned tg = og / nx;
            if (og + 1u == (tg + 1u) * nx) xb_add(&bar[XB_TOPGEN], 1u);
            else XB_SPIN(xb_ld(&bar[XB_TOPGEN]) == tg, bar);
            __builtin_amdgcn_fence(__ATOMIC_ACQUIRE, "agent");
            xb_add(&bar[XB_XGEN(b.x)], 1u);
            asm volatile("s_waitcnt vmcnt(0)" ::: "memory");
        } else {
            XB_SPIN(xb_ld(&bar[XB_XGEN(b.x)]) == gen, bar);
            __builtin_amdgcn_fence(__ATOMIC_ACQUIRE, "agent");
            asm volatile("s_waitcnt vmcnt(0)" ::: "memory");
        }
    }
    __syncthreads();
}

__device__ __forceinline__ float wave_sum(float v) {
#pragma unroll
    for (int o = 1; o < 64; o <<= 1) v += __shfl_xor(v, o);
    return v;
}
#define MFMA32(a, b, c) __builtin_amdgcn_mfma_f32_32x32x16_bf16((a), (b), (c), 0, 0, 0)
#define MFMA16(a, b, c) __builtin_amdgcn_mfma_f32_16x16x32_bf16((a), (b), (c), 0, 0, 0)
#define PACK_STEP(dst, x, s) do { u32x4 _p; asm volatile("v_cvt_pk_bf16_f32 %0, %4, %5\n\tv_cvt_pk_bf16_f32 %1, %6, %7\n\tv_cvt_pk_bf16_f32 %2, %8, %9\n\tv_cvt_pk_bf16_f32 %3, %10, %11\n\ts_nop 1" \
        : "=&v"(_p[0]), "=&v"(_p[1]), "=&v"(_p[2]), "=&v"(_p[3]) \
        : "v"(x[8 * (s)]), "v"(x[8 * (s) + 1]), "v"(x[8 * (s) + 2]), "v"(x[8 * (s) + 3]), "v"(x[8 * (s) + 4]), "v"(x[8 * (s) + 5]), "v"(x[8 * (s) + 6]), "v"(x[8 * (s) + 7])); \
        dst = __builtin_bit_cast(bf16x8, _p); } while (0)
template <int OFF_LO, int OFF_HI> __device__ __forceinline__ bf16x8 tr_read2(unsigned base) {
    s16x4 lo, hi;
    asm volatile("ds_read_b64_tr_b16 %0, %2 offset:%3\n\tds_read_b64_tr_b16 %1, %2 offset:%4\n\ts_waitcnt lgkmcnt(0)" : "=&v"(lo), "=&v"(hi) : "v"(base), "i"(OFF_LO), "i"(OFF_HI) : "memory");
    return __builtin_shufflevector(lo, hi, 0, 1, 2, 3, 4, 5, 6, 7);
}
__device__ __forceinline__ unsigned lds_addr(LAS unsigned char* p) { return (unsigned)(__UINTPTR_TYPE__)p; }

__device__ __forceinline__ void transpose_item(const float* W, int N, bf16* WT, int ldt, int k0, int src_n0, int dst_n0, LAS float* scr, int lane) {
#pragma unroll
    for (int i = 0; i < 32; ++i) { const int kk = 2 * i + (lane >> 5); scr[kk * 33 + (lane & 31)] = __builtin_nontemporal_load(W + (size_t)(k0 + kk) * N + src_n0 + (lane & 31)); }
    LDS_WAIT();
    const int c = lane & 7;
#pragma unroll
    for (int j = 0; j < 4; ++j) { const int n = (lane >> 3) + 8 * j; const LAS float* s = scr + (8 * c) * 33 + n;
        u32x4 o; o.x = cvt_pk_bf16(s[0 * 33], s[1 * 33]); o.y = cvt_pk_bf16(s[2 * 33], s[3 * 33]); o.z = cvt_pk_bf16(s[4 * 33], s[5 * 33]); o.w = cvt_pk_bf16(s[6 * 33], s[7 * 33]);
        *(u32x4*)(WT + (size_t)(dst_n0 + n) * ldt + k0 + 8 * c) = o; }
    LDS_WAIT();
}
__device__ __forceinline__ void transpose_item_fp8(const float* W, int N, unsigned char* WT8, int ldt, int k0, int src_n0, int dst_n0, LAS float* scr, int lane) {
#pragma unroll
    for (int i = 0; i < 32; ++i) { const int kk = 2 * i + (lane >> 5); scr[kk * 33 + (lane & 31)] = __builtin_nontemporal_load(W + (size_t)(k0 + kk) * N + src_n0 + (lane & 31)); }
    LDS_WAIT();
    const int c = lane & 7;
#pragma unroll
    for (int j = 0; j < 4; ++j) { const int n = (lane >> 3) + 8 * j; const LAS float* s = scr + (8 * c) * 33 + n;
        float e[8];
#pragma unroll
        for (int q = 0; q < 8; ++q) e[q] = fminf(fmaxf(s[q * 33] * 2048.f, -448.f), 448.f);
        int w0 = __builtin_amdgcn_cvt_pk_fp8_f32(e[0], e[1], 0, false); w0 = __builtin_amdgcn_cvt_pk_fp8_f32(e[2], e[3], w0, true);
        int w1 = __builtin_amdgcn_cvt_pk_fp8_f32(e[4], e[5], 0, false); w1 = __builtin_amdgcn_cvt_pk_fp8_f32(e[6], e[7], w1, true);
        *(u32x2*)(WT8 + (size_t)(dst_n0 + n) * ldt + k0 + 8 * c) = (u32x2){(unsigned)w0, (unsigned)w1}; }
    LDS_WAIT();
}
__device__ __forceinline__ int src_block(int mode, int nb) {
    if (mode == 1) { const int pn = nb >> 3, wb = nb & 7, bj = wb >> 2, jb = wb & 3; return bj * 192 + 4 * pn + jb; }
    if (mode == 2 && nb < 128) { const int tile = nb >> 3, wb = nb & 7, bj = wb >> 2, hh = (wb & 3) >> 1, rr = wb & 1; const int base = tile < 8 ? 0 : AW, head = 2 * (tile & 7) + hh; return (base + head * HD + rr * 64 + 32 * bj) >> 5; }
    return nb;
}
__device__ __forceinline__ void transpose_matrix_items(const float* W, int K, int N, bf16* WT, int ldt, int mode, int it, LAS float* scr, int lane, unsigned char* WT8 = nullptr) {
    const int nblk = N / 32, kb = it / nblk, nb = it % nblk;
    if (mode == 2 && nb >= 288) { transpose_item_fp8(W, N, WT8, K, 64 * kb, 32 * nb, 32 * (nb - 288), scr, lane); return; }
    transpose_item(W, N, WT, ldt, 64 * kb, 32 * src_block(mode, nb), 32 * nb, scr, lane);
}

struct Args { const float* in[32]; float* out; unsigned char* ws; int ph_lo, ph_hi; };

__device__ __forceinline__ void p0_tables(const Args& args, int gtid, int gthreads) {
    unsigned char* ws = args.ws;
    float* rope = (float*)(ws + WS_ROPE);
    for (int i = gtid; i < 128 * 32; i += gthreads) { const int pos = i >> 5, j = i & 31; const float inv = exp2f(-(float)j * (13.287712379549449f / 32.0f)); const float ang = (float)pos * inv; rope[i] = cosf(ang); rope[128 * 32 + i] = sinf(ang); }
    const float *lam_re = as_global(args.in[18]), *lam_im = as_global(args.in[19]), *log_dt = as_global(args.in[20]), *b_re = as_global(args.in[21]), *b_im = as_global(args.in[22]), *c_re = as_global(args.in[23]), *c_im = as_global(args.in[24]);
    f32x4* SA = (f32x4*)(ws + WS_SA); bf16* SBB = (bf16*)(ws + WS_SBB); bf16* SC = (bf16*)(ws + WS_SC);
    for (int i = gtid; i < DEPTH * 2 * NG * NP; i += gthreads) {
        const int p = i & 63, ldg = i >> 6;
        const float dt = expf(log_dt[ldg]), lr = lam_re[i], li = lam_im[i];
        const float x = lr * dt, y = li * dt, mag = expf(x), cs = cosf(y), sn = sinf(y), sh = sinf(0.5f * y);
        const float ar = mag * cs, ai = mag * sn, re1 = expm1f(x) * cs - 2.0f * sh * sh, den = lr * lr + li * li;
        const float fr = (re1 * lr + ai * li) / den, fi = (ai * lr - re1 * li) / den;
        float tr = ar, ti = ai;
#pragma unroll
        for (int q = 0; q < 7; ++q) { const float nr = tr * tr - ti * ti, ni = 2.0f * tr * ti; tr = nr; ti = ni; }
        SA[i] = (f32x4){ar, ai, tr, ti};
        { bf16* o_re = SBB + ((size_t)ldg * 128 + p) * SG; bf16* o_im = o_re + 64 * SG;
#pragma unroll
          for (int ch = 0; ch < SG; ch += 2) { const float br0 = b_re[(size_t)i * SG + ch], bi0 = b_im[(size_t)i * SG + ch], br1 = b_re[(size_t)i * SG + ch + 1], bi1 = b_im[(size_t)i * SG + ch + 1];
              *(unsigned*)(o_re + ch) = cvt_pk_bf16(fr * br0 - fi * bi0, fr * br1 - fi * bi1); *(unsigned*)(o_im + ch) = cvt_pk_bf16(fr * bi0 + fi * br0, fr * bi1 + fi * br1); } }
#pragma unroll
        for (int ch = 0; ch < SG; ++ch) { const size_t ci = ((size_t)ldg * SG + ch) * NP + p; const size_t o = ((size_t)ldg * SG + ch) * 128;
            SC[o + p] = (bf16)(cvt_pk_bf16(c_re[ci], 0.f) & 0xffffu); SC[o + 64 + p] = (bf16)(cvt_pk_bf16(-c_im[ci], 0.f) & 0xffffu); }
    }
    const float* gws = as_global(args.in[16]); bf16* GWS = (bf16*)(ws + WS_GWS);
    for (int i = gtid; i < DEPTH * 8 * 128 * 128 / 2; i += gthreads) ((unsigned*)GWS)[i] = cvt_pk_bf16(gws[2 * i], gws[2 * i + 1]);
}

__device__ __forceinline__ void p0_mod(const Args& args, LAS unsigned char* lds, int wid, int lane, int tid, int G, int bx) {
    LAS float* sv = (LAS float*)lds;
    LAS float* red = (LAS float*)(lds + 49152);
    const float *c = as_global(args.in[1]), *cctx = as_global(args.in[3]);
    for (int i = tid; i < 3 * D; i += 512) { const float v = i < 2 * D ? c[i] : cctx[i - 2 * D]; sv[i] = silu_f(v); }
    __syncthreads();
    float* modv = (float*)(args.ws + WS_MOD);
    constexpr int NCB = NMODC / 256;
    for (int u = bx; u < DEPTH * NCB; u += G) {
        const int l = u / NCB, cb = u % NCB;
        const float* W = as_global(args.in[4]) + (size_t)l * D * NMODC + (size_t)cb * 256 + 4 * lane;
        f32x4 a0 = {0.f, 0.f, 0.f, 0.f}, a1 = a0, a2 = a0;
        const int kbeg = wid * 512;
        for (int k = kbeg; k < kbeg + 512; k += 8) {
            f32x4 w[8];
#pragma unroll
            for (int i = 0; i < 8; ++i) w[i] = __builtin_nontemporal_load((const f32x4*)(W + (size_t)(k + i) * NMODC));
#pragma unroll
            for (int i = 0; i < 8; ++i) { a0 += w[i] * sv[k + i]; a1 += w[i] * sv[D + k + i]; a2 += w[i] * sv[2 * D + k + i]; }
        }
        *(LAS f32x4*)(red + (wid * 3 + 0) * 256 + 4 * lane) = a0; *(LAS f32x4*)(red + (wid * 3 + 1) * 256 + 4 * lane) = a1; *(LAS f32x4*)(red + (wid * 3 + 2) * 256 + 4 * lane) = a2;
        __syncthreads();
        for (int o = tid; o < 768; o += 512) { const int s = o >> 8, cc = o & 255; float sum = 0.f;
#pragma unroll
            for (int w8 = 0; w8 < 8; ++w8) sum += red[(w8 * 3 + s) * 256 + cc];
            modv[(size_t)(l * 3 + s) * NMODC + cb * 256 + cc] = sum + as_global(args.in[5])[(size_t)l * NMODC + cb * 256 + cc]; }
        __syncthreads();
    }
}

__device__ __forceinline__ void p0_item_finish(const f32x4 (&rg)[32], unsigned char* dst, int ldt, bool f8, LAS unsigned char* scrb, int lane) {
    const int r8 = lane >> 3, ch = lane & 7;
#pragma unroll
    for (int p = 0; p < 16; ++p) { const int k = 16 * p + 2 * r8;
#pragma unroll
        for (int e = 0; e < 4; ++e) *(LAS unsigned*)(scrb + (4 * ch + e) * 512 + ((((k >> 3) ^ ch) & 31) << 4) + (k & 7) * 2) = cvt_pk_bf16(rg[2 * p][e], rg[2 * p + 1][e]); }
    LDS_WAIT();
    const int c = lane & 31;
#pragma unroll
    for (int j = 0; j < 16; ++j) { const int n = (lane >> 5) + 2 * j; const u32x4 o = *(const LAS u32x4*)(scrb + n * 512 + (((c ^ (n >> 2)) & 31) << 4));
        if (f8) {
            float e[8] = {bf_lo(o.x), bf_hi(o.x), bf_lo(o.y), bf_hi(o.y), bf_lo(o.z), bf_hi(o.z), bf_lo(o.w), bf_hi(o.w)};
#pragma unroll
            for (int q = 0; q < 8; ++q) e[q] = fminf(fmaxf(e[q] * 2048.f, -448.f), 448.f);
            int w0 = __builtin_amdgcn_cvt_pk_fp8_f32(e[0], e[1], 0, false); w0 = __builtin_amdgcn_cvt_pk_fp8_f32(e[2], e[3], w0, true);
            int w1 = __builtin_amdgcn_cvt_pk_fp8_f32(e[4], e[5], 0, false); w1 = __builtin_amdgcn_cvt_pk_fp8_f32(e[6], e[7], w1, true);
            __builtin_nontemporal_store((u32x2){(unsigned)w0, (unsigned)w1}, (u32x2*)(dst + (size_t)n * ldt + 8 * c));
        } else __builtin_nontemporal_store(o, (u32x4*)(dst + ((size_t)n * ldt + 8 * c) * 2)); }
    LDS_WAIT();
}
__device__ __forceinline__ void p0_weights(const Args& args, LAS unsigned char* lds, int wid, int lane, int G, int bx) {
    LAS unsigned char* scr = lds + wid * 16384;
    const int gw = bx * 8 + wid, NGW = G * 8;
    constexpr int I_FI = (D / 256) * (2 * DFF / 32), I_FO = (DFF / 256) * (D / 32), I_IN = (D / 256) * (NIN / 32), I_GL = (SSW / 256) * (SSW / 32), I_PA = (GMW / 256) * (D / 32), I_PB = (AW / 256) * (D / 32), I_PC = (SSW / 256) * (D / 32), I_O = (D / 256) * (D / 32);
    constexpr int PER_L = 2 * I_FI + 2 * I_FO + I_IN + I_GL + I_PA + I_PB + I_PC + I_O;
    constexpr int TOTAL = DEPTH * PER_L, MODU = (D * 256 * 4) / (48 * 1024) / 8;
    const int nheavy = (DEPTH * (NMODC / 256) > G && DEPTH * (NMODC / 256) < 2 * G) ? DEPTH * (NMODC / 256) - G : 0;
    const int X = nheavy > 0 && TOTAL > MODU * 8 * (G - nheavy) ? TOTAL - MODU * 8 * (G - nheavy) : TOTAL;
    const int c0 = gw < X ? (X - gw + NGW - 1) / NGW : 0;
    const int st1 = (G - nheavy) * 8, i1 = X + (bx - nheavy) * 8 + wid;
    const int c1 = (bx >= nheavy && i1 < TOTAL) ? (TOTAL - i1 + st1 - 1) / st1 : 0;
    const int cnt = c0 + c1;
    if (cnt == 0) return;
#define P0_ITEM(k_) ((k_) < c0 ? gw + (k_) * NGW : i1 + ((k_) - c0) * st1)
#define P0_DECODE(it_, SRC, NN, DST, LDT, F8) do { const int l_ = (it_) / PER_L; int r_ = (it_) % PER_L; unsigned char* wl_ = args.ws + WS_W + (size_t)l_ * LW_BYTES; \
        const float* W_; int K_, N_, md_; unsigned char* T_; int lt_; \
        if (r_ < I_FI) { W_ = as_global(args.in[8]) + (size_t)l_ * D * 2 * DFF; K_ = D; N_ = 2 * DFF; T_ = wl_ + LW_W1IN; lt_ = D; md_ = 1; } \
        else if ((r_ -= I_FI) < I_FO) { W_ = as_global(args.in[9]) + (size_t)l_ * DFF * D; K_ = DFF; N_ = D; T_ = wl_ + LW_W1OUT; lt_ = DFF; md_ = 0; } \
        else if ((r_ -= I_FO) < I_FI) { W_ = as_global(args.in[10]) + (size_t)l_ * D * 2 * DFF; K_ = D; N_ = 2 * DFF; T_ = wl_ + LW_W2IN; lt_ = D; md_ = 1; } \
        else if ((r_ -= I_FI) < I_FO) { W_ = as_global(args.in[11]) + (size_t)l_ * DFF * D; K_ = DFF; N_ = D; T_ = wl_ + LW_W2OUT; lt_ = DFF; md_ = 0; } \
        else if ((r_ -= I_FO) < I_IN) { W_ = as_global(args.in[12]) + (size_t)l_ * D * NIN; K_ = D; N_ = NIN; T_ = wl_ + LW_WIN; lt_ = D; md_ = 2; } \
        else if ((r_ -= I_IN) < I_GL) { W_ = as_global(args.in[26]) + (size_t)l_ * SSW * SSW; K_ = SSW; N_ = SSW; T_ = wl_ + LW_WGLU; lt_ = SSW; md_ = 0; } \
        else if ((r_ -= I_GL) < I_PA) { W_ = as_global(args.in[28]) + (size_t)l_ * GMW * D; K_ = GMW; N_ = D; T_ = wl_ + LW_WCAT; lt_ = D; md_ = 0; } \
        else if ((r_ -= I_PA) < I_PB) { W_ = as_global(args.in[29]) + (size_t)l_ * AW * D; K_ = AW; N_ = D; T_ = wl_ + LW_WCAT + 2 * GMW; lt_ = D; md_ = 0; } \
        else if ((r_ -= I_PB) < I_PC) { W_ = as_global(args.in[30]) + (size_t)l_ * SSW * D; K_ = SSW; N_ = D; T_ = wl_ + LW_WCAT + 2 * (GMW + AW); lt_ = D; md_ = 0; } \
        else { r_ -= I_PC; W_ = as_global(args.in[31]) + (size_t)l_ * D * D; K_ = D; N_ = D; T_ = wl_ + LW_WO; lt_ = D; md_ = 0; } \
        const int nblk_ = N_ / 32, kb_ = r_ / nblk_, nb_ = r_ % nblk_; NN = N_; \
        if (md_ == 2 && nb_ >= 288) { F8 = true; SRC = W_ + (size_t)(256 * kb_) * N_ + 32 * nb_; DST = wl_ + LW_W8 + (size_t)(32 * (nb_ - 288)) * K_ + 256 * kb_; LDT = K_; }     \
        else { F8 = false; SRC = W_ + (size_t)(256 * kb_) * N_ + 32 * src_block(md_, nb_); DST = T_ + ((size_t)(32 * nb_) * lt_ + 256 * kb_) * 2; LDT = lt_; } } while (0)
#define P0_LOAD(RG, SRC, NN) do { _Pragma("unroll") for (int i = 0; i < 32; ++i) RG[i] = __builtin_nontemporal_load((const f32x4*)((SRC) + (size_t)(16 * (i >> 1) + 2 * (lane >> 3) + (i & 1)) * (NN) + 4 * (lane & 7))); } while (0)
    f32x4 ra[32];
    for (int k = 0; k < cnt; ++k) {
        const float* srcA; int nnA, ldA; unsigned char* dstA; bool f8A;
        P0_DECODE(P0_ITEM(k), srcA, nnA, dstA, ldA, f8A);
        P0_LOAD(ra, srcA, nnA);
        p0_item_finish(ra, dstA, ldA, f8A, scr, lane);
    }
#undef P0_LOAD
#undef P0_DECODE
#undef P0_ITEM
}

__device__ __forceinline__ void thin_phase(int mode, const float* xin, const float* cin, float* X, const bf16* Y, const float* lng, const float* lnb, const float* modl, int sh_i, int sc_i, bf16* H, float* outp, int mrows, int gw, int NGW, int lane, LAS float* vl, int tid, unsigned char* H8 = nullptr, int row_lo = 0) {
    for (int i = tid; i < D / 4; i += 512) { const int c4 = 4 * i;
        if (mode != 0) { *(LAS f32x4*)(vl + c4) = *(const f32x4*)(lng + c4); *(LAS f32x4*)(vl + D + c4) = *(const f32x4*)(lnb + c4); }
        if (mode != 2) {
#pragma unroll
            for (int sx = 0; sx < 3; ++sx) { *(LAS f32x4*)(vl + (2 + sx) * D + c4) = *(const f32x4*)(modl + (size_t)(sx * NMOD + sh_i) * D + c4); *(LAS f32x4*)(vl + (5 + sx) * D + c4) = *(const f32x4*)(modl + (size_t)(sx * NMOD + sc_i) * D + c4) + 1.0f; } } }
    __syncthreads();
    if (row_lo + gw >= mrows) return;
    f32x4 v[16]; u32x2 y[16];
#define THIN_LOAD(dst, dsty, r) do { if (xin) { const float* src_ = (r) < ML ? xin + (size_t)(r) * D : cin + (size_t)((r) - ML) * D; \
        _Pragma("unroll") for (int j = 0; j < 16; ++j) dst[j] = __builtin_nontemporal_load((const f32x4*)(src_ + 256 * j + 4 * lane)); } \
        else { const unsigned* src_ = (const unsigned*)X + (size_t)(r) * (5 * D / 8); \
        _Pragma("unroll") for (int s_ = 0; s_ < 2; ++s_) { unsigned w_[20]; \
            _Pragma("unroll") for (int g = 0; g < 5; ++g) { const u32x4 t_ = __builtin_nontemporal_load((const u32x4*)(src_ + 256 * (5 * s_ + g) + 4 * lane)); w_[4 * g] = t_.x; w_[4 * g + 1] = t_.y; w_[4 * g + 2] = t_.z; w_[4 * g + 3] = t_.w; } \
            _Pragma("unroll") for (int p_ = 0; p_ < 4; ++p_) { const unsigned d0 = w_[5 * p_], d1 = w_[5 * p_ + 1], d2 = w_[5 * p_ + 2], d3 = w_[5 * p_ + 3], d4 = w_[5 * p_ + 4]; const int j0 = 8 * s_ + 2 * p_; \
                dst[j0][0] = __uint_as_float(d0 << 12); dst[j0][1] = __uint_as_float(__builtin_amdgcn_alignbit(d1, d0, 20) << 12); dst[j0][2] = __uint_as_float((d1 >> 8) << 12); dst[j0][3] = __uint_as_float(__builtin_amdgcn_alignbit(d2, d1, 28) << 12); \
                dst[j0 + 1][0] = __uint_as_float(__builtin_amdgcn_alignbit(d3, d2, 16) << 12); dst[j0 + 1][1] = __uint_as_float((d3 >> 4) << 12); dst[j0 + 1][2] = __uint_as_float(__builtin_amdgcn_alignbit(d4, d3, 24) << 12); dst[j0 + 1][3] = __uint_as_float(d4 & 0xfffff000u); } } } \
        if (mode != 0) { _Pragma("unroll") for (int j = 0; j < 16; ++j) dsty[j] = __builtin_nontemporal_load((const u32x2*)(Y + (size_t)(r) * D + 256 * j + 4 * lane)); } } while (0)
    for (int row = row_lo + gw; row < mrows; row += NGW) {
        THIN_LOAD(v, y, row);
        if (mode != 0) {
            float s = 0.f;
#pragma unroll
            for (int j = 0; j < 16; ++j) { v[j] = v[j] * ALPHA + (f32x4){bf_lo(y[j].x), bf_hi(y[j].x), bf_lo(y[j].y), bf_hi(y[j].y)}; s += (v[j][0] + v[j][1]) + (v[j][2] + v[j][3]); }
            const float mean = wave_sum(s) * (1.0f / D); float q = 0.f;
#pragma unroll
            for (int j = 0; j < 16; ++j) { v[j] = v[j] - mean; q += (v[j][0] * v[j][0] + v[j][1] * v[j][1]) + (v[j][2] * v[j][2] + v[j][3] * v[j][3]); }
            const float rstd = 1.0f / sqrtf(wave_sum(q) * (1.0f / D) + LN_EPS);
#pragma unroll
            for (int j = 0; j < 16; ++j) { const f32x4 g = *(const LAS f32x4*)(vl + 256 * j + 4 * lane), b = *(const LAS f32x4*)(vl + D + 256 * j + 4 * lane); v[j] = v[j] * rstd * g + b; }
            if (mode == 2) { float* dst = outp + (size_t)row * D;
#pragma unroll
                for (int j = 0; j < 16; ++j) __builtin_nontemporal_store(v[j], (f32x4*)(dst + 256 * j + 4 * lane)); }
            else { unsigned* dst = (unsigned*)X + (size_t)row * (5 * D / 8);
#pragma unroll
                for (int s_ = 0; s_ < 2; ++s_) { unsigned w_[20];
#pragma unroll
                    for (int p_ = 0; p_ < 4; ++p_) { const int j0 = 8 * s_ + 2 * p_; unsigned f[8];
#pragma unroll
                        for (int e = 0; e < 8; ++e) f[e] = (__float_as_uint(v[j0 + (e >> 2)][e & 3]) + 0x800u) >> 12;
                        w_[5 * p_] = f[0] | (f[1] << 20); w_[5 * p_ + 1] = (f[1] >> 12) | (f[2] << 8) | (f[3] << 28); w_[5 * p_ + 2] = (f[3] >> 4) | (f[4] << 16);
                        w_[5 * p_ + 3] = (f[4] >> 16) | (f[5] << 4) | (f[6] << 24); w_[5 * p_ + 4] = (f[6] >> 8) | (f[7] << 12); }
#pragma unroll
                    for (int g = 0; g < 5; ++g) { u32x4 t_; t_.x = w_[4 * g]; t_.y = w_[4 * g + 1]; t_.z = w_[4 * g + 2]; t_.w = w_[4 * g + 3]; __builtin_nontemporal_store(t_, (u32x4*)(dst + 256 * (5 * s_ + g) + 4 * lane)); } } }
        }
        if (mode != 2) {
            float s = 0.f;
#pragma unroll
            for (int j = 0; j < 16; ++j) s += (v[j][0] + v[j][1]) + (v[j][2] + v[j][3]);
            const float mean = wave_sum(s) * (1.0f / D); float q = 0.f;
#pragma unroll
            for (int j = 0; j < 16; ++j) { v[j] = v[j] - mean; q += (v[j][0] * v[j][0] + v[j][1] * v[j][1]) + (v[j][2] * v[j][2] + v[j][3] * v[j][3]); }
            const float rstd = 1.0f / sqrtf(wave_sum(q) * (1.0f / D) + LN_EPS);
            const int sidx = row < SEQ ? 0 : (row < ML ? 1 : 2);
            const LAS float* shp = vl + (2 + sidx) * D; const LAS float* scp = vl + (5 + sidx) * D;
#pragma unroll
            for (int j = 0; j < 16; ++j) { const f32x4 sh = *(const LAS f32x4*)(shp + 256 * j + 4 * lane), sc = *(const LAS f32x4*)(scp + 256 * j + 4 * lane);
                const f32x4 h = v[j] * rstd * sc + sh; u32x2 w; w.x = cvt_pk_bf16(h[0], h[1]); w.y = cvt_pk_bf16(h[2], h[3]);
                *(u32x2*)(H + (size_t)row * D + 256 * j + 4 * lane) = w;
                if (H8) { const f32x4 q = __builtin_elementwise_min(__builtin_elementwise_max(h * 8.f, (f32x4){-448.f, -448.f, -448.f, -448.f}), (f32x4){448.f, 448.f, 448.f, 448.f});
                    int w8 = __builtin_amdgcn_cvt_pk_fp8_f32(q[0], q[1], 0, false); w8 = __builtin_amdgcn_cvt_pk_fp8_f32(q[2], q[3], w8, true); *(unsigned*)(H8 + (size_t)row * D + 256 * j + 4 * lane) = (unsigned)w8; } }
        }
    }
#undef THIN_LOAD
}

constexpr int AT_KP = 272, AT_VP = 320, AT_VOFF = 64 * AT_KP, AT_BUF = AT_VOFF + 64 * AT_VP, AT_BOFF = 2 * AT_BUF + 256;
__device__ __forceinline__ int clampi(int v, int lo, int hi) { return v < lo ? lo : (v > hi ? hi : v); }
template <int OFF> __device__ __forceinline__ void tr_read_v4(unsigned base, bf16x8 (&f)[4]) {
    s16x4 l0, h0, l1, h1, l2, h2, l3, h3;
    asm volatile("ds_read_b64_tr_b16 %0, %8 offset:%9\n\tds_read_b64_tr_b16 %1, %8 offset:%10\n\tds_read_b64_tr_b16 %2, %8 offset:%11\n\tds_read_b64_tr_b16 %3, %8 offset:%12\n\t"
                 "ds_read_b64_tr_b16 %4, %8 offset:%13\n\tds_read_b64_tr_b16 %5, %8 offset:%14\n\tds_read_b64_tr_b16 %6, %8 offset:%15\n\tds_read_b64_tr_b16 %7, %8 offset:%16\n\ts_waitcnt lgkmcnt(0)"
                 : "=&v"(l0), "=&v"(h0), "=&v"(l1), "=&v"(h1), "=&v"(l2), "=&v"(h2), "=&v"(l3), "=&v"(h3)
                 : "v"(base), "i"(OFF), "i"(OFF + 8 * AT_VP), "i"(OFF + 64), "i"(OFF + 8 * AT_VP + 64), "i"(OFF + 128), "i"(OFF + 8 * AT_VP + 128), "i"(OFF + 192), "i"(OFF + 8 * AT_VP + 192) : "memory");
    f[0] = __builtin_shufflevector(l0, h0, 0, 1, 2, 3, 4, 5, 6, 7); f[1] = __builtin_shufflevector(l1, h1, 0, 1, 2, 3, 4, 5, 6, 7);
    f[2] = __builtin_shufflevector(l2, h2, 0, 1, 2, 3, 4, 5, 6, 7); f[3] = __builtin_shufflevector(l3, h3, 0, 1, 2, 3, 4, 5, 6, 7);
}
__device__ __forceinline__ void attn_unit(LAS unsigned char* lds, const bf16* QP, const bf16* QR, const bf16* KB, const bf16* VB, bf16* ACAT, const float* rpb_l, int b, int h, int r0, int tid, int wid, int lane) {
    const int hl = lane >> 5, l31 = lane & 31;
    const bool isctx = r0 < 0;
    const int r = isctx ? 0 : r0 + (wid >> 1), half = wid & 1;
    const int qrow = isctx ? ML + b * CTXL + 32 * wid + l31 : b * SEQ + r * 64 + 32 * half + l31;
    const int c = 32 * half + l31;
    int lo = 0, nloc = 0;
    if (!isctx) { lo = clampi(r0 - 4, 0, 120); nloc = clampi(r0 - 1, 0, 120) + 7 - lo + 1; }
    const int nt = nloc + 4, rs = clampi(r - 4, 0, 120);
    LAS float* bias = (LAS float*)(lds + AT_BOFF);
    const int skey = tid >> 3, spart = tid & 7;
    u32x4 kreg0, kreg1, vreg0, vreg1;
#define AT_GLOAD(it_) do { const int t_ = (it_); const size_t off = (size_t)((t_ < nloc ? b * SEQ + (lo + t_) * 64 : ML + b * CTXL + 64 * (t_ - nloc)) + skey) * AW + h * HD + 16 * spart; \
        kreg0 = *(const u32x4*)(KB + off); kreg1 = *(const u32x4*)(KB + off + 8); vreg0 = *(const u32x4*)(VB + off); vreg1 = *(const u32x4*)(VB + off + 8); } while (0)
#define AT_LWRITE(buf_) do { LAS unsigned char* kb_ = lds + (buf_) * AT_BUF; *(LAS u32x4*)(kb_ + skey * AT_KP + 32 * spart) = kreg0; *(LAS u32x4*)(kb_ + skey * AT_KP + 32 * spart + 16) = kreg1; \
        *(LAS u32x4*)(kb_ + AT_VOFF + skey * AT_VP + 32 * spart) = vreg0; *(LAS u32x4*)(kb_ + AT_VOFF + skey * AT_VP + 32 * spart + 16) = vreg1; } while (0)
    AT_GLOAD(0);
    bf16x8 qf[8];
    { const bf16* p2 = (isctx ? QP : QR) + (size_t)qrow * AW + h * HD + 8 * hl;
#pragma unroll
      for (int s = 0; s < 8; ++s) qf[s] = *(const bf16x8*)(p2 + 16 * s); }
    const float bias_w = tid < 15 * 31 ? rpb_l[h * 465 + tid] * LOG2E : 0.f;
    __syncthreads();
    if (tid < 15 * 31) bias[tid] = bias_w;
    AT_LWRITE(0);
    AT_GLOAD(1);
    {
#pragma unroll
      for (int s = 0; s < 8; ++s) asm volatile("" : "+v"(qf[s])); }
    f32x16 O[4];
#pragma unroll
    for (int cc = 0; cc < 4; ++cc)
#pragma unroll
        for (int i = 0; i < 16; ++i) O[cc][i] = 0.f;
    float mrun = -1e30f, lrun = 0.f;
    const float SC = 0.08838834764831845f * LOG2E;
    const int blk = (lane >> 4) & 1, q4 = (lane & 15) >> 2, p4 = lane & 3;
    const unsigned vtr0 = lds_addr(lds + AT_VOFF) + (unsigned)((4 * hl + q4) * AT_VP + 32 * blk + 8 * p4);
    __syncthreads();
    for (int it = 0; it < nt; ++it) {
        const int cur = it & 1;
        if (it + 1 < nt) { AT_LWRITE(cur ^ 1); if (it + 2 < nt) AT_GLOAD(it + 2); }
        const bool local = it < nloc; const int kr = lo + it;
        if (!(local && (kr < rs || kr > rs + 7))) {
            LAS unsigned char* kimg = lds + cur * AT_BUF;
            f32x16 s0, s1;
#pragma unroll
            for (int i = 0; i < 16; ++i) { s0[i] = 0.f; s1[i] = 0.f; }
            if (it == nloc && !isctx) {
                const bf16* p = QP + (size_t)qrow * AW + h * HD + 8 * hl;
#pragma unroll
                for (int s = 0; s < 8; ++s) qf[s] = *(const bf16x8*)(p + 16 * s);
#pragma unroll
                for (int s = 0; s < 8; ++s) asm volatile("" : "+v"(qf[s]));
            }
#pragma unroll
            for (int s = 0; s < 8; ++s) { const bf16x8 a0 = *(const LAS bf16x8*)(kimg + l31 * AT_KP + 32 * s + 16 * hl), a1 = *(const LAS bf16x8*)(kimg + (32 + l31) * AT_KP + 32 * s + 16 * hl);
                s0 = MFMA32(a0, qf[s], s0); s1 = MFMA32(a1, qf[s], s1); }
            float tmax = -INFINITY;
            if (local) {
                int cv = c; asm volatile("" : "+v"(cv));
                const int e0 = 4 * hl - clampi(cv - 8, 0, 48);
                const LAS float* bl = bias + ((kr - r + 7) * 31 + 4 * hl - cv + 15);
#pragma unroll
                for (int i = 0; i < 16; ++i) { const int ki = (i & 3) + 8 * (i >> 2);
                    const float x0 = s0[i] * SC + bl[ki], x1 = s1[i] * SC + bl[ki + 32];
                    s0[i] = ((unsigned)(ki + e0) < 16u) ? x0 : -INFINITY; s1[i] = ((unsigned)(ki + 32 + e0) < 16u) ? x1 : -INFINITY;
                    tmax = fmaxf(tmax, fmaxf(s0[i], s1[i])); }
            } else {
#pragma unroll
                for (int i = 0; i < 16; ++i) { s0[i] *= SC; s1[i] *= SC; tmax = fmaxf(tmax, fmaxf(s0[i], s1[i])); }
            }
            tmax = fmaxf(tmax, __shfl_xor(tmax, 32));
            const float mnew = fmaxf(mrun, tmax), alpha = __builtin_amdgcn_exp2f(mrun - mnew); mrun = mnew;
            float psum = 0.f;
#pragma unroll
            for (int i = 0; i < 16; ++i) { s0[i] = __builtin_amdgcn_exp2f(s0[i] - mnew); s1[i] = __builtin_amdgcn_exp2f(s1[i] - mnew); psum += s0[i] + s1[i]; }
            lrun = lrun * alpha + psum;
            if (!__all(alpha == 1.0f)) {
#pragma unroll
                for (int cc = 0; cc < 4; ++cc)
#pragma unroll
                    for (int i = 0; i < 16; ++i) O[cc][i] *= alpha;
            }
            const unsigned vtr = vtr0 + (unsigned)(cur * AT_BUF);
#define AT_PV(S16, SRC, ST) do { bf16x8 pf, vf[4]; PACK_STEP(pf, SRC, ST); tr_read_v4<16 * S16 * AT_VP>(vtr, vf); \
                O[0] = MFMA32(vf[0], pf, O[0]); O[1] = MFMA32(vf[1], pf, O[1]); O[2] = MFMA32(vf[2], pf, O[2]); O[3] = MFMA32(vf[3], pf, O[3]); } while (0)
            if (!(local && half == 1)) AT_PV(0, s0, 0);
            AT_PV(1, s0, 1); AT_PV(2, s1, 0);
            if (!(local && half == 0)) AT_PV(3, s1, 1);
#undef AT_PV
        }
        __syncthreads();
    }
#undef AT_GLOAD
#undef AT_LWRITE
    const float inv = 1.0f / (lrun + __shfl_xor(lrun, 32));
    bf16* orow = ACAT + (size_t)qrow * D + GMW + h * HD + 4 * hl;
#pragma unroll
    for (int cc = 0; cc < 4; ++cc)
#pragma unroll
        for (int g = 0; g < 4; ++g) { u32x2 w; w.x = cvt_pk_bf16(O[cc][4 * g] * inv, O[cc][4 * g + 1] * inv); w.y = cvt_pk_bf16(O[cc][4 * g + 2] * inv, O[cc][4 * g + 3] * inv);
            *(u32x2*)(orow + 32 * cc + 8 * g) = w; }
}

constexpr int GM_IMG = 128 * 96;
__device__ __forceinline__ void gmlp_unit(LAS unsigned char* lds, const bf16* ZB, bf16* ACAT, const float* lng, const float* lnb, const bf16* WSb, const float* bs, int unit, int tid, int wid, int lane) {
    const int chunk = unit >> 1, gh = unit & 1;
    const int hl = lane >> 5, l31 = lane & 31, row0 = 128 * chunk;
    LAS f32x2* stats = (LAS f32x2*)(lds + 8 * GM_IMG);
    __syncthreads();
    {
        u32x4 raw[16][2];
#pragma unroll
        for (int k = 0; k < 16; ++k) { const bf16* p = ZB + (size_t)(row0 + 16 * wid + k) * 2048 + 1024 + 8 * lane; raw[k][0] = *(const u32x4*)p; raw[k][1] = *(const u32x4*)(p + 512); }
#pragma unroll
        for (int k = 0; k < 16; ++k) {
            f32x4 v[4]; unpack8(raw[k][0], v[0], v[1]); unpack8(raw[k][1], v[2], v[3]);
            float s = 0.f;
#pragma unroll
            for (int j = 0; j < 4; ++j) s += (v[j][0] + v[j][1]) + (v[j][2] + v[j][3]);
            const float mean = wave_sum(s) * (1.0f / 1024.0f); float q = 0.f;
#pragma unroll
            for (int j = 0; j < 4; ++j) { const f32x4 d = v[j] - mean; q += (d[0] * d[0] + d[1] * d[1]) + (d[2] * d[2] + d[3] * d[3]); }
            const float rstd = 1.0f / sqrtf(wave_sum(q) * (1.0f / 1024.0f) + LN_EPS);
            if (lane == 0) stats[16 * wid + k] = (f32x2){mean, rstd};
        }
    }
    __syncthreads();
    const int g = 4 * gh + (wid & 3);
    LAS unsigned char* img = lds + wid * GM_IMG;
    const int blk = (lane >> 4) & 1, q4 = (lane & 15) >> 2, p4 = lane & 3;
    const unsigned itr = lds_addr(img) + (unsigned)((8 * hl + q4) * 96 + 32 * blk + 8 * p4);
    const bf16* wbase = WSb + ((size_t)(g * 128 + l31) * 128 + 8 * hl);
    for (int cbi = 0; cbi < 2; ++cbi) {
        const int cbase = 128 * g + 32 * (2 * (wid >> 2) + cbi);
        u32x4 vraw[2][4];
#pragma unroll
        for (int j2 = 0; j2 < 2; ++j2)
#pragma unroll
            for (int k4 = 0; k4 < 4; ++k4) vraw[j2][k4] = *(const u32x4*)(ZB + (size_t)(row0 + lane + 64 * j2) * 2048 + 1024 + cbase + 8 * k4);
        bf16x8 wf[4][4];
#pragma unroll
        for (int s4 = 0; s4 < 4; ++s4)
#pragma unroll
            for (int qb = 0; qb < 4; ++qb) wf[s4][qb] = *(const bf16x8*)(wbase + (size_t)(32 * qb) * 128 + 16 * s4);
#pragma unroll
        for (int j2 = 0; j2 < 2; ++j2) {
            const int p = lane + 64 * j2; const f32x2 st = stats[p];
#pragma unroll
            for (int k4 = 0; k4 < 4; ++k4) {
                f32x4 a, bq; unpack8(vraw[j2][k4], a, bq);
                const f32x4 g0 = *(const f32x4*)(lng + cbase + 8 * k4), g1 = *(const f32x4*)(lng + cbase + 8 * k4 + 4), b0 = *(const f32x4*)(lnb + cbase + 8 * k4), b1 = *(const f32x4*)(lnb + cbase + 8 * k4 + 4);
                a = (a - st.x) * st.y * g0 + b0; bq = (bq - st.x) * st.y * g1 + b1;
                *(LAS u32x4*)(img + p * 96 + 16 * k4) = pg8::pack8(a, bq);
            }
        }
        u32x2 uw[4][4]; float bqv[4];
#pragma unroll
        for (int qb = 0; qb < 4; ++qb) { bqv[qb] = bs[g * 128 + 32 * qb + l31];
#pragma unroll
            for (int gq = 0; gq < 4; ++gq) uw[qb][gq] = *(const u32x2*)(ZB + (size_t)(row0 + 32 * qb + l31) * 2048 + cbase + 8 * gq + 4 * hl); }
        LDS_WAIT();
        f32x16 acc[4];
#pragma unroll
        for (int qb = 0; qb < 4; ++qb)
#pragma unroll
            for (int i = 0; i < 16; ++i) acc[qb][i] = 0.f;
#define GM_STEP(S, WF) do { const bf16x8 vf = tr_read2<16 * S * 96, 16 * S * 96 + 4 * 96>(itr); \
            _Pragma("unroll") for (int qb = 0; qb < 4; ++qb) acc[qb] = MFMA32(vf, WF[S & 3][qb], acc[qb]); } while (0)
        GM_STEP(0, wf); GM_STEP(1, wf); GM_STEP(2, wf); GM_STEP(3, wf);
#pragma unroll
        for (int s4 = 0; s4 < 4; ++s4)
#pragma unroll
            for (int qb = 0; qb < 4; ++qb) wf[s4][qb] = *(const bf16x8*)(wbase + (size_t)(32 * qb) * 128 + 16 * (4 + s4));
        GM_STEP(4, wf); GM_STEP(5, wf); GM_STEP(6, wf); GM_STEP(7, wf);
#undef GM_STEP
#pragma unroll
        for (int qb = 0; qb < 4; ++qb) {
            const int q = 32 * qb + l31; const float bq = bqv[qb];
            const size_t row = (size_t)(row0 + q);
#pragma unroll
            for (int gq = 0; gq < 4; ++gq) { const int col = cbase + 8 * gq + 4 * hl;
                const u32x2 uwv = uw[qb][gq];
                u32x2 w; w.x = cvt_pk_bf16(bf_lo(uwv.x) * (acc[qb][4 * gq] + bq), bf_hi(uwv.x) * (acc[qb][4 * gq + 1] + bq)); w.y = cvt_pk_bf16(bf_lo(uwv.y) * (acc[qb][4 * gq + 2] + bq), bf_hi(uwv.y) * (acc[qb][4 * gq + 3] + bq));
                *(u32x2*)(ACAT + row * D + col) = w; }
        }
        LDS_WAIT();
    }
}

constexpr int S5_WAVE_LDS = 8192 + 16 * 272;
__device__ __forceinline__ void s5_chunk_ids(int ci, int& b, int& n, bool& isctx) { isctx = ci >= 128; if (isctx) { b = (ci - 128) >> 1; n = (ci - 128) & 1; } else { b = ci >> 6; n = ci & 63; } }
__device__ __forceinline__ int s5_scan_index(int d, int n, bool isctx) { return d == 0 ? (isctx ? n : 2 + n) : (isctx ? 1 - n : 2 + (63 - n)); }
__device__ __forceinline__ void s5_load_u(bf16x8 (&ufr)[4], const bf16* US, int row0, int g, int lane) {
#pragma unroll
    for (int tb = 0; tb < 4; ++tb) ufr[tb] = *(const bf16x8*)(US + (size_t)(row0 + 32 * tb + (lane & 31)) * SSW + SG * g + 8 * (lane >> 5));
}
__device__ __forceinline__ void s5_bu(f32x16 (&Dt)[4], const bf16x8 uf, const bf16x8 (&bfr)[4]) {
#pragma unroll
    for (int j = 0; j < 4; ++j) {
#pragma unroll
        for (int i = 0; i < 16; ++i) Dt[j][i] = 0.f;
        Dt[j] = MFMA32(uf, bfr[j], Dt[j]); }
}
template <int H2> __device__ __forceinline__ void s5_bu_to_lds(LAS float* bu, const f32x16 (&Dt)[4], int lane) {
    const int hl = lane >> 5, l31 = lane & 31;
#pragma unroll
    for (int j = 0; j < 4; ++j)
#pragma unroll
        for (int ii = 0; ii < 8; ++ii) { const int i = 8 * H2 + ii, tt = (ii & 3) + 8 * (ii >> 2) + 4 * hl; bu[tt * 128 + 32 * j + l31] = Dt[j][i]; }
    LDS_WAIT();
}
template <bool WRITE_H> __device__ __forceinline__ void s5_scan16(const LAS float* bu, LAS unsigned char* hs, int d, float ar, float ai, float& hr, float& hi, int lane) {
    for (int st = 0; st < 16; ++st) { const int tt = d ? 15 - st : st;
        const float br = bu[tt * 128 + lane], bi = bu[tt * 128 + 64 + lane];
        const float nr = ar * hr - ai * hi + br, ni = ar * hi + ai * hr + bi; hr = nr; hi = ni;
        if (WRITE_H) { const unsigned w = cvt_pk_bf16(hr, hi);
            *(LAS unsigned short*)(hs + tt * 272 + 2 * lane) = (unsigned short)(w & 0xffffu); *(LAS unsigned short*)(hs + tt * 272 + 128 + 2 * lane) = (unsigned short)(w >> 16); } }
    LDS_WAIT();
}
__device__ __forceinline__ void s5_pass1(LAS unsigned char* wl, const bf16* US, const f32x4* SA_l, const bf16* SBB_l, f32x2* HEND, int ci, int g, int lane) {
    LAS float* bu = (LAS float*)wl;
    int b, n; bool isctx; s5_chunk_ids(ci, b, n, isctx);
    const int row0 = 128 * ci;
    bf16x8 ufr[4]; s5_load_u(ufr, US, row0, g, lane);
#pragma unroll
    for (int d = 0; d < 2; ++d) {
        const int k = s5_scan_index(d, n, isctx);
        if (k == NK - 1) continue;
        const f32x4 A = SA_l[(d * NG + g) * NP + lane];
        bf16x8 bfr[4];
#pragma unroll
        for (int j = 0; j < 4; ++j) bfr[j] = *(const bf16x8*)(SBB_l + ((size_t)((d * NG + g) * 128 + 32 * j + (lane & 31)) * SG + 8 * (lane >> 5)));
        float hr = 0.f, hi = 0.f;
#pragma unroll
        for (int tbi = 0; tbi < 4; ++tbi) {
            const int tb = d ? 3 - tbi : tbi;
            f32x16 Dt[4]; s5_bu(Dt, ufr[tb], bfr);
            if (d == 0) { s5_bu_to_lds<0>(bu, Dt, lane); s5_scan16<false>(bu, nullptr, 0, A[0], A[1], hr, hi, lane); s5_bu_to_lds<1>(bu, Dt, lane); s5_scan16<false>(bu, nullptr, 0, A[0], A[1], hr, hi, lane); }
            else        { s5_bu_to_lds<1>(bu, Dt, lane); s5_scan16<false>(bu, nullptr, 1, A[0], A[1], hr, hi, lane); s5_bu_to_lds<0>(bu, Dt, lane); s5_scan16<false>(bu, nullptr, 1, A[0], A[1], hr, hi, lane); }
        }
        HEND[((size_t)((b * 2 + d) * NK + k) * NG + g) * NP + lane] = (f32x2){hr, hi};
    }
}
__device__ __forceinline__ void s5_pass2(LAS unsigned char* wl, const bf16* US, const f32x4* SA_l, const bf16* SBB_l, const bf16* SC_l, const f32x2* HEND, const float* dskip_l, bf16* YS, int ci, int g, int lane) {
    LAS float* bu = (LAS float*)wl; LAS unsigned char* hs = wl + 8192;
    int b, n; bool isctx; s5_chunk_ids(ci, b, n, isctx);
    const int row0 = 128 * ci;
    f32x4 yacc[8];
#pragma unroll
    for (int sb = 0; sb < 8; ++sb) yacc[sb] = (f32x4){0.f, 0.f, 0.f, 0.f};
    const int t16 = lane & 15, kq = lane >> 4;
    bf16x8 ufr[4]; s5_load_u(ufr, US, row0, g, lane);
#define S5_HALF(SB, H2, DIR) do { s5_bu_to_lds<H2>(bu, Dt, lane); s5_scan16<true>(bu, hs, DIR, A[0], A[1], hr, hi, lane); \
        _Pragma("unroll") for (int kb = 0; kb < 4; ++kb) { const bf16x8 hf = *(const LAS bf16x8*)(hs + t16 * 272 + 64 * kb + 16 * kq); yacc[SB] = MFMA16(cf[kb], hf, yacc[SB]); } \
        LDS_WAIT(); } while (0)
#pragma unroll
    for (int d = 0; d < 2; ++d) {
        const int k = s5_scan_index(d, n, isctx);
        const f32x4 A = SA_l[(d * NG + g) * NP + lane];
        bf16x8 bfr[4], cf[4];
#pragma unroll
        for (int j = 0; j < 4; ++j) bfr[j] = *(const bf16x8*)(SBB_l + ((size_t)((d * NG + g) * 128 + 32 * j + (lane & 31)) * SG + 8 * (lane >> 5)));
#pragma unroll
        for (int kb = 0; kb < 4; ++kb) cf[kb] = *(const bf16x8*)(SC_l + ((size_t)((d * NG + g) * SG + t16) * 128 + 32 * kb + 8 * kq));
        float hr = 0.f, hi = 0.f;
        const f32x2* he = HEND + ((size_t)((b * 2 + d) * NK) * NG + g) * NP + lane;
        for (int j0 = 0; j0 < k; j0 += 8) {
            f32x2 e[8];
#pragma unroll
            for (int q = 0; q < 8; ++q) { const int jj = (j0 + q < k) ? j0 + q : k - 1; e[q] = he[(size_t)jj * NG * NP]; }
#pragma unroll
            for (int q = 0; q < 8; ++q) if (j0 + q < k) { const float nr = A[2] * hr - A[3] * hi + e[q].x, ni = A[2] * hi + A[3] * hr + e[q].y; hr = nr; hi = ni; }
        }
        f32x16 Dt[4];
        if (d == 0) {
            s5_bu(Dt, ufr[0], bfr); S5_HALF(0, 0, 0); S5_HALF(1, 1, 0);
            s5_bu(Dt, ufr[1], bfr); S5_HALF(2, 0, 0); S5_HALF(3, 1, 0);
            s5_bu(Dt, ufr[2], bfr); S5_HALF(4, 0, 0); S5_HALF(5, 1, 0);
            s5_bu(Dt, ufr[3], bfr); S5_HALF(6, 0, 0); S5_HALF(7, 1, 0);
        } else {
            s5_bu(Dt, ufr[3], bfr); S5_HALF(7, 1, 1); S5_HALF(6, 0, 1);
            s5_bu(Dt, ufr[2], bfr); S5_HALF(5, 1, 1); S5_HALF(4, 0, 1);
            s5_bu(Dt, ufr[1], bfr); S5_HALF(3, 1, 1); S5_HALF(2, 0, 1);
            s5_bu(Dt, ufr[0], bfr); S5_HALF(1, 1, 1); S5_HALF(0, 0, 1);
        }
    }
#undef S5_HALF
    const f32x4 dsk = *(const f32x4*)(dskip_l + SG * g + 4 * kq);
#pragma unroll
    for (int sb = 0; sb < 8; ++sb) { const int t = 16 * sb + t16; const u32x2 uw = *(const u32x2*)(US + (size_t)(row0 + t) * SSW + SG * g + 4 * kq);
        const f32x4 us4 = {bf_lo(uw.x), bf_hi(uw.x), bf_lo(uw.y), bf_hi(uw.y)};
        f32x4 y = yacc[sb] + dsk * us4;
#pragma unroll
        for (int e = 0; e < 4; ++e) y[e] = gelu_tanh_f(y[e]);
        u32x2 w; w.x = cvt_pk_bf16(y[0], y[1]); w.y = cvt_pk_bf16(y[2], y[3]);
        *(u32x2*)(YS + (size_t)(row0 + t) * SSW + SG * g + 4 * kq) = w; }
}

constexpr int NPH = 2 + 13 * DEPTH;
__global__ void __launch_bounds__(512, 2) fwd_kernel(Args args) {
    extern __shared__ __attribute__((aligned(16))) unsigned char lds_raw[];
    LAS unsigned char* lds = (LAS unsigned char*)lds_raw;
    volatile LAS unsigned* MISC = (volatile LAS unsigned*)(lds + MISC_OFF);
    for (int u = threadIdx.x; u < (LDS_BYTES - LDSCTL_OFF) / 4; u += 512) ((LAS unsigned*)(lds + LDSCTL_OFF))[u] = 0u;
    __syncthreads();
    const int lo = args.ph_lo, hi = args.ph_hi;
    const bool use_bar = (hi - lo) > 1;
    XcdBarrier bar; bar.bar = (unsigned*)(args.ws + WS_CTL) + CW_BAR; bar.x = 0; bar.st = nullptr;
    if (use_bar) bar = xcd_barrier_post((unsigned*)(args.ws + WS_CTL) + CW_BAR, MISC + 8);
#ifndef PH_MASK
#define PH_MASK 0xFFFFFFFFu
#endif
#define IN(k) ((PH_MASK >> ((k) < 2 ? (k) : 2 + ((k) - 2) % 13) & 1u) && lo <= (k) && (k) < hi)
#define SEAM(k) do { if (IN(k) && IN((k) + 1)) xcd_barrier(bar); } while (0)
#define PHASE_IDS() int tid = threadIdx.x; asm volatile("" : "+v"(tid)); const int lane = tid & 63, wid = __builtin_amdgcn_readfirstlane(tid >> 6); \
    int bx = blockIdx.x, G = gridDim.x; asm volatile("" : "+s"(bx), "+s"(G)); GAS unsigned char* wsg_ = (GAS unsigned char*)args.ws; asm volatile("" : "+s"(wsg_)); unsigned char* ws = (unsigned char*)wsg_; const int gw = bx * 8 + wid, NGW = G * 8; (void)lane; (void)gw; (void)NGW
#define X ((float*)(ws + WS_X))
#define H ((bf16*)(ws + WS_H))
#define ACT ((bf16*)(ws + WS_ACT))
#define QP ((bf16*)(ws + WS_QP))
#define QR ((bf16*)(ws + WS_QR))
#define KB ((bf16*)(ws + WS_KB))
#define VB ((bf16*)(ws + WS_VB))
#define ZB ((bf16*)(ws + WS_ZB))
#define US ((bf16*)(ws + WS_US))
#define GB ((bf16*)(ws + WS_GB))
#define ACAT ((bf16*)(ws + WS_ACAT))
#define YS ((bf16*)(ws + WS_YS))
#define MG ((bf16*)(ws + WS_MG))
#define YB ((bf16*)(ws + WS_Y))
#define XSRC_IN (l == 0 ? as_global(args.in[0]) : nullptr)
#define modv ((const float*)(ws + WS_MOD))
#define WL(off) ((const bf16*)(ws + WS_W + (size_t)l * LW_BYTES + (off)))
#define MODL (modv + (size_t)l * 3 * NMODC)
#define LNG(i) (as_global(args.in[6]) + (size_t)(l * 3 + (i)) * D)
#define LNB(i) (as_global(args.in[7]) + (size_t)(l * 3 + (i)) * D)
#define MEFF (l == DEPTH - 1 ? ML : M)
constexpr int NCTXU = (MC / 256) * (D / 256);
#define OVL(mrows_) (use_bar && (mrows_) == M && G >= 4 * NCTXU)

    if (IN(0)) {
        PHASE_IDS();
        p0_tables(args, bx * 512 + tid, G * 512);
        p0_mod(args, lds, wid, lane, tid, G, bx);
        p0_weights(args, lds, wid, lane, G, bx);
        __syncthreads();
    }
    SEAM(0);
    if (IN(1)) { PHASE_IDS(); thin_phase(0, as_global(args.in[0]), as_global(args.in[2]), X, nullptr, nullptr, nullptr, modv, 0, 1, H, nullptr, M, gw, NGW, lane, (LAS float*)lds, tid); }
    SEAM(1);

    for (int l = 0; l < DEPTH; ++l) {
        const int pb = 2 + 13 * l;
        if (pb >= hi || pb + 13 <= lo) continue;
        if (IN(pb + 0)) { PHASE_IDS(); pg8::Gemm g{H, WL(LW_W1IN), M, 2 * DFF, D, D, D}; pg8::StaticOrder S; S.init(M, 2 * DFF, G, bx, D); pg8::EpiSwiGLU E{ACT, DFF};
            pg8::gemm_phase<pg8::EpiSwiGLU, pg8::StaticOrder>(lds, g, S, E, tid); }
        SEAM(pb + 0);
        if (IN(pb + 1)) { PHASE_IDS(); const int mr = OVL(M) ? ML : M; pg8::Gemm g{ACT, WL(LW_W1OUT), mr, D, DFF, DFF, DFF}; pg8::StaticOrder S; S.init(mr, D, G, bx, DFF); pg8::EpiY E{YB, MODL, 2, 0.5f};
            pg8::gemm_phase<pg8::EpiY, pg8::StaticOrder>(lds, g, S, E, tid); }
        SEAM(pb + 1);
        if (IN(pb + 2)) { PHASE_IDS();
            if (OVL(M)) {
                if (bx < NCTXU) { pg8::Gemm g{ACT, WL(LW_W1OUT), M, D, DFF, DFF, DFF}; pg8::CtxOrder S; S.init(D, bx, DFF); pg8::EpiY E{YB, MODL, 2, 0.5f}; pg8::gemm_phase<pg8::EpiY, pg8::CtxOrder>(lds, g, S, E, tid); }
                else thin_phase(1, XSRC_IN, as_global(args.in[2]), X, YB, LNG(0), LNB(0), MODL, 3, 4, H, nullptr, ML, (bx - NCTXU) * 8 + wid, (G - NCTXU) * 8, lane, (LAS float*)lds, tid, (unsigned char*)ACT);
                xcd_barrier(bar);
                thin_phase(1, XSRC_IN, as_global(args.in[2]), X, YB, LNG(0), LNB(0), MODL, 3, 4, H, nullptr, M, gw, NGW, lane, (LAS float*)lds, tid, (unsigned char*)ACT, ML);
            } else thin_phase(1, XSRC_IN, as_global(args.in[2]), X, YB, LNG(0), LNB(0), MODL, 3, 4, H, nullptr, M, gw, NGW, lane, (LAS float*)lds, tid, (unsigned char*)ACT); }
        SEAM(pb + 2);
        if (IN(pb + 3)) {
            { PHASE_IDS(); pg8::Gemm g{H, WL(LW_WIN), M, 36 * 256, D, D, D}; pg8::StaticOrder S; S.init(M, 36 * 256, G, bx, D);
              pg8::EpiIn<false> E{ws, (const float*)(ws + WS_ROPE), 0, 1.0f};
              pg8::gemm_phase<pg8::EpiIn<false>, pg8::StaticOrder>(lds, g, S, E, tid); }
            { PHASE_IDS(); pg8::Gemm g{ACT, WL(LW_W8), MEFF, 48 * 256, D / 2, D / 2, D / 2}; pg8::StaticOrder S; S.init(MEFF, 48 * 256, G, (bx + G / 2) % G, D / 2);
              pg8::EpiIn<true> E{ws, (const float*)(ws + WS_ROPE), 36, 1.0f / 16384.0f};
              pg8::gemm_phase<pg8::EpiIn<true>, pg8::StaticOrder>(lds, g, S, E, tid); }
        }
        SEAM(pb + 3);
#ifndef M1_MASK
#define M1_MASK 7
#endif
        if (IN(pb + 4)) {
            if (M1_MASK & 1) { PHASE_IDS();
                const float* rpb_l = as_global(args.in[13]) + (size_t)l * NH * 465;
                for (int u = bx; u < (l == DEPTH - 1 ? 1024 : 1056); u += G) {
                    if (u < 1024) { const int rb = u & 31, h = (u >> 5) & 15, b = u >> 9; attn_unit(lds, QP, QR, KB, VB, ACAT, rpb_l, b, h, 4 * rb, tid, wid, lane); }
                    else { const int v = u - 1024; attn_unit(lds, QP, QR, KB, VB, ACAT, rpb_l, v >> 4, v & 15, -1, tid, wid, lane); }
                }
                __syncthreads(); }
            if (M1_MASK & 2) { PHASE_IDS();
                for (int u = (G - 1 - bx); u < 2 * (MEFF / 128); u += G)
                    gmlp_unit(lds, ZB, ACAT, as_global(args.in[14]) + (size_t)l * GMW, as_global(args.in[15]) + (size_t)l * GMW, (const bf16*)(ws + WS_GWS) + (size_t)l * 8 * 128 * 128, as_global(args.in[17]) + (size_t)l * 8 * 128, u, tid, wid, lane);
                __syncthreads(); }
            if (M1_MASK & 4) { PHASE_IDS();
                for (int u = gw; u < NCH * NG; u += NGW)
                    s5_pass1(lds + wid * S5_WAVE_LDS, US, (const f32x4*)(ws + WS_SA) + (size_t)l * 2 * NG * NP, (const bf16*)(ws + WS_SBB) + (size_t)l * 2 * NG * 128 * SG, (f32x2*)(ws + WS_HEND), u >> 6, u & 63, lane);
                __syncthreads(); }
        }
        SEAM(pb + 4);
        if (IN(pb + 5)) { PHASE_IDS();
            for (int u = gw; u < (MEFF / 128) * NG; u += NGW)
                s5_pass2(lds + wid * S5_WAVE_LDS, US, (const f32x4*)(ws + WS_SA) + (size_t)l * 2 * NG * NP, (const bf16*)(ws + WS_SBB) + (size_t)l * 2 * NG * 128 * SG, (const bf16*)(ws + WS_SC) + (size_t)l * 2 * NG * SG * 128,
                         (const f32x2*)(ws + WS_HEND), as_global(args.in[25]) + (size_t)l * SSW, YS, u >> 6, u & 63, lane);
            __syncthreads();
        }
        SEAM(pb + 5);
        if (IN(pb + 6)) { PHASE_IDS(); pg8::Gemm g{YS, WL(LW_WGLU), MEFF, SSW, SSW, SSW, SSW}; pg8::StaticOrder S; S.init(MEFF, SSW, G, bx, SSW); pg8::EpiGLU E{YS, ACAT + GMW + AW, as_global(args.in[27]) + (size_t)l * SSW};
            pg8::gemm_phase<pg8::EpiGLU, pg8::StaticOrder>(lds, g, S, E, tid); }
        SEAM(pb + 6);
        if (IN(pb + 7)) { PHASE_IDS(); pg8::Gemm g{ACAT, WL(LW_WCAT), MEFF, D, D, D, D}; pg8::MergeOrder S; S.init(MEFF, D, G, bx); pg8::EpiMerge1 E{GB, MG};
            pg8::gemm_phase<pg8::EpiMerge1, pg8::MergeOrder>(lds, g, S, E, tid); }
        SEAM(pb + 7);
        if (IN(pb + 8)) { PHASE_IDS(); const int mr = OVL(MEFF) ? ML : MEFF; pg8::Gemm g{MG, WL(LW_WO), mr, D, D, D, D}; pg8::StaticOrder S; S.init(mr, D, G, bx, D); pg8::EpiY E{YB, MODL, 5, 1.0f};
            pg8::gemm_phase<pg8::EpiY, pg8::StaticOrder>(lds, g, S, E, tid); }
        SEAM(pb + 8);
        if (IN(pb + 9)) { PHASE_IDS();
            if (OVL(MEFF)) {
                if (bx < NCTXU) { pg8::Gemm g{MG, WL(LW_WO), M, D, D, D, D}; pg8::CtxOrder S; S.init(D, bx, D); pg8::EpiY E{YB, MODL, 5, 1.0f}; pg8::gemm_phase<pg8::EpiY, pg8::CtxOrder>(lds, g, S, E, tid); }
                else thin_phase(1, nullptr, nullptr, X, YB, LNG(1), LNB(1), MODL, 6, 7, H, nullptr, ML, (bx - NCTXU) * 8 + wid, (G - NCTXU) * 8, lane, (LAS float*)lds, tid);
                xcd_barrier(bar);
                thin_phase(1, nullptr, nullptr, X, YB, LNG(1), LNB(1), MODL, 6, 7, H, nullptr, M, gw, NGW, lane, (LAS float*)lds, tid, nullptr, ML);
            } else thin_phase(1, nullptr, nullptr, X, YB, LNG(1), LNB(1), MODL, 6, 7, H, nullptr, MEFF, gw, NGW, lane, (LAS float*)lds, tid); }
        SEAM(pb + 9);
        if (IN(pb + 10)) { PHASE_IDS(); pg8::Gemm g{H, WL(LW_W2IN), MEFF, 2 * DFF, D, D, D}; pg8::StaticOrder S; S.init(MEFF, 2 * DFF, G, bx, D); pg8::EpiSwiGLU E{ACT, DFF};
            pg8::gemm_phase<pg8::EpiSwiGLU, pg8::StaticOrder>(lds, g, S, E, tid); }
        SEAM(pb + 10);
        if (IN(pb + 11)) { PHASE_IDS(); const int mr = OVL(MEFF) ? ML : MEFF; pg8::Gemm g{ACT, WL(LW_W2OUT), mr, D, DFF, DFF, DFF}; pg8::StaticOrder S; S.init(mr, D, G, bx, DFF); pg8::EpiY E{YB, MODL, 8, 0.5f};
            pg8::gemm_phase<pg8::EpiY, pg8::StaticOrder>(lds, g, S, E, tid); }
        SEAM(pb + 11);
        if (IN(pb + 12)) { PHASE_IDS();
            if (l + 1 < DEPTH && OVL(M)) {
                if (bx < NCTXU) { pg8::Gemm g{ACT, WL(LW_W2OUT), M, D, DFF, DFF, DFF}; pg8::CtxOrder S; S.init(D, bx, DFF); pg8::EpiY E{YB, MODL, 8, 0.5f}; pg8::gemm_phase<pg8::EpiY, pg8::CtxOrder>(lds, g, S, E, tid); }
                else thin_phase(1, nullptr, nullptr, X, YB, LNG(2), LNB(2), MODL + 3 * NMODC, 0, 1, H, nullptr, ML, (bx - NCTXU) * 8 + wid, (G - NCTXU) * 8, lane, (LAS float*)lds, tid);
                xcd_barrier(bar);
                thin_phase(1, nullptr, nullptr, X, YB, LNG(2), LNB(2), MODL + 3 * NMODC, 0, 1, H, nullptr, M, gw, NGW, lane, (LAS float*)lds, tid, nullptr, ML);
            } else if (l + 1 < DEPTH) thin_phase(1, nullptr, nullptr, X, YB, LNG(2), LNB(2), MODL + 3 * NMODC, 0, 1, H, nullptr, M, gw, NGW, lane, (LAS float*)lds, tid);
            else thin_phase(2, nullptr, nullptr, X, YB, LNG(2), LNB(2), MODL, 0, 1, H, as_global(args.out), ML, gw, NGW, lane, (LAS float*)lds, tid);
        }
        SEAM(pb + 12);
    }
}

extern "C" void kernel_launch(void* const* d_in, const int* in_sizes, int n_in, void* d_out, int out_size, void* d_ws, size_t ws_size, hipStream_t stream) {
    static int grid = 0;
    if (grid == 0) {
        if (n_in != 32 || out_size != ML * D || ws_size < WS_END) { fprintf(stderr, "kernel_launch: unexpected sizes (n_in %d, out %d, ws %zu, need %zu)\n", n_in, out_size, ws_size, (size_t)WS_END); grid = -1; return; }
        int dev = 0, cus = 0, per_cu = 0;
        if (hipGetDevice(&dev) != hipSuccess || hipDeviceGetAttribute(&cus, hipDeviceAttributeMultiprocessorCount, dev) != hipSuccess) { grid = -1; return; }
        if (hipFuncSetAttribute((const void*)fwd_kernel, hipFuncAttributeMaxDynamicSharedMemorySize, LDS_BYTES) != hipSuccess) { fprintf(stderr, "kernel_launch: hipFuncSetAttribute failed\n"); grid = -1; return; }
        if (hipOccupancyMaxActiveBlocksPerMultiprocessor(&per_cu, (const void*)fwd_kernel, 512, LDS_BYTES) != hipSuccess || per_cu < 1) fprintf(stderr, "kernel_launch: occupancy query says %d\n", per_cu);
        (void)hipGetLastError();
        grid = cus;
    }
    if (grid < 0) return;
    (void)hipMemsetAsync((char*)d_ws + WS_CTL, 0, CTL_ZERO_BYTES, stream);
    Args a{};
    for (int i = 0; i < 32; ++i) a.in[i] = (const float*)d_in[i];
    a.out = (float*)d_out; a.ws = (unsigned char*)d_ws;
#if MK_N_LAUNCHES == 1
    a.ph_lo = 0; a.ph_hi = NPH;
    hipLaunchKernelGGL(fwd_kernel, dim3(grid), dim3(512), LDS_BYTES, stream, a);
#else
    for (int p = 0; p < NPH; ++p) { a.ph_lo = p; a.ph_hi = p + 1; hipLaunchKernelGGL(fwd_kernel, dim3(grid), dim3(512), LDS_BYTES, stream, a); }
#endif
}
```
